# Optimizing an MI355X kernel written in HIP

```python
import math
import jax, jax.numpy as jnp
from jax import lax
import numpy as np

D_MODEL = 1024
BATCH = 8
SEQ = 2048
DEPTH = 1

D_MIX = D_MODEL
SSD_HEADS = 8
SSD_HEAD_DIM = 64
D_SSD = SSD_HEADS * SSD_HEAD_DIM
SSD_GROUPS = 2
SSD_HEADS_PER_GROUP = SSD_HEADS // SSD_GROUPS
D_STATE = 128
CONV_WIDTH = 4
SSD_CHUNK = 128
D_CONV = D_SSD + 2 * SSD_GROUPS * D_STATE
ATTN_Q_HEADS = 8
ATTN_KV_HEADS = 2
ATTN_Q_PER_KV = ATTN_Q_HEADS // ATTN_KV_HEADS
ATTN_HEAD_DIM = 64
D_ATTN = ATTN_Q_HEADS * ATTN_HEAD_DIM
D_KV = ATTN_KV_HEADS * ATTN_HEAD_DIM
WINDOW = 128
ATTN_BLOCK = 128
REL_BUCKETS = 32
REL_MAX_DIST = 128
D_PROJ = D_SSD + D_CONV + SSD_HEADS + D_ATTN + 2 * D_KV
N_EXPERTS = 32
TOP_K = 4
D_EXPERT = D_MODEL
SWIGLU_LIMIT = 7.0
SWIGLU_ALPHA = 1.702
MOE_BLOCK = 128
RMS_EPS = 1e-5

kernel_name = "hymba_ssd_swa_sink_moe_block"


def rmsnorm(x, g):
    xf = x.astype(jnp.float32)
    y = xf * lax.rsqrt(jnp.mean(xf * xf, axis=-1, keepdims=True) + RMS_EPS)
    return (y * g.astype(jnp.float32)).astype(x.dtype)


def causal_depthwise_conv(u, w, b):
    k_width, chans = w.shape
    out = lax.conv_general_dilated(
        u, w[:, None, :].astype(u.dtype), window_strides=(1,),
        padding=[(k_width - 1, 0)], dimension_numbers=("NWC", "WIO", "NWC"),
        feature_group_count=chans)
    return out + b.astype(u.dtype)


def ssd_group(z, xbc, dt_raw, conv_w, conv_b, dt_bias, a_log, d_skip, norm_g):
    bsz, seq = z.shape[0], z.shape[1]
    nc = seq // SSD_CHUNK
    G, R, P, N, L = SSD_GROUPS, SSD_HEADS_PER_GROUP, SSD_HEAD_DIM, D_STATE, SSD_CHUNK
    xbc = jax.nn.silu(causal_depthwise_conv(xbc, conv_w, conv_b))
    xs = xbc[..., :D_SSD]
    bm = xbc[..., D_SSD:D_SSD + G * N].reshape(bsz, nc, L, G, N)
    cm = xbc[..., D_SSD + G * N:].reshape(bsz, nc, L, G, N)
    x = xs.reshape(bsz, nc, L, G, R, P)
    dt = jax.nn.softplus(dt_raw.astype(jnp.float32) + dt_bias.astype(jnp.float32))
    a = -jnp.exp(a_log.astype(jnp.float32))
    dt_c = dt.reshape(bsz, nc, L, G, R)
    xdt = x * dt_c[..., None]
    a_dt = jnp.transpose(dt_c * a.reshape(G, R), (0, 3, 4, 1, 2))
    a_cum = jnp.cumsum(a_dt, axis=-1)
    seg = a_cum[..., :, None] - a_cum[..., None, :]
    causal = jnp.tril(jnp.ones((L, L), dtype=bool))
    decay = jnp.exp(jnp.where(causal, seg, -jnp.inf))
    cb = jnp.einsum("bclgn,bcsgn->bgcls", cm, bm)
    y_diag = jnp.einsum("bgrcls,bcsgrp->bclgrp", cb[:, :, None] * decay, xdt)
    decay_to_end = jnp.exp(a_cum[..., -1:] - a_cum)
    states = jnp.einsum("bclgn,bgrcl,bclgrp->bcgrpn", bm, decay_to_end, xdt)
    chunk_decay = jnp.exp(a_cum[..., -1])

    def step(h, inp):
        st, dec = inp
        return h * dec[..., None, None] + st, h

    h0 = jnp.zeros(states.shape[:1] + states.shape[2:], states.dtype)
    _, prev = lax.scan(step, h0, (jnp.moveaxis(states, 1, 0), jnp.moveaxis(chunk_decay, 3, 0)))
    prev = jnp.moveaxis(prev, 0, 1)
    y_off = jnp.einsum("bclgn,bcgrpn,bgrcl->bclgrp", cm, prev, jnp.exp(a_cum))
    y = y_diag + y_off + x * d_skip.reshape(G, R)[:, :, None]
    y = y.reshape(bsz, seq, D_SSD).astype(z.dtype)
    return rmsnorm(y * jax.nn.silu(z), norm_g)


def t5_bucket(dist):
    max_exact = REL_BUCKETS // 2
    is_small = dist < max_exact
    d = jnp.maximum(dist, 1).astype(jnp.float32)
    large = max_exact + (jnp.log(d / max_exact) / math.log(REL_MAX_DIST / max_exact)
                         * (REL_BUCKETS - max_exact)).astype(jnp.int32)
    large = jnp.minimum(large, REL_BUCKETS - 1)
    return jnp.where(is_small, dist, large)


def swa_group(q, k, v, sinks, rel_bias):
    bsz, seq = q.shape[0], q.shape[1]
    L = ATTN_BLOCK
    nb = seq // L
    HK, G, Dh = ATTN_KV_HEADS, ATTN_Q_PER_KV, ATTN_HEAD_DIM
    qb = q.reshape(bsz, nb, L, HK, G, Dh)
    kb = k.reshape(bsz, nb, L, HK, Dh)
    vb = v.reshape(bsz, nb, L, HK, Dh)
    kk = jnp.concatenate([jnp.concatenate([jnp.zeros_like(kb[:, :1]), kb[:, :-1]], axis=1), kb], axis=2)
    vv = jnp.concatenate([jnp.concatenate([jnp.zeros_like(vb[:, :1]), vb[:, :-1]], axis=1), vb], axis=2)
    s = jnp.einsum("bnqhgd,bnkhd->bnhgqk", qb, kk).astype(jnp.float32) * (1.0 / math.sqrt(Dh))
    dist = L + jnp.arange(L)[:, None] - jnp.arange(2 * L)[None, :]
    in_window = (dist >= 0) & (dist < WINDOW)
    bias = rel_bias.astype(jnp.float32)[t5_bucket(jnp.clip(dist, 0, REL_MAX_DIST))]
    bias = jnp.transpose(bias.reshape(L, 2 * L, HK, G), (2, 3, 0, 1))
    prev_ok = (jnp.arange(nb)[:, None] > 0) | (jnp.arange(2 * L)[None, :] >= L)
    mask = in_window[None] & prev_ok[:, None, :]
    s = jnp.where(mask[None, :, None, None], s + bias[None, None], -jnp.inf)
    sink = sinks.astype(jnp.float32).reshape(HK, G)[None, None, :, :, None, None]
    m = jnp.maximum(jnp.max(s, axis=-1, keepdims=True), sink)
    p = jnp.exp(s - m)
    p = p / (jnp.sum(p, axis=-1, keepdims=True) + jnp.exp(sink - m))
    o = jnp.einsum("bnhgqk,bnkhd->bnqhgd", p.astype(vv.dtype), vv)
    return o.reshape(bsz, seq, D_ATTN)


def clamped_swiglu(hid):
    x_glu = jnp.minimum(hid[..., :D_EXPERT], SWIGLU_LIMIT)
    x_lin = jnp.clip(hid[..., D_EXPERT:], -SWIGLU_LIMIT, SWIGLU_LIMIT)
    return x_glu * jax.nn.sigmoid(SWIGLU_ALPHA * x_glu) * (x_lin + 1.0)


def moe_ffn(u, w_router, b_router, w1, b1, w2, b2):
    bsz, seq, d = u.shape
    T = bsz * seq
    xt = u.reshape(T, d)
    logits = (xt @ w_router + b_router).astype(jnp.float32)
    top_val, top_idx = lax.top_k(logits, TOP_K)
    gate = jax.nn.softmax(top_val, axis=-1)
    e_flat = top_idx.reshape(-1).astype(jnp.int32)
    tok_flat = jnp.repeat(jnp.arange(T, dtype=jnp.int32), TOP_K)
    g_flat = gate.reshape(-1)
    order = jnp.argsort(e_flat)
    e_sorted = e_flat[order]
    counts = jnp.bincount(e_flat, length=N_EXPERTS)
    starts = jnp.cumsum(counts) - counts
    padded = ((counts + MOE_BLOCK - 1) // MOE_BLOCK) * MOE_BLOCK
    padded_ends = jnp.cumsum(padded)
    padded_starts = padded_ends - padded
    n_assign = T * TOP_K
    dest = padded_starts[e_sorted] + jnp.arange(n_assign) - starts[e_sorted]
    P = n_assign + N_EXPERTS * MOE_BLOCK
    row_tok = jnp.full((P,), T, dtype=jnp.int32).at[dest].set(tok_flat[order])
    row_gate = jnp.zeros((P,), jnp.float32).at[dest].set(g_flat[order])
    nblk = P // MOE_BLOCK
    blk_expert = jnp.minimum(
        jnp.searchsorted(padded_ends, jnp.arange(nblk) * MOE_BLOCK, side="right"), N_EXPERTS - 1)
    x_pad = jnp.concatenate([xt, jnp.zeros((1, d), xt.dtype)], axis=0)
    xs = x_pad[row_tok].reshape(nblk, MOE_BLOCK, d)

    def expert_block(args):
        xb, e = args
        hid = clamped_swiglu(xb @ w1[e] + b1[e])
        return hid @ w2[e] + b2[e]

    ys = lax.map(expert_block, (xs, blk_expert)).reshape(P, d)
    ys = ys * row_gate[:, None].astype(ys.dtype)
    out = jax.ops.segment_sum(ys, row_tok, num_segments=T + 1)[:T]
    return out.reshape(bsz, seq, d)


def setup_inputs(seed: int = 0) -> dict:
    key = jax.random.key(seed)
    ks = jax.random.split(key, 24)
    f32 = jnp.float32
    nrm = lambda k, shape, scale: jax.random.normal(k, shape, f32) * scale
    gain = lambda k, shape: 1.0 + 0.05 * jax.random.normal(k, shape, f32)
    dt0 = jnp.exp(jax.random.uniform(ks[5], (DEPTH, SSD_HEADS), f32, math.log(1e-3), math.log(1e-1)))
    return {
        "x": nrm(ks[0], (BATCH, SEQ, D_MODEL), 1.0),
        "norm_mix_g": gain(ks[1], (DEPTH, D_MODEL)),
        "w_in": nrm(ks[2], (DEPTH, D_MODEL, D_PROJ), D_MODEL ** -0.5),
        "conv_w": nrm(ks[3], (DEPTH, CONV_WIDTH, D_CONV), CONV_WIDTH ** -0.5),
        "conv_b": nrm(ks[4], (DEPTH, D_CONV), 0.02),
        "dt_bias": jnp.log(jnp.expm1(dt0)),
        "a_log": jnp.log(jax.random.uniform(ks[6], (DEPTH, SSD_HEADS), f32, 1.0, 16.0)),
        "d_skip": gain(ks[7], (DEPTH, SSD_HEADS)),
        "ssd_norm_g": gain(ks[8], (DEPTH, D_SSD)),
        "attn_sinks": nrm(ks[9], (DEPTH, ATTN_Q_HEADS), 0.5),
        "rel_bias": nrm(ks[10], (REL_BUCKETS, ATTN_Q_HEADS), 0.5),
        "attn_norm_g": gain(ks[11], (DEPTH, D_ATTN)),
        "w_out": nrm(ks[12], (DEPTH, D_MIX, D_MODEL), D_MIX ** -0.5),
        "norm_ffn_g": gain(ks[13], (DEPTH, D_MODEL)),
        "w_router": nrm(ks[14], (DEPTH, D_MODEL, N_EXPERTS), D_MODEL ** -0.5),
        "b_router": nrm(ks[15], (DEPTH, N_EXPERTS), 0.01),
        "w1": nrm(ks[16], (DEPTH, N_EXPERTS, D_MODEL, 2 * D_EXPERT), D_MODEL ** -0.5),
        "b1": nrm(ks[17], (DEPTH, N_EXPERTS, 2 * D_EXPERT), 0.02),
        "w2": nrm(ks[18], (DEPTH, N_EXPERTS, D_EXPERT, D_MODEL), D_EXPERT ** -0.5),
        "b2": nrm(ks[19], (DEPTH, N_EXPERTS, D_MODEL), 0.02),
        "norm_final_g": gain(ks[20], (D_MODEL,)),
    }


def reference(x, norm_mix_g, w_in, conv_w, conv_b, dt_bias, a_log, d_skip, ssd_norm_g,
              attn_sinks, rel_bias, attn_norm_g, w_out, norm_ffn_g, w_router, b_router,
              w1, b1, w2, b2, norm_final_g):
    h = x
    o1 = D_SSD
    o2 = o1 + D_CONV
    o3 = o2 + SSD_HEADS
    o4 = o3 + D_ATTN
    o5 = o4 + D_KV
    for layer in range(DEPTH):
        u = rmsnorm(h, norm_mix_g[layer])
        proj = u @ w_in[layer]
        z, xbc, dt_raw = proj[..., :o1], proj[..., o1:o2], proj[..., o2:o3]
        q, k, v = proj[..., o3:o4], proj[..., o4:o5], proj[..., o5:]
        y_ssd = ssd_group(z, xbc, dt_raw, conv_w[layer], conv_b[layer], dt_bias[layer],
                          a_log[layer], d_skip[layer], ssd_norm_g[layer])
        y_attn = rmsnorm(swa_group(q, k, v, attn_sinks[layer], rel_bias), attn_norm_g[layer])
        h = h + jnp.concatenate([y_ssd, y_attn], axis=-1) @ w_out[layer]
        h = h + moe_ffn(rmsnorm(h, norm_ffn_g[layer]), w_router[layer], b_router[layer],
                        w1[layer], b1[layer], w2[layer], b2[layer])
    return rmsnorm(h, norm_final_g)
```

```cpp
#include <hip/hip_runtime.h>
#include <cstdio>
#include <cstdint>

#ifndef MK_ONE_LAUNCH
#define MK_ONE_LAUNCH 1
#endif

constexpr int BATCH = 8, SEQ = 2048, T = BATCH * SEQ, DM = 1024, DPROJ = 2312;
constexpr int NCH = SEQ / 128;
constexpr int NE = 32, TOPK = 4;
constexpr int O_DT = 1536;
constexpr int NP = 2304;
constexpr int PZ = 0, PXBC = 512, PQ = 1536, PK = 2048, PV = 2176;
constexpr float EPS = 1e-5f;
constexpr int NT = 512;
constexpr int MAXROWS = T * TOPK + NE * 256;
constexpr int NPH = 12;

__constant__ int c_bucket[129] = {0, 1, 2, 3, 4, 5, 6, 7, 8, 9, 10, 11, 12, 13, 14, 15, 16, 16, 16, 17, 17, 18, 18, 18, 19, 19, 19, 20, 20, 20, 20, 21, 21, 21, 21, 22, 22, 22, 22, 22, 23, 23, 23, 23, 23, 23, 24, 24, 24, 24, 24, 24, 25, 25, 25, 25, 25, 25, 25, 26, 26, 26, 26, 26, 26, 26, 26, 27, 27, 27, 27, 27, 27, 27, 27, 27, 27, 28, 28, 28, 28, 28, 28, 28, 28, 28, 28, 29, 29, 29, 29, 29, 29, 29, 29, 29, 29, 29, 29, 30, 30, 30, 30, 30, 30, 30, 30, 30, 30, 30, 30, 30, 30, 31, 31, 31, 31, 31, 31, 31, 31, 31, 31, 31, 31, 31, 31, 31, 31};

constexpr size_t MiB = 1ull << 20;
constexpr size_t WS_CTL = 0, CTL_ZERO_BYTES = 1 * MiB;
constexpr int CW_BAR = 4096;
static_assert((CW_BAR + 3 * 3456) * 4 <= 65536, "control words inside the per-call memset");
constexpr size_t WS_WIN = 1 * MiB;
constexpr size_t WS_WOUT = WS_WIN + (size_t)NP * DM * 2;
constexpr size_t WS_W1 = WS_WOUT + (size_t)DM * DM * 2;
constexpr size_t WS_W2 = WS_W1 + (size_t)NE * 2048 * 1024 * 2;
constexpr size_t WS_U = WS_W2 + (size_t)NE * 1024 * 1024 * 2;
constexpr size_t WS_DTRAW = WS_U + (size_t)T * DM * 2;
constexpr size_t WS_PROJ = WS_DTRAW + (size_t)T * 8 * 4;
constexpr size_t WS_XC = WS_PROJ + (size_t)T * NP * 2;
constexpr size_t WS_DT = WS_XC + (size_t)T * 1024 * 4;
constexpr size_t WS_ACUM = WS_DT + (size_t)T * 8 * 4;
constexpr size_t WS_CDEC = WS_ACUM + (size_t)T * 8 * 4;
constexpr size_t WS_STATES = WS_CDEC + 1 * MiB;
constexpr size_t WS_PREV = WS_STATES + (size_t)BATCH * NCH * 8 * 8192 * 4;
constexpr size_t WS_YG = WS_PREV + (size_t)BATCH * NCH * 8 * 8192 * 4;
constexpr size_t WS_YGB = WS_YG;
constexpr size_t WS_SSSD = WS_YG + (size_t)T * 512 * 2;
constexpr size_t WS_AO = WS_YG + (size_t)T * 512 * 4;
constexpr size_t WS_SSAT = WS_AO + (size_t)T * 512 * 2;
constexpr size_t WS_CAT = WS_SSAT + (size_t)T * 8 * 4;
constexpr size_t WS_H = WS_CAT + (size_t)T * DM * 2;
constexpr size_t WS_U2 = WS_H + (size_t)T * DM * 4;
constexpr size_t WS_TOKE = WS_U2 + (size_t)T * DM * 2;
constexpr size_t WS_TOKS = WS_TOKE + (size_t)T * 4 * 4;
constexpr size_t WS_LTOK = WS_TOKS + (size_t)T * 4 * 4;
constexpr size_t WS_LGATE = WS_LTOK + (size_t)NE * T * 4;
constexpr size_t WS_ACT = WS_LGATE + (size_t)NE * T * 4;
constexpr size_t WS_YS = WS_ACT + (size_t)MAXROWS * 1024 * 2;
constexpr size_t WS_END = WS_YS + (size_t)MAXROWS * 1024 * 2;
static_assert(WS_END <= 1024 * MiB, "workspace");

constexpr int SCR_BYTES = 143360;
constexpr int TAB_OFF = SCR_BYTES;
constexpr int TB_CNT = TAB_OFF, TB_PTILE = TAB_OFF + 128, TB_RE = TAB_OFF + 272, TB_TSTART = TAB_OFF + 400, TB_MISC = TAB_OFF + 544, TB_UNITS = TAB_OFF + 576, TB_ROWTAB = TAB_OFF + 1024;
constexpr int XBW_OFF = TB_ROWTAB + 9 * 256 * 4;
constexpr int LDS_BYTES = 163840;
static_assert(XBW_OFF + 16 <= LDS_BYTES && XBW_OFF % 16 == 0, "LDS map");

#define GAS __attribute__((address_space(1)))
#define LAS __attribute__((address_space(3)))
typedef unsigned short bf16;
typedef unsigned v4u __attribute__((ext_vector_type(4)));
#define LDS_WAIT() asm volatile("s_waitcnt lgkmcnt(0)" ::: "memory")
#define VM_WAIT() asm volatile("s_waitcnt vmcnt(0)" ::: "memory")
__device__ __forceinline__ unsigned f2bf(float f) { unsigned u = __builtin_bit_cast(unsigned, f); return (u + 0x7fffu + ((u >> 16) & 1u)) >> 16; }
__device__ __forceinline__ unsigned pk2(float lo, float hi) { return f2bf(lo) | (f2bf(hi) << 16); }
__device__ __forceinline__ float bf2f(unsigned short b) { return __uint_as_float((unsigned)b << 16); }
__device__ __forceinline__ float bflo(unsigned w) { return __uint_as_float(w << 16); }
__device__ __forceinline__ float bfhi(unsigned w) { return __uint_as_float(w & 0xffff0000u); }

namespace pg8 {
#define PG8_LAS __attribute__((address_space(3)))
typedef unsigned short bf16_t;
typedef short bf16x8 __attribute__((ext_vector_type(8)));
typedef float f32x4 __attribute__((ext_vector_type(4)));
typedef unsigned u32x4 __attribute__((ext_vector_type(4)));
typedef unsigned u32x2 __attribute__((ext_vector_type(2)));
typedef int i32x8 __attribute__((ext_vector_type(8)));
typedef int i32x4 __attribute__((ext_vector_type(4)));
constexpr int BM = 256, BK = 64, HALF = 128, HTB = HALF * BK * 2  , STAGE_BYTES = 8 * HTB, NXCD = 8, WGM = 8;

__host__ __device__ __forceinline__ int lds_byte(int r, int c) { const int st = (r >> 4) * 2 + (c >> 5), rr = r & 15, cc = c & 31, ob = rr * 64 + cc * 2; return st * 1024 + (ob ^ (((ob >> 9) & 1) << 5)); }
__host__ __device__ __forceinline__ void stage_rc(int b, int& R, int& C) { const int st = b / 1024, sb = b % 1024, swz = sb ^ (((sb >> 9) & 1) << 5); R = (st >> 1) * 16 + swz / 64; C = (st & 1) * 32 + (swz % 64) / 2; }
__host__ __device__ __forceinline__ int perm32(int rho) { const int n = rho >> 4, i = rho & 15; return 8 * (i >> 2) + 4 * n + (i & 3); }

struct Unit { int pm, pn, rid; };
struct Gemm { const bf16_t* A; const bf16_t* Bt; int M, N, K; };

struct StaticOrder {
    int nM, nN, nwg, G, c;
    __host__ __device__ __forceinline__ void init(int M, int N, int G_, int c_) { nM = M / BM; nN = N / BM; nwg = nM * nN; G = G_; c = c_; }
    __host__ __device__ __forceinline__ bool next(int i, Unit& u) const {
        const long L = (long)i * G + c; if (L >= nwg) return false;
        int wgid = (int)L; { const int q = nwg / NXCD, r = nwg % NXCD, xcd = wgid % NXCD, off = wgid / NXCD; wgid = (xcd < r ? xcd * (q + 1) : r * (q + 1) + (xcd - r) * q) + off; }
        const int nig = WGM * nN, gid = wgid / nig, fm = gid * WGM, gsz = (nM - fm) < WGM ? (nM - fm) : WGM;
        u.pm = fm + ((wgid % nig) % gsz); u.pn = (wgid % nig) / gsz; u.rid = 0; return true;
    }
    __device__ __forceinline__ void a_ready(const Unit&) const {}
    __device__ __forceinline__ void done(const Unit&) const {}
};


typedef float f32x2 __attribute__((ext_vector_type(2)));
__device__ __forceinline__ unsigned cvt_pk_bf16(float lo, float hi) { unsigned r; asm volatile("v_cvt_pk_bf16_f32 %0, %1, %2" : "=v"(r) : "v"(lo), "v"(hi)); return r; }

struct EpiStoreBf16 {
    static constexpr bool PERM = true, AFTER_DRAIN = false, HAS_MID = false;
    bf16_t* O; int ldc;
    __device__ __forceinline__ void operator()(const f32x4 (&acc)[2][2][4][2], const Unit& u, int wr, int wc, int fr, int fq) const {
        const int row0 = u.pm * BM + wr * 64 + fr, col0 = u.pn * BM + wc * 32 + 8 * fq;
#pragma unroll
        for (int ai = 0; ai < 2; ++ai)
#pragma unroll
            for (int m = 0; m < 4; ++m) { bf16_t* rowp = O + (size_t)(row0 + ai * HALF + m * 16) * ldc + col0;
#pragma unroll
                for (int bj = 0; bj < 2; ++bj) { const f32x4 v0 = acc[ai][bj][m][0], v1 = acc[ai][bj][m][1];
                    u32x4 w; w.x = cvt_pk_bf16(v0[0], v0[1]); w.y = cvt_pk_bf16(v0[2], v0[3]); w.z = cvt_pk_bf16(v1[0], v1[1]); w.w = cvt_pk_bf16(v1[2], v1[3]);
                    *(u32x4*)(rowp + bj * HALF) = w; } }
    }
};
struct EpiResF32 {
    static constexpr bool PERM = false, AFTER_DRAIN = false, HAS_MID = false;
    const float* __restrict__ base; float* __restrict__ C; int ldc;
    __device__ __forceinline__ void operator()(const f32x4 (&acc)[2][2][4][2], const Unit& u, int wr, int wc, int fr, int fq) const {
        const int row0 = u.pm * BM + wr * 64 + fr, col0 = u.pn * BM + wc * 32 + 4 * fq;
#pragma unroll
        for (int ai = 0; ai < 2; ++ai)
#pragma unroll
            for (int m = 0; m < 4; ++m) { const size_t off = (size_t)(row0 + ai * HALF + m * 16) * ldc + col0; f32x4 bs[2][2];
#pragma unroll
                for (int bj = 0; bj < 2; ++bj)
#pragma unroll
                    for (int n = 0; n < 2; ++n) bs[bj][n] = __builtin_nontemporal_load((const f32x4*)(base + off + bj * HALF + n * 16));
#pragma unroll
                for (int bj = 0; bj < 2; ++bj)
#pragma unroll
                    for (int n = 0; n < 2; ++n) *(f32x4*)(C + off + bj * HALF + n * 16) = bs[bj][n] + acc[ai][bj][m][n]; }
    }
};
struct EpiResScale {
    static constexpr bool PERM = true, AFTER_DRAIN = false, HAS_MID = true;
    bf16_t* D; int ldc; const PG8_LAS float* r1; const PG8_LAS float* r2;
    __device__ __forceinline__ void mid(f32x4 (&acc)[2][2][4][2], const Unit&, int wr, int, int fr, int) const {
#pragma unroll
        for (int ai = 0; ai < 2; ++ai)
#pragma unroll
            for (int m = 0; m < 4; ++m) { const int rl = ai * HALF + wr * 64 + m * 16 + fr; const float f = r1[rl] / r2[rl];
#pragma unroll
                for (int bj = 0; bj < 2; ++bj)
#pragma unroll
                    for (int n = 0; n < 2; ++n) acc[ai][bj][m][n] *= f; }
    }
    __device__ __forceinline__ void operator()(const f32x4 (&acc)[2][2][4][2], const Unit& u, int wr, int wc, int fr, int fq) const {
        const int row0 = u.pm * BM + wr * 64 + fr, col0 = u.pn * BM + wc * 32 + 8 * fq;
#pragma unroll
        for (int ai = 0; ai < 2; ++ai)
#pragma unroll
            for (int m = 0; m < 4; ++m) { bf16_t* rowp = D + (size_t)(row0 + ai * HALF + m * 16) * ldc + col0; const float f = r2[ai * HALF + wr * 64 + m * 16 + fr];
#pragma unroll
                for (int bj = 0; bj < 2; ++bj) { const f32x4 v0 = acc[ai][bj][m][0] * f, v1 = acc[ai][bj][m][1] * f;
                    u32x4 w; w.x = cvt_pk_bf16(v0[0], v0[1]); w.y = cvt_pk_bf16(v0[2], v0[3]); w.z = cvt_pk_bf16(v1[0], v1[1]); w.w = cvt_pk_bf16(v1[2], v1[3]);
                    *(u32x4*)(rowp + bj * HALF) = w; } }
    }
};
struct EpiSwiglu {
    static constexpr bool PERM = true, AFTER_DRAIN = false, HAS_MID = false;
    unsigned char* act; const PG8_LAS float* btab; float dq, asc;
    __device__ __forceinline__ void operator()(const f32x4 (&acc)[2][2][4][2], const Unit& u, int wr, int wc, int fr, int fq) const {
        const int e = u.pn >> 3, ct = u.pn & 7, colo = ct * 128 + wc * 32 + 8 * fq;
        const PG8_LAS float* bg = btab + u.rid * 256 + wc * 32 + 8 * fq; (void)e;
        const f32x4 g0 = *(const PG8_LAS f32x4*)bg, g1 = *(const PG8_LAS f32x4*)(bg + 4), l0 = *(const PG8_LAS f32x4*)(bg + 128), l1 = *(const PG8_LAS f32x4*)(bg + 132);
        const int row0 = u.pm * BM + wr * 64 + fr;
#pragma unroll
        for (int ai = 0; ai < 2; ++ai)
#pragma unroll
            for (int m = 0; m < 4; ++m) {
                const f32x4 xg[2] = {acc[ai][0][m][0] * dq + g0, acc[ai][0][m][1] * dq + g1}; const f32x4 xl[2] = {acc[ai][1][m][0] * dq + l0, acc[ai][1][m][1] * dq + l1};
                float o[8];
#pragma unroll
                for (int q = 0; q < 4; ++q) {
                    f32x2 a2 = {xg[q >> 1][2 * (q & 1)], xg[q >> 1][2 * (q & 1) + 1]}, b2 = {xl[q >> 1][2 * (q & 1)], xl[q >> 1][2 * (q & 1) + 1]};
                    a2 = __builtin_elementwise_min(a2, (f32x2){7.f, 7.f}); b2 = __builtin_elementwise_min(__builtin_elementwise_max(b2, (f32x2){-7.f, -7.f}), (f32x2){7.f, 7.f});
                    const f32x2 t2 = a2 * (-1.702f * 1.4426950408889634f); f32x2 e2; e2.x = __builtin_amdgcn_exp2f(t2.x); e2.y = __builtin_amdgcn_exp2f(t2.y);
                    const f32x2 d2 = e2 + 1.f; f32x2 r2; r2.x = __builtin_amdgcn_rcpf(d2.x); r2.y = __builtin_amdgcn_rcpf(d2.y);
                    const f32x2 o2 = (a2 * r2) * (b2 * asc + asc); o[2 * q] = o2.x; o[2 * q + 1] = o2.y; }
                int w0 = 0, w1 = 0; w0 = __builtin_amdgcn_cvt_pk_fp8_f32(o[0], o[1], w0, false); w0 = __builtin_amdgcn_cvt_pk_fp8_f32(o[2], o[3], w0, true);
                w1 = __builtin_amdgcn_cvt_pk_fp8_f32(o[4], o[5], w1, false); w1 = __builtin_amdgcn_cvt_pk_fp8_f32(o[6], o[7], w1, true);
                u32x2 w; w.x = (unsigned)w0; w.y = (unsigned)w1;
                *(u32x2*)(act + (size_t)(row0 + ai * HALF + m * 16) * 1024 + colo) = w; }
    }
};
struct EpiMoe2 {
    static constexpr bool PERM = true, AFTER_DRAIN = false, HAS_MID = false;
    unsigned char* ys; const PG8_LAS float* btab; const PG8_LAS float* gtab; float dq, ysc;
    __device__ __forceinline__ void operator()(const f32x4 (&acc)[2][2][4][2], const Unit& u, int wr, int wc, int fr, int fq) const {
        const int e = u.pn >> 2, ct = u.pn & 3, colb = ct * 256 + wc * 32 + 8 * fq;
        (void)e;
        f32x4 bv[2][2];
#pragma unroll
        for (int bj = 0; bj < 2; ++bj)
#pragma unroll
            for (int n = 0; n < 2; ++n) bv[bj][n] = *(const PG8_LAS f32x4*)(btab + u.rid * 256 + bj * HALF + wc * 32 + 8 * fq + 4 * n);
        const int row0 = u.pm * BM + wr * 64 + fr;
#pragma unroll
        for (int ai = 0; ai < 2; ++ai)
#pragma unroll
            for (int m = 0; m < 4; ++m) { const float gt = gtab[u.rid * 256 + ai * HALF + wr * 64 + m * 16 + fr] * ysc;
                unsigned char* rowp = ys + (size_t)(row0 + ai * HALF + m * 16) * 1024 + colb;
#pragma unroll
                for (int bj = 0; bj < 2; ++bj) { f32x4 v0 = (acc[ai][bj][m][0] * dq + bv[bj][0]) * gt, v1 = (acc[ai][bj][m][1] * dq + bv[bj][1]) * gt;
                    v0 = __builtin_elementwise_min(__builtin_elementwise_max(v0, (f32x4){-440.f, -440.f, -440.f, -440.f}), (f32x4){440.f, 440.f, 440.f, 440.f});
                    v1 = __builtin_elementwise_min(__builtin_elementwise_max(v1, (f32x4){-440.f, -440.f, -440.f, -440.f}), (f32x4){440.f, 440.f, 440.f, 440.f});
                    int w0 = 0, w1 = 0; w0 = __builtin_amdgcn_cvt_pk_fp8_f32(v0[0], v0[1], w0, false); w0 = __builtin_amdgcn_cvt_pk_fp8_f32(v0[2], v0[3], w0, true);
                    w1 = __builtin_amdgcn_cvt_pk_fp8_f32(v1[0], v1[1], w1, false); w1 = __builtin_amdgcn_cvt_pk_fp8_f32(v1[2], v1[3], w1, true);
                    u32x2 w; w.x = (unsigned)w0; w.y = (unsigned)w1; *(u32x2*)(rowp + bj * HALF) = w; } }
    }
};
struct MoeOrder {
    const PG8_LAS int* units; const PG8_LAS unsigned* rowtab; int nr;
    __device__ __forceinline__ bool next(int i, Unit& u) const {
        if (i >= nr) return false;
        const int pm = __builtin_amdgcn_readfirstlane(units[2 * i]); if (pm < 0) return false;
        u.pm = pm; u.pn = __builtin_amdgcn_readfirstlane(units[2 * i + 1]); u.rid = i; return true;
    }
    __device__ __forceinline__ unsigned arow(const Unit& u, int r) const { return rowtab[u.rid * 256 + r]; }
    __device__ __forceinline__ void a_ready(const Unit&) const {}
    __device__ __forceinline__ void done(const Unit&) const {}
};

template <class Epi, class Sched, bool ALIGN_EPI = false, bool SP2 = false, bool GATHER = false, bool FP8 = false>
__device__ __forceinline__ void gemm_phase(PG8_LAS unsigned char* lds, const Gemm g, const Sched& S, const Epi& E) {
    const int tid = threadIdx.x, wid = __builtin_amdgcn_readfirstlane(tid >> 6), lane = tid & 63, wr = wid >> 2, wc = wid & 3, fr = lane & 15, fq = lane >> 4;
    const int K = g.K, nt = K / BK;
    unsigned voffA[2], voffB[2];
#pragma unroll
    for (int i = 0; i < 2; ++i) { int R, C; stage_rc(tid * 16 + i * 8192, R, C); const int Rb = Epi::PERM ? ((R & ~31) + perm32(R & 31)) : R;
        voffA[i] = (unsigned)(R * K + C) * 2u; voffB[i] = (unsigned)(Rb * K + C) * 2u; }
    const size_t kstep = (size_t)(BK * 2);
    const size_t hstep = (size_t)HALF * K * 2;
    const size_t tstep = 2 * hstep;
    const unsigned ldsw = (unsigned)wid * 1024u;
    const int aoff = lds_byte(wr * 64 + fr, fq * 8), boff = lds_byte(wc * 32 + fr, fq * 8);
#define PG8_SA(b, h) (((b) * 2 + (h)) * HTB)
#define PG8_SB(b, h) ((4 + (b) * 2 + (h)) * HTB)
#define PG8_STAGE(bufoff, gbase, voff) do { _Pragma("unroll") for (int _i = 0; _i < 2; ++_i) \
        __builtin_amdgcn_global_load_lds((const unsigned*)((const char*)(gbase) + (voff)[_i]), (PG8_LAS unsigned*)(lds + (bufoff) + ldsw + _i * 8192), 16, 0, 0); } while (0)
#define PG8_STAGE_A(b, h, U, koff) do { if constexpr (GATHER) { PG8_STAGE(PG8_SA(b, h), Ab + (koff), c_ao[h]); } else { PG8_STAGE(PG8_SA(b, h), U##_A + (size_t)(h) * hstep + (koff), voffA); } } while (0)
#define PG8_LDA(dst, b, h) do { _Pragma("unroll") for (int m = 0; m < 4; ++m) _Pragma("unroll") for (int k = 0; k < 2; ++k) dst[m][k] = *(const PG8_LAS bf16x8*)(lds + PG8_SA(b, h) + aoff + m * 2048 + k * 1024); } while (0)
#define PG8_LDB(dst, b, h) do { _Pragma("unroll") for (int n = 0; n < 2; ++n) _Pragma("unroll") for (int k = 0; k < 2; ++k) dst[n][k] = *(const PG8_LAS bf16x8*)(lds + PG8_SB(b, h) + boff + n * 2048 + k * 1024); } while (0)
#define PG8_MMA(ai, bj, At, Bt) do { __builtin_amdgcn_s_setprio(1); _Pragma("unroll") for (int m = 0; m < 4; ++m) _Pragma("unroll") for (int n = 0; n < 2; ++n) { \
        if constexpr (FP8) { const i32x8 ub_ = __builtin_shufflevector(__builtin_bit_cast(i32x4, Bt[n][0]), __builtin_bit_cast(i32x4, Bt[n][1]), 0, 1, 2, 3, 4, 5, 6, 7); \
            const i32x8 ua_ = __builtin_shufflevector(__builtin_bit_cast(i32x4, At[m][0]), __builtin_bit_cast(i32x4, At[m][1]), 0, 1, 2, 3, 4, 5, 6, 7); \
            acc[ai][bj][m][n] = __builtin_amdgcn_mfma_scale_f32_16x16x128_f8f6f4(ub_, ua_, acc[ai][bj][m][n], 0, 0, 0, 0x7f7f7f7f, 0, 0x7f7f7f7f); } \
        else { _Pragma("unroll") for (int k = 0; k < 2; ++k) acc[ai][bj][m][n] = __builtin_amdgcn_mfma_f32_16x16x32_bf16(Bt[n][k], At[m][k], acc[ai][bj][m][n], 0, 0, 0); } } \
        __builtin_amdgcn_s_setprio(0); } while (0)
#define PG8_WAIT_V(n) asm volatile("s_waitcnt vmcnt(" #n ")" ::: "memory")
#define PG8_WAIT_L(n) asm volatile("s_waitcnt lgkmcnt(" #n ")" ::: "memory")
#define PG8_BAR __builtin_amdgcn_s_barrier()
#define PG8_SCHED __builtin_amdgcn_sched_barrier(0)
    Unit cur, nxt; int ui = 0;
    if (!S.next(0, cur)) return;
    f32x4 acc[2][2][4][2];
#pragma unroll
    for (int a = 0; a < 2; ++a)
#pragma unroll
        for (int b = 0; b < 2; ++b)
#pragma unroll
            for (int m = 0; m < 4; ++m)
#pragma unroll
                for (int n = 0; n < 2; ++n) acc[a][b][m][n] = (f32x4){0.f, 0.f, 0.f, 0.f};
    bf16x8 At[4][2], B0[2][2], B1[2][2];
    const char* const Ab = (const char*)g.A; (void)Ab;
    unsigned c_ao[2][2] = {{0u, 0u}, {0u, 0u}}; (void)c_ao;
    int RA0, CA0; stage_rc(tid * 16, RA0, CA0);
    const char* c_A = (const char*)g.A + (size_t)cur.pm * tstep; const char* cB = (const char*)g.Bt + (size_t)cur.pn * tstep;
    if constexpr (GATHER) { _Pragma("unroll") for (int h_ = 0; h_ < 2; ++h_) _Pragma("unroll") for (int i_ = 0; i_ < 2; ++i_) c_ao[h_][i_] = S.arow(cur, h_ * HALF + RA0 + i_ * 64) + (unsigned)CA0 * 2u; }
    S.a_ready(cur);
    if constexpr (SP2) {
        PG8_STAGE(PG8_SB(0, 0), cB, voffB); PG8_STAGE(PG8_SB(0, 1), cB + hstep, voffB); PG8_STAGE_A(0, 0, c, (size_t)0); PG8_STAGE_A(0, 1, c, (size_t)0);
        if (wr == 1) PG8_BAR;
        PG8_WAIT_V(2); PG8_BAR;
        PG8_STAGE(PG8_SB(1, 0), cB + kstep, voffB); PG8_STAGE_A(1, 0, c, kstep); PG8_STAGE(PG8_SB(1, 1), cB + hstep + kstep, voffB);
        PG8_WAIT_V(6); PG8_BAR;
    } else {
        PG8_STAGE(PG8_SB(0, 0), cB, voffB); PG8_STAGE_A(0, 0, c, (size_t)0); PG8_STAGE(PG8_SB(0, 1), cB + hstep, voffB); PG8_STAGE_A(0, 1, c, (size_t)0);
        if (wr == 1) PG8_BAR;
        PG8_WAIT_V(4); PG8_BAR;
        PG8_STAGE(PG8_SB(1, 0), cB + kstep, voffB); PG8_STAGE_A(1, 0, c, kstep); PG8_STAGE(PG8_SB(1, 1), cB + hstep + kstep, voffB);
        PG8_WAIT_V(6); PG8_BAR;
    }
    for (;;) {
        const bool has_next = S.next(ui + 1, nxt);
        const char* n_A = has_next ? (const char*)g.A + (size_t)nxt.pm * tstep : c_A; const char* nB = has_next ? (const char*)g.Bt + (size_t)nxt.pn * tstep : cB;
#pragma unroll 1
        for (int t = 0; t < nt; t += 2) {
            const bool last = (t == nt - 2);
            if constexpr (Epi::HAS_MID) { if (t == (nt >> 1)) E.mid(acc, cur, wr, wc, fr, fq); }
            const char* s_A = last ? n_A : c_A; const size_t k2 = last ? (size_t)0 : (size_t)(t + 2) * kstep; const char* b2 = last ? nB : cB + (size_t)(t + 2) * kstep;
            const char* b3 = b2 + kstep; (void)s_A;
            if (last && has_next) S.a_ready(nxt);
            if constexpr (SP2) {
            PG8_LDB(B0, 0, 0); PG8_LDB(B1, 0, 1); PG8_SCHED; PG8_LDA(At, 0, 0); PG8_STAGE_A(1, 1, c, (size_t)(t + 1) * kstep); if constexpr (GATHER) { if (last && has_next) { _Pragma("unroll") for (int h_ = 0; h_ < 2; ++h_) _Pragma("unroll") for (int i_ = 0; i_ < 2; ++i_) c_ao[h_][i_] = S.arow(nxt, h_ * HALF + RA0 + i_ * 64) + (unsigned)CA0 * 2u; } }
            PG8_WAIT_V(8); PG8_WAIT_L(0); PG8_BAR; PG8_MMA(0, 0, At, B0); PG8_MMA(0, 1, At, B1); PG8_BAR; PG8_SCHED;
            PG8_LDA(At, 0, 1); PG8_STAGE(PG8_SB(0, 0), b2, voffB); PG8_STAGE(PG8_SB(0, 1), b2 + hstep, voffB); PG8_STAGE_A(0, 0, s, k2);
            PG8_WAIT_V(8); PG8_WAIT_L(0); PG8_BAR; PG8_MMA(1, 0, At, B0); PG8_MMA(1, 1, At, B1); PG8_BAR; PG8_SCHED;
            PG8_LDB(B0, 1, 0); PG8_LDB(B1, 1, 1); PG8_SCHED; PG8_LDA(At, 1, 0); PG8_STAGE_A(0, 1, s, k2);
            PG8_WAIT_V(8); PG8_WAIT_L(0); PG8_BAR; PG8_MMA(0, 0, At, B0); PG8_MMA(0, 1, At, B1); PG8_BAR; PG8_SCHED;
            PG8_LDA(At, 1, 1); PG8_STAGE(PG8_SB(1, 0), b3, voffB); PG8_STAGE(PG8_SB(1, 1), b3 + hstep, voffB); PG8_STAGE_A(1, 0, s, k2 + kstep);
            PG8_WAIT_V(8); PG8_WAIT_L(0); PG8_BAR; PG8_MMA(1, 0, At, B0); PG8_MMA(1, 1, At, B1); PG8_BAR; PG8_SCHED;
            } else {
            PG8_LDB(B0, 0, 0); PG8_SCHED; PG8_LDA(At, 0, 0); PG8_STAGE_A(1, 1, c, (size_t)(t + 1) * kstep); if constexpr (GATHER) { if (last && has_next) { _Pragma("unroll") for (int h_ = 0; h_ < 2; ++h_) _Pragma("unroll") for (int i_ = 0; i_ < 2; ++i_) c_ao[h_][i_] = S.arow(nxt, h_ * HALF + RA0 + i_ * 64) + (unsigned)CA0 * 2u; } }
            PG8_WAIT_L(8); PG8_BAR; PG8_WAIT_L(0); PG8_MMA(0, 0, At, B0); PG8_BAR; PG8_SCHED;
            PG8_LDB(B1, 0, 1); PG8_STAGE(PG8_SB(0, 0), b2, voffB);
            PG8_BAR; PG8_WAIT_L(0); PG8_MMA(0, 1, At, B1); PG8_BAR;
            PG8_LDA(At, 0, 1); PG8_STAGE_A(0, 0, s, k2);
            PG8_BAR; PG8_WAIT_L(0); PG8_MMA(1, 0, At, B0); PG8_BAR; PG8_SCHED;
            PG8_STAGE(PG8_SB(0, 1), b2 + hstep, voffB);
            PG8_WAIT_V(6); PG8_BAR; PG8_MMA(1, 1, At, B1); PG8_BAR;
            PG8_LDB(B0, 1, 0); PG8_SCHED; PG8_LDA(At, 1, 0); PG8_STAGE_A(0, 1, s, k2);
            PG8_WAIT_L(8); PG8_BAR; PG8_WAIT_L(0); PG8_MMA(0, 0, At, B0); PG8_BAR; PG8_SCHED;
            PG8_LDB(B1, 1, 1); PG8_STAGE(PG8_SB(1, 0), b3, voffB);
            PG8_BAR; PG8_WAIT_L(0); PG8_MMA(0, 1, At, B1); PG8_BAR;
            PG8_LDA(At, 1, 1); PG8_STAGE_A(1, 0, s, k2 + kstep);
            PG8_BAR; PG8_WAIT_L(0); PG8_MMA(1, 0, At, B0); PG8_BAR; PG8_SCHED;
            PG8_STAGE(PG8_SB(1, 1), b3 + hstep, voffB);
            PG8_WAIT_V(6); PG8_BAR; PG8_MMA(1, 1, At, B1); PG8_BAR;
            }
        }
        if constexpr (ALIGN_EPI) { if (wr == 0) PG8_BAR; }
        if constexpr (!Epi::AFTER_DRAIN) { E(acc, cur, wr, wc, fr, fq); S.done(cur); }
        if (!has_next) break;
#pragma unroll
        for (int a = 0; a < 2; ++a)
#pragma unroll
            for (int b = 0; b < 2; ++b)
#pragma unroll
                for (int m = 0; m < 4; ++m)
#pragma unroll
                    for (int n = 0; n < 2; ++n) acc[a][b][m][n] = (f32x4){0.f, 0.f, 0.f, 0.f};
        cur = nxt; c_A = n_A; cB = nB; ++ui;
        if constexpr (ALIGN_EPI) { if (wr == 1) PG8_BAR; }
    }
    PG8_WAIT_V(0);
    if constexpr (!ALIGN_EPI) { if (wr == 0) PG8_BAR; }
    PG8_BAR;
    if constexpr (Epi::AFTER_DRAIN) { E.fused(acc, cur, wr, wc, fr, fq, lds, wid, lane); S.done(cur); }
#undef PG8_SA
#undef PG8_SB
#undef PG8_STAGE
#undef PG8_STAGE_A
#undef PG8_LDA
#undef PG8_LDB
#undef PG8_MMA
#undef PG8_WAIT_V
#undef PG8_WAIT_L
#undef PG8_BAR
#undef PG8_SCHED
}
}

#define XB_TMO      128
#define XB_XCNT(j)  (256  + 64 * (j))
#define XB_XSUB(j)  (1280 + 64 * (j))
#define XB_XGEN(j)  (2304 + 64 * (j))
#define XB_TOP      3328
#define XB_TOPGEN   3392
#define XCD_BAR_WORDS 3456
#define XB_SPIN_CAP (1u << 18)

__device__ __forceinline__ unsigned xb_ld(unsigned* p)              { return __hip_atomic_load(p, __ATOMIC_RELAXED, __HIP_MEMORY_SCOPE_AGENT); }
__device__ __forceinline__ unsigned xb_add(unsigned* p, unsigned v) { return __hip_atomic_fetch_add(p, v, __ATOMIC_RELAXED, __HIP_MEMORY_SCOPE_AGENT); }
__device__ __forceinline__ unsigned xb_xcc_id() { return (unsigned)__builtin_amdgcn_s_getreg((3 << 11) | 20) & 0xFu; }
#define XB_SPIN(cond, bar) do { unsigned _sp = 0; while (cond) { __builtin_amdgcn_s_sleep(1); \
    if ((++_sp & 255u) == 0u) { if (xb_ld(&(bar)[XB_TMO])) break; if (_sp > XB_SPIN_CAP) { atomicAdd(&(bar)[XB_TMO], 1u); break; } } } } while (0)

struct XcdBarrier {
    unsigned* bar; unsigned x;
    volatile LAS unsigned* st;
};

__device__ __forceinline__ XcdBarrier xcd_barrier_post(unsigned* bar, volatile LAS unsigned* st) {
    XcdBarrier b; b.bar = bar; b.x = xb_xcc_id(); b.st = st;
    if (threadIdx.x == 0) (void)xb_add(&bar[XB_XCNT(b.x)], 1u);
    return b;
}
__device__ __forceinline__ void xcd_barrier_complete(unsigned* bar, unsigned x, unsigned& nloc, unsigned& nx) {
    const unsigned G = gridDim.x * gridDim.y * gridDim.z;
    unsigned sum, cnt, mine, sp = 0u;
    for (;;) {
        sum = 0u; cnt = 0u; mine = 0u;
#pragma unroll
        for (unsigned j = 0; j < 16; ++j) { const unsigned c = xb_ld(&bar[XB_XCNT(j)]); sum += c; cnt += (c > 0u) ? 1u : 0u; mine = (j == x) ? c : mine; }
        if (sum == G) break;
        __builtin_amdgcn_s_sleep(1);
        if ((++sp & 255u) == 0u) { if (xb_ld(&bar[XB_TMO])) break; if (sp > XB_SPIN_CAP) { atomicAdd(&bar[XB_TMO], 1u); break; } }
    }
    nloc = mine > 0u ? mine : 1u; nx = cnt > 0u ? cnt : 1u;
}

__device__ __forceinline__ void xcd_barrier(const XcdBarrier& b) {
    asm volatile("s_waitcnt vmcnt(0)" ::: "memory");
    __syncthreads();
    if (threadIdx.x == 0) {
        unsigned* bar = b.bar;
        __builtin_amdgcn_s_waitcnt(0);
        unsigned nloc = b.st[0], nx = b.st[1];
        if (nloc == 0u) { xcd_barrier_complete(bar, b.x, nloc, nx); b.st[0] = nloc; b.st[1] = nx; }
        const unsigned old = xb_add(&bar[XB_XSUB(b.x)], 1u);
        const unsigned gen = old / nloc;
        if (old + 1u == (gen + 1u) * nloc) {
            __builtin_amdgcn_fence(__ATOMIC_RELEASE, "agent");
            asm volatile("s_waitcnt vmcnt(0)" ::: "memory");
            const unsigned og = xb_add(&bar[XB_TOP], 1u);
            const unsigned tg = og / nx;
            if (og + 1u == (tg + 1u) * nx) xb_add(&bar[XB_TOPGEN], 1u);
            else XB_SPIN(xb_ld(&bar[XB_TOPGEN]) == tg, bar);
            __builtin_amdgcn_fence(__ATOMIC_ACQUIRE, "agent");
            xb_add(&bar[XB_XGEN(b.x)], 1u);
            asm volatile("s_waitcnt vmcnt(0)" ::: "memory");
        } else {
            XB_SPIN(xb_ld(&bar[XB_XGEN(b.x)]) == gen, bar);
            __builtin_amdgcn_fence(__ATOMIC_ACQUIRE, "agent");
            asm volatile("s_waitcnt vmcnt(0)" ::: "memory");
        }
    }
    __syncthreads();
}

typedef short bf16x8 __attribute__((ext_vector_type(8)));
typedef float f32x16 __attribute__((ext_vector_type(16)));
typedef float f32x4v __attribute__((ext_vector_type(4)));
typedef unsigned u32x2v __attribute__((ext_vector_type(2)));
struct Args { const float* in[21]; float* out; unsigned char* ws; int ph_lo, ph_hi, bar_sel, pad; };

__device__ __forceinline__ float wave_sum(float v) {
#pragma unroll
    for (int o = 1; o < 64; o <<= 1) v += __shfl_xor(v, o);
    return v;
}
__device__ __forceinline__ float wave_max(float v) {
#pragma unroll
    for (int o = 1; o < 64; o <<= 1) v = fmaxf(v, __shfl_xor(v, o));
    return v;
}
__device__ __forceinline__ float silu_f(float x) { return x / (1.f + __expf(-x)); }

template <bool GAIN>
__device__ __forceinline__ void cvt_item(const float* W, int ldw, int n0src, bf16* WT, int K, int drow0, int k0, LAS float* scr, int lane, const float* gk = nullptr) {
#pragma unroll 16
    for (int i = 0; i < 32; ++i) { const int kk = 2 * i + (lane >> 5); float v = W[(size_t)(k0 + kk) * ldw + n0src + (lane & 31)]; if (GAIN) v *= gk[kk]; scr[kk * 33 + (lane & 31)] = v; }
    LDS_WAIT(); asm volatile("" ::: "memory");
    const int c = lane & 7;
#pragma unroll
    for (int j = 0; j < 4; ++j) { const int n = (lane >> 3) + 8 * j; const LAS float* s = scr + (8 * c) * 33 + n;
        v4u o; o.x = pk2(s[0 * 33], s[1 * 33]); o.y = pk2(s[2 * 33], s[3 * 33]); o.z = pk2(s[4 * 33], s[5 * 33]); o.w = pk2(s[6 * 33], s[7 * 33]);
        *(GAS v4u*)(WT + (size_t)(drow0 + n) * K + k0 + 8 * c) = o; }
    LDS_WAIT(); asm volatile("" ::: "memory");
}
constexpr float W8_SCALE = 64.f, ACT8_SCALE = 4.f, YS8_SCALE = 16.f;
__device__ __forceinline__ unsigned pk4_fp8(float a, float b, float c, float d) { int w = 0; w = __builtin_amdgcn_cvt_pk_fp8_f32(a, b, w, false); w = __builtin_amdgcn_cvt_pk_fp8_f32(c, d, w, true); return (unsigned)w; }
__device__ __forceinline__ void cvt_item_fp8(const float* W, int ldw, int n0src, unsigned char* WT, int K, int drow0, int k0, LAS float* scr, int lane) {
#pragma unroll 16
    for (int i = 0; i < 32; ++i) { const int kk = 2 * i + (lane >> 5); scr[kk * 33 + (lane & 31)] = W[(size_t)(k0 + kk) * ldw + n0src + (lane & 31)] * W8_SCALE; }
    LDS_WAIT(); asm volatile("" ::: "memory");
    const int c = lane & 3;
#pragma unroll
    for (int j = 0; j < 2; ++j) { const int n = (lane >> 2) + 16 * j; const LAS float* s = scr + (16 * c) * 33 + n;
        v4u o; o.x = pk4_fp8(s[0 * 33], s[1 * 33], s[2 * 33], s[3 * 33]); o.y = pk4_fp8(s[4 * 33], s[5 * 33], s[6 * 33], s[7 * 33]);
        o.z = pk4_fp8(s[8 * 33], s[9 * 33], s[10 * 33], s[11 * 33]); o.w = pk4_fp8(s[12 * 33], s[13 * 33], s[14 * 33], s[15 * 33]);
        *(GAS v4u*)(WT + (size_t)(drow0 + n) * K + k0 + 16 * c) = o; }
    LDS_WAIT(); asm volatile("" ::: "memory");
}
__device__ __forceinline__ void ph_prologue(const Args& a, LAS unsigned char* lds, int bid, int nb) {
    const int tid = threadIdx.x, lane = tid & 63, wave = tid >> 6;
    unsigned char* ws = a.ws;
    LAS float* scr = (LAS float*)(lds + wave * 16384);
    const int gw = bid * 8 + wave, ngw = nb * 8;
    constexpr int I_IN = 16 * 72, I_OUT = 16 * 32;
    for (int it0 = gw; it0 < I_IN + I_OUT; it0 += ngw) {
        int it = it0;
        if (it < I_IN) { const int kb = it / 72, d0 = 32 * (it % 72); cvt_item<false>(a.in[2], DPROJ, d0 < 1536 ? d0 : d0 + 8, (bf16*)(ws + WS_WIN), DM, d0, 64 * kb, scr, lane); continue; }
        it -= I_IN;
        { const int kb = it / 32, d0 = 32 * (it % 32); cvt_item<true>(a.in[12], DM, d0, (bf16*)(ws + WS_WOUT), DM, d0, 64 * kb, scr, lane, (kb < 8 ? a.in[8] : a.in[11] - 512) + 64 * kb); }
    }
    __syncthreads();
    LAS float* wdt = (LAS float*)lds;
    for (int i = tid; i < 1024 * 8; i += NT) wdt[i] = a.in[2][(size_t)(i >> 3) * DPROJ + O_DT + (i & 7)];
    __syncthreads();
    const float* x = a.in[0]; const float* g = a.in[1]; bf16* u = (bf16*)(ws + WS_U); float* dtraw = (float*)(ws + WS_DTRAW);
    for (int r0 = gw; r0 < T; r0 += 2 * ngw) {
        float4 vv[2][4];
#pragma unroll
        for (int q = 0; q < 2; ++q) { const int r = r0 + q * ngw; if (r < T) { const float4* xr = (const float4*)(x + (size_t)r * DM);
#pragma unroll
            for (int j = 0; j < 4; ++j) vv[q][j] = xr[lane + 64 * j]; } }
#pragma unroll
        for (int q = 0; q < 2; ++q) { const int r = r0 + q * ngw; if (r < T) {
        float4 (&v)[4] = vv[q]; float s = 0.f;
#pragma unroll
        for (int j = 0; j < 4; ++j) s += v[j].x * v[j].x + v[j].y * v[j].y + v[j].z * v[j].z + v[j].w * v[j].w;
        const float rs = rsqrtf(wave_sum(s) * (1.f / DM) + EPS);
        float dacc[8];
#pragma unroll
        for (int h = 0; h < 8; ++h) dacc[h] = 0.f;
#pragma unroll
        for (int j = 0; j < 4; ++j) { const float4 gg = ((const float4*)g)[lane + 64 * j];
            const float un[4] = {v[j].x * rs * gg.x, v[j].y * rs * gg.y, v[j].z * rs * gg.z, v[j].w * rs * gg.w};
            uint2 o; o.x = pk2(un[0], un[1]); o.y = pk2(un[2], un[3]);
            *(uint2*)(u + (size_t)r * DM + 4 * lane + 256 * j) = o;
#pragma unroll
            for (int c = 0; c < 4; ++c) { const LAS float* wd = wdt + (size_t)(4 * lane + 256 * j + c) * 8;
#pragma unroll
                for (int h = 0; h < 8; ++h) dacc[h] += un[c] * wd[h]; } }
#pragma unroll
        for (int h = 0; h < 8; ++h) dacc[h] = wave_sum(dacc[h]);
        if (lane == 0) {
#pragma unroll
            for (int h = 0; h < 8; ++h) dtraw[(size_t)r * 8 + h] = dacc[h]; }
        } }
    }
}

constexpr int CW_QHEAD = 1024;
constexpr int I_W1 = NE * 8 * 64, I_W2 = NE * 8 * 32;
struct CvtItem { const float* W; unsigned char* WT; int ldw, n0src, drow0, k0; };
__device__ __forceinline__ CvtItem moe_item(const Args& a, int it) {
    CvtItem c; unsigned char* ws = a.ws;
    if (it < I_W1) { const int e = it >> 9, r = it & 511, kb = r >> 6, d0 = 32 * (r & 63), pn = d0 >> 8, j0 = d0 & 255;
        c.W = a.in[16] + (size_t)e * 1024 * 2048; c.ldw = 2048; c.n0src = j0 < 128 ? pn * 128 + j0 : 1024 + pn * 128 + (j0 - 128); c.WT = ws + WS_W1 + (size_t)e * 2048 * 1024; c.drow0 = d0; c.k0 = 128 * kb; }
    else { it -= I_W1; const int e = it >> 8, r = it & 255, kb = r >> 5, d0 = 32 * (r & 31);
        c.W = a.in[18] + (size_t)e * 1024 * 1024; c.ldw = 1024; c.n0src = d0; c.WT = ws + WS_W2 + (size_t)e * 1024 * 1024; c.drow0 = d0; c.k0 = 128 * kb; }
    return c;
}
__device__ __forceinline__ void cvt8_load(const CvtItem& c, int lane, f32x4v (&v)[16]) {
    const float* p = c.W + (size_t)(c.k0 + 16 * (lane >> 3)) * c.ldw + c.n0src + (lane & 7) * 4;
#pragma unroll
    for (int i = 0; i < 16; ++i) v[i] = __builtin_nontemporal_load((const f32x4v*)(p + (size_t)i * c.ldw));
}
__device__ __forceinline__ void cvt8_finish(const CvtItem& c, int lane, const f32x4v (&v)[16]) {
    unsigned char* q = c.WT + (size_t)(c.drow0 + 4 * (lane & 7)) * DM + c.k0 + 16 * (lane >> 3);
#pragma unroll
    for (int cc = 0; cc < 4; ++cc) { v4u o;
        o.x = pk4_fp8(v[0][cc] * W8_SCALE, v[1][cc] * W8_SCALE, v[2][cc] * W8_SCALE, v[3][cc] * W8_SCALE); o.y = pk4_fp8(v[4][cc] * W8_SCALE, v[5][cc] * W8_SCALE, v[6][cc] * W8_SCALE, v[7][cc] * W8_SCALE);
        o.z = pk4_fp8(v[8][cc] * W8_SCALE, v[9][cc] * W8_SCALE, v[10][cc] * W8_SCALE, v[11][cc] * W8_SCALE); o.w = pk4_fp8(v[12][cc] * W8_SCALE, v[13][cc] * W8_SCALE, v[14][cc] * W8_SCALE, v[15][cc] * W8_SCALE);
        *(GAS v4u*)(q + (size_t)cc * DM) = o; }
}
constexpr int I_MOE = I_W1 + I_W2, QB8 = 4, Q_NA = I_W1 + (I_W2 / 4) * 3;
static_assert((Q_NA / 8) % QB8 == 0 && ((I_MOE - Q_NA) / 8) % QB8 == 0, "queue partitions");
template <int WHICH>
__device__ __forceinline__ void moe_weight_queue(const Args& a, LAS unsigned char* lds, int bid) {
    constexpr int BASE = WHICH ? Q_NA : 0, QPART = (WHICH ? I_MOE - Q_NA : Q_NA) / 8;
    const int tid = threadIdx.x, lane = tid & 63; (void)lds;
    unsigned* heads = (unsigned*)(a.ws + WS_CTL) + CW_QHEAD + WHICH * 512;
    for (int k = 0; k < 8; ++k) { const int part = (bid + k) & 7;
        for (;;) { unsigned b0 = 0u; if (lane == 0) b0 = atomicAdd(&heads[64 * part], (unsigned)QB8); b0 = (unsigned)__builtin_amdgcn_readfirstlane((int)b0);
            if (b0 >= (unsigned)QPART) break;
            const int base = BASE + part * QPART + (int)b0;
            f32x4v A[16], B[16];
#define QL(j, R) cvt8_load(moe_item(a, base + (j)), lane, R)
#define QF(j, R) cvt8_finish(moe_item(a, base + (j)), lane, R)
            QL(0, A); QL(1, B);
            QF(0, A); QL(2, A); QF(1, B); QL(3, B);
            QF(2, A); QF(3, B); } }
#undef QL
#undef QF
}
__device__ __forceinline__ void ph_conv(const Args& a, int bid, int nb) {
    const bf16* proj = (const bf16*)(a.ws + WS_PROJ); const float* cw = a.in[3]; const float* cb = a.in[4]; const float* dtb = a.in[5]; const float* dtraw = (const float*)(a.ws + WS_DTRAW);
    float* xc = (float*)(a.ws + WS_XC); float* dt = (float*)(a.ws + WS_DT);
    const size_t n = (size_t)T * 1024;
    for (size_t i = (size_t)bid * NT + threadIdx.x; i < n; i += (size_t)nb * NT) {
        const int t = (int)(i >> 10), c = (int)(i & 1023), s = t % SEQ;
        float v = cb[c];
#pragma unroll
        for (int k = 0; k < 4; ++k) { const int ss = s - 3 + k; if (ss >= 0) v += cw[k * 1024 + c] * bf2f(proj[(size_t)(t - 3 + k) * NP + PXBC + c]); }
        xc[i] = silu_f(v);
    }
    for (int i = bid * NT + threadIdx.x; i < T * 8; i += nb * NT) {
        const float v = dtraw[i] + dtb[i & 7];
        dt[i] = v > 20.f ? v : log1pf(__expf(v));
    }
}
__device__ __forceinline__ unsigned cvtpk(float lo, float hi) { unsigned r; asm volatile("v_cvt_pk_bf16_f32 %0, %1, %2" : "=v"(r) : "v"(lo), "v"(hi)); return r; }
__device__ __forceinline__ float silu_fast(float x) { return x * __builtin_amdgcn_rcpf(1.f + __expf(-x)); }
__device__ __forceinline__ void conv_load(const bf16* proj, int t0, int s0, int l0, int ch, unsigned (&raw)[11]) {
#pragma unroll
    for (int i = 0; i < 11; ++i) { const int l = l0 - 3 + i; unsigned wv = 0u; if (s0 + l >= 0) wv = *(const unsigned*)(proj + (size_t)(t0 + l) * NP + PXBC + ch); raw[i] = wv; }
}
__device__ __forceinline__ void conv_compute(const unsigned (&raw)[11], const float* cw, const float* cb, int ch, float (&o0)[8], float (&o1)[8]) {
    float w0[4], w1[4];
#pragma unroll
    for (int k = 0; k < 4; ++k) { const float2 wv = *(const float2*)(cw + k * 1024 + ch); w0[k] = wv.x; w1[k] = wv.y; }
    const float2 bb = *(const float2*)(cb + ch);
#pragma unroll
    for (int j = 0; j < 8; ++j) { float v0 = bb.x, v1 = bb.y;
#pragma unroll
        for (int k = 0; k < 4; ++k) { v0 += w0[k] * bflo(raw[j + k]); v1 += w1[k] * bfhi(raw[j + k]); }
        o0[j] = silu_fast(v0); o1[j] = silu_fast(v1); }
}
constexpr int SL_ST = 272, SL_XW = 0, SL_BMT = 256 * SL_ST, SL_WL = SL_BMT + 128 * SL_ST, SL_TMP = SL_WL + 2048;
__device__ __forceinline__ void ph_ssd_local(const Args& a, LAS unsigned char* lds, int bid, int nb) {
    const bf16* proj = (const bf16*)(a.ws + WS_PROJ); const float* dtraw = (const float*)(a.ws + WS_DTRAW); const float* dtb = a.in[5]; const float* alog = a.in[6];
    float* dtg = (float*)(a.ws + WS_DT); float* acum = (float*)(a.ws + WS_ACUM); float* cdec = (float*)(a.ws + WS_CDEC); float* states = (float*)(a.ws + WS_STATES);
    const int tid = threadIdx.x, lane = tid & 63, w = tid >> 6;
    LAS unsigned char* XW = lds + SL_XW; LAS unsigned char* BMT = lds + SL_BMT; LAS float* wl = (LAS float*)(lds + SL_WL); LAS float* tmp = (LAS float*)(lds + SL_TMP);
    for (int unit = bid; unit < BATCH * NCH * 2; unit += nb) {
        const int g = unit & 1, c = (unit >> 1) % NCH, b = unit / (2 * NCH); const int t0 = b * SEQ + c * 128;
        __syncthreads();
        { const int r = tid >> 7, l = tid & 127, h = g * 4 + r;
          const float v = dtraw[(size_t)(t0 + l) * 8 + h] + dtb[h]; const float dtv = fmaxf(v, 0.f) + log1pf(__expf(-fabsf(v))); const float av = -__expf(alog[h]);
          float x = dtv * av;
#pragma unroll
          for (int o = 1; o < 64; o <<= 1) { const float y = __shfl_up(x, o); if (lane >= o) x += y; }
          if (lane == 63) tmp[w] = x;
          __syncthreads();
          if (w & 1) x += tmp[w - 1];
          const float last = tmp[2 * r] + tmp[2 * r + 1];
          dtg[(size_t)(t0 + l) * 8 + h] = dtv; acum[(size_t)(t0 + l) * 8 + h] = x; wl[r * 128 + l] = dtv * __expf(last - x);
          if (l == 127) cdec[(b * NCH + c) * 8 + h] = __expf(x); }
        __syncthreads();
        { unsigned raw[6][11];
#pragma unroll
          for (int it = 0; it < 6; ++it) { const int task = tid + it * NT, pi = task % 192, l0 = (task / 192) * 8;
              const int ch = pi < 128 ? g * 256 + 2 * pi : 512 + g * 128 + 2 * (pi - 128); conv_load(proj, t0, c * 128, l0, ch, raw[it]); }
#pragma unroll
          for (int it = 0; it < 6; ++it) { const int task = tid + it * NT, pi = task % 192, l0 = (task / 192) * 8;
            const int ch = pi < 128 ? g * 256 + 2 * pi : 512 + g * 128 + 2 * (pi - 128);
            float o0[8], o1[8]; conv_compute(raw[it], a.in[3], a.in[4], ch, o0, o1);
            if (pi < 128) { const int row = 2 * pi; const LAS float* ws_ = wl + (row >> 6) * 128 + l0;
#pragma unroll
                for (int j = 0; j < 8; ++j) { o0[j] *= ws_[j]; o1[j] *= ws_[j]; }
                v4u p0, p1; p0.x = cvtpk(o0[0], o0[1]); p0.y = cvtpk(o0[2], o0[3]); p0.z = cvtpk(o0[4], o0[5]); p0.w = cvtpk(o0[6], o0[7]);
                p1.x = cvtpk(o1[0], o1[1]); p1.y = cvtpk(o1[2], o1[3]); p1.z = cvtpk(o1[4], o1[5]); p1.w = cvtpk(o1[6], o1[7]);
                *(LAS v4u*)(XW + row * SL_ST + l0 * 2) = p0; *(LAS v4u*)(XW + (row + 1) * SL_ST + l0 * 2) = p1; }
            else { const int row = 2 * (pi - 128);
                v4u p0, p1; p0.x = cvtpk(o0[0], o0[1]); p0.y = cvtpk(o0[2], o0[3]); p0.z = cvtpk(o0[4], o0[5]); p0.w = cvtpk(o0[6], o0[7]);
                p1.x = cvtpk(o1[0], o1[1]); p1.y = cvtpk(o1[2], o1[3]); p1.z = cvtpk(o1[4], o1[5]); p1.w = cvtpk(o1[6], o1[7]);
                *(LAS v4u*)(BMT + row * SL_ST + l0 * 2) = p0; *(LAS v4u*)(BMT + (row + 1) * SL_ST + l0 * 2) = p1; } } }
        __syncthreads();
        { const int r = w >> 1, ph = w & 1, qc = lane & 31, hh = lane >> 5, h = g * 4 + r;
          f32x16 acc[4];
#pragma unroll
          for (int n4 = 0; n4 < 4; ++n4)
#pragma unroll
              for (int i = 0; i < 16; ++i) acc[n4][i] = 0.f;
#pragma unroll
          for (int ks = 0; ks < 8; ++ks) { const bf16x8 af = *(const LAS bf16x8*)(XW + (r * 64 + ph * 32 + qc) * SL_ST + (16 * ks + 8 * hh) * 2);
#pragma unroll
              for (int n4 = 0; n4 < 4; ++n4) { const bf16x8 bfr = *(const LAS bf16x8*)(BMT + (n4 * 32 + qc) * SL_ST + (16 * ks + 8 * hh) * 2);
                  acc[n4] = __builtin_amdgcn_mfma_f32_32x32x16_bf16(af, bfr, acc[n4], 0, 0, 0); } }
          float* st = states + ((size_t)((b * NCH + c) * 8 + h)) * 8192;
#pragma unroll
          for (int n4 = 0; n4 < 4; ++n4)
#pragma unroll
              for (int i = 0; i < 16; ++i) { const int pp = ph * 32 + (i & 3) + 8 * (i >> 2) + 4 * hh; st[pp * 128 + n4 * 32 + qc] = acc[n4][i]; } }
    }
}
__device__ __forceinline__ void ph_scan(const Args& a, int bid, int nb) {
    const float* states = (const float*)(a.ws + WS_STATES); const float* cdec = (const float*)(a.ws + WS_CDEC); bf16* prev = (bf16*)(a.ws + WS_PREV);
    const int n4 = BATCH * 8 * 2048;
    for (int i = bid * NT + threadIdx.x; i < n4; i += nb * NT) {
        const int e4 = i & 2047, h = (i >> 11) & 7, b = i >> 14;
        f32x4v st[NCH]; float dc[NCH];
#pragma unroll
        for (int c = 0; c < NCH; ++c) { st[c] = *(const f32x4v*)(states + ((size_t)((b * NCH + c) * 8 + h)) * 8192 + e4 * 4); dc[c] = cdec[(b * NCH + c) * 8 + h]; }
        f32x4v hc = {0.f, 0.f, 0.f, 0.f};
#pragma unroll
        for (int c = 0; c < NCH; ++c) { u32x2v pk; pk.x = cvtpk(hc[0], hc[1]); pk.y = cvtpk(hc[2], hc[3]); *(u32x2v*)(prev + ((size_t)((b * NCH + c) * 8 + h)) * 8192 + e4 * 4) = pk; hc = hc * dc[c] + st[c]; }
    }
}
constexpr int SO_XST = 264, SO_NST = 272, SO_XS = 0, SO_BM = 256 * SO_XST, SO_CM = SO_BM + 128 * SO_NST, SO_AC = SO_CM + 128 * SO_NST, SO_DT = SO_AC + 2048, SO_EA = SO_DT + 2048, SO_END = SO_EA + 2048;
constexpr int SO_YST = 260;
static_assert(128 * SO_YST * 4 <= SO_AC && SO_END <= SCR_BYTES, "ssd_out LDS map");
__device__ __forceinline__ void ph_ssd_out(const Args& a, LAS unsigned char* lds, int bid, int nb) {
    const bf16* proj = (const bf16*)(a.ws + WS_PROJ); const float* dtg = (const float*)(a.ws + WS_DT); const float* acum = (const float*)(a.ws + WS_ACUM);
    const bf16* prev = (const bf16*)(a.ws + WS_PREV); const float* dsk = a.in[7];
    bf16* ygb = (bf16*)(a.ws + WS_CAT); float* ssd = (float*)(a.ws + WS_SSSD);
    const int tid = threadIdx.x, lane = tid & 63, w = tid >> 6, r = w >> 1, lsel = w & 1, qc = lane & 31, hh = lane >> 5;
    LAS unsigned char* XS = lds + SO_XS; LAS unsigned char* BM = lds + SO_BM; LAS unsigned char* CM = lds + SO_CM;
    LAS float* AC = (LAS float*)(lds + SO_AC); LAS float* DT = (LAS float*)(lds + SO_DT); LAS float* EA = (LAS float*)(lds + SO_EA); LAS float* YS = (LAS float*)lds;
    for (int unit = bid; unit < BATCH * NCH * 2; unit += nb) {
        const int g = unit & 1, c = (unit >> 1) % NCH, b = unit / (2 * NCH); const int t0 = b * SEQ + c * 128;
        __syncthreads();
        bf16x8 pf[2][8];
        { const bf16* pvb = prev + ((size_t)((b * NCH + c) * 8 + g * 4 + r)) * 8192 + qc * 128 + 8 * hh;
#pragma unroll
          for (int pb = 0; pb < 2; ++pb)
#pragma unroll
              for (int ks = 0; ks < 8; ++ks) pf[pb][ks] = *(const bf16x8*)(pvb + pb * 32 * 128 + 16 * ks); }
        { const int rr = tid >> 7, l = tid & 127, h = g * 4 + rr; const float ac = acum[(size_t)(t0 + l) * 8 + h];
          AC[rr * 128 + l] = ac; DT[rr * 128 + l] = dtg[(size_t)(t0 + l) * 8 + h]; EA[rr * 128 + l] = __expf(ac); }
#pragma unroll 1
        for (int bt = 0; bt < 2; ++bt) { unsigned raw[4][11];
#pragma unroll
          for (int it = 0; it < 4; ++it) { const int task = tid + (bt * 4 + it) * NT, pi = task & 255, l0 = (task >> 8) * 8;
              const int ch = pi < 128 ? g * 256 + 2 * pi : (pi < 192 ? 512 + g * 128 + 2 * (pi - 128) : 768 + g * 128 + 2 * (pi - 192)); conv_load(proj, t0, c * 128, l0, ch, raw[it]); }
#pragma unroll
          for (int it = 0; it < 4; ++it) { const int task = tid + (bt * 4 + it) * NT, pi = task & 255, l0 = (task >> 8) * 8;
            const int ch = pi < 128 ? g * 256 + 2 * pi : (pi < 192 ? 512 + g * 128 + 2 * (pi - 128) : 768 + g * 128 + 2 * (pi - 192));
            float o0[8], o1[8]; conv_compute(raw[it], a.in[3], a.in[4], ch, o0, o1);
            if (pi < 128) { const int row = 2 * pi; u32x2v q0, q1;
                q0.x = cvtpk(o0[0], o0[1]); q0.y = cvtpk(o0[2], o0[3]); q1.x = cvtpk(o0[4], o0[5]); q1.y = cvtpk(o0[6], o0[7]);
                *(LAS u32x2v*)(XS + row * SO_XST + l0 * 2) = q0; *(LAS u32x2v*)(XS + row * SO_XST + l0 * 2 + 8) = q1;
                q0.x = cvtpk(o1[0], o1[1]); q0.y = cvtpk(o1[2], o1[3]); q1.x = cvtpk(o1[4], o1[5]); q1.y = cvtpk(o1[6], o1[7]);
                *(LAS u32x2v*)(XS + (row + 1) * SO_XST + l0 * 2) = q0; *(LAS u32x2v*)(XS + (row + 1) * SO_XST + l0 * 2 + 8) = q1; }
            else { LAS unsigned char* img = pi < 192 ? BM : CM; const int n = 2 * ((pi - 128) & 63);
#pragma unroll
                for (int j = 0; j < 8; ++j) *(LAS unsigned*)(img + (l0 + j) * SO_NST + n * 2) = cvtpk(o0[j], o1[j]); } } }
        __syncthreads();
        const int h = g * 4 + r; const float dskip = dsk[h];
        f32x16 Y[2][2];
#pragma unroll
        for (int li = 0; li < 2; ++li) {
            const int lb = lsel ? (1 + li) : (li ? 3 : 0);
#pragma unroll
            for (int pb = 0; pb < 2; ++pb)
#pragma unroll
                for (int i = 0; i < 16; ++i) Y[li][pb][i] = 0.f;
#pragma unroll
            for (int ks = 0; ks < 8; ++ks) { const bf16x8 bfr = *(const LAS bf16x8*)(CM + (lb * 32 + qc) * SO_NST + (16 * ks + 8 * hh) * 2);
#pragma unroll
                for (int pb = 0; pb < 2; ++pb) Y[li][pb] = __builtin_amdgcn_mfma_f32_32x32x16_bf16(pf[pb][ks], bfr, Y[li][pb], 0, 0, 0); }
            const float ea = EA[r * 128 + lb * 32 + qc], acl = AC[r * 128 + lb * 32 + qc];
#pragma unroll
            for (int pb = 0; pb < 2; ++pb)
#pragma unroll
                for (int i = 0; i < 16; ++i) Y[li][pb][i] *= ea;
            for (int sb = 0; sb <= lb; ++sb) {
                f32x16 X;
#pragma unroll
                for (int i = 0; i < 16; ++i) X[i] = 0.f;
#pragma unroll
                for (int ks = 0; ks < 8; ++ks) { const bf16x8 af = *(const LAS bf16x8*)(BM + (sb * 32 + qc) * SO_NST + (16 * ks + 8 * hh) * 2);
                    const bf16x8 bfr = *(const LAS bf16x8*)(CM + (lb * 32 + qc) * SO_NST + (16 * ks + 8 * hh) * 2);
                    X = __builtin_amdgcn_mfma_f32_32x32x16_bf16(af, bfr, X, 0, 0, 0); }
                const bool dg = (sb == lb);
#pragma unroll
                for (int q = 0; q < 4; ++q) { const f32x4v as4 = *(const LAS f32x4v*)(AC + r * 128 + sb * 32 + 8 * q + 4 * hh), ds4 = *(const LAS f32x4v*)(DT + r * 128 + sb * 32 + 8 * q + 4 * hh);
#pragma unroll
                    for (int i = 0; i < 4; ++i) { const int sl = 8 * q + 4 * hh + i;
                        const float e = __expf(acl - as4[i]) * ds4[i]; const bool ok = !dg || sl <= qc; float f = ok ? e : 0.f;
                        float xv = X[4 * q + i] * f; if (dg && sl == qc) xv += dskip; X[4 * q + i] = xv; } }
#pragma unroll
                for (int k2 = 0; k2 < 2; ++k2) { union { bf16x8 v; unsigned u[4]; } gb;
#pragma unroll
                    for (int e = 0; e < 4; ++e) gb.u[e] = cvtpk(X[8 * k2 + 2 * e], X[8 * k2 + 2 * e + 1]);
#pragma unroll
                    for (int pb = 0; pb < 2; ++pb) { const LAS unsigned char* xp = XS + (r * 64 + pb * 32 + qc) * SO_XST + (sb * 32 + 16 * k2 + 4 * hh) * 2;
                        union { bf16x8 v; u32x2v h2[2]; } af; af.h2[0] = *(const LAS u32x2v*)xp; af.h2[1] = *(const LAS u32x2v*)(xp + 16);
                        Y[li][pb] = __builtin_amdgcn_mfma_f32_32x32x16_bf16(af.v, gb.v, Y[li][pb], 0, 0, 0); } }
            }
        }
        __syncthreads();
#pragma unroll
        for (int li = 0; li < 2; ++li) { const int lb = lsel ? (1 + li) : (li ? 3 : 0);
#pragma unroll
            for (int pb = 0; pb < 2; ++pb)
#pragma unroll
                for (int q = 0; q < 4; ++q) { f32x4v v4; v4[0] = Y[li][pb][4 * q]; v4[1] = Y[li][pb][4 * q + 1]; v4[2] = Y[li][pb][4 * q + 2]; v4[3] = Y[li][pb][4 * q + 3];
                    *(LAS f32x4v*)(YS + (lb * 32 + qc) * SO_YST + r * 64 + pb * 32 + 8 * q + 4 * hh) = v4; } }
        __syncthreads();
        { v4u zz8[8];
#pragma unroll
          for (int it = 0; it < 8; ++it) { const int task = tid + it * NT, row = task >> 5, ck = task & 31; zz8[it] = *(const v4u*)(proj + (size_t)(t0 + row) * NP + PZ + g * 256 + ck * 8); }
#pragma unroll
          for (int it = 0; it < 8; ++it) { const int task = tid + it * NT, row = task >> 5, ck = task & 31; const v4u zz = zz8[it];
            const f32x4v y0 = *(const LAS f32x4v*)(YS + row * SO_YST + ck * 8), y1 = *(const LAS f32x4v*)(YS + row * SO_YST + ck * 8 + 4);
            float o[8]; o[0] = y0[0] * silu_fast(bflo(zz.x)); o[1] = y0[1] * silu_fast(bfhi(zz.x)); o[2] = y0[2] * silu_fast(bflo(zz.y)); o[3] = y0[3] * silu_fast(bfhi(zz.y));
            o[4] = y1[0] * silu_fast(bflo(zz.z)); o[5] = y1[1] * silu_fast(bfhi(zz.z)); o[6] = y1[2] * silu_fast(bflo(zz.w)); o[7] = y1[3] * silu_fast(bfhi(zz.w));
            float ss = 0.f;
#pragma unroll
            for (int e = 0; e < 8; ++e) ss += o[e] * o[e];
#pragma unroll
            for (int of = 1; of < 32; of <<= 1) ss += __shfl_xor(ss, of);
            if (ck == 0) ssd[(size_t)(t0 + row) * 2 + g] = ss;
            v4u ov; ov.x = cvtpk(o[0], o[1]); ov.y = cvtpk(o[2], o[3]); ov.z = cvtpk(o[4], o[5]); ov.w = cvtpk(o[6], o[7]);
            *(v4u*)(ygb + (size_t)(t0 + row) * 1024 + g * 256 + ck * 8) = ov; } }
    }
}
constexpr int AT_KST = 144, AT_VST = 520, AT_K = 0, AT_V = 256 * AT_KST, AT_B = AT_V + 64 * AT_VST;
__device__ __forceinline__ void ph_attn(const Args& a, LAS unsigned char* lds, int bid, int nb) {
    const bf16* proj = (const bf16*)(a.ws + WS_PROJ); const float* sinks = a.in[9]; const float* relb = a.in[10];
    bf16* ao = (bf16*)(a.ws + WS_CAT) + 512; float* ssat = (float*)(a.ws + WS_SSAT);
    const int tid = threadIdx.x, lane = tid & 63, w = tid >> 6, g = w >> 1, half = w & 1, qc = lane & 31, hh = lane >> 5;
    LAS unsigned char* Kimg = lds + AT_K; LAS unsigned char* VT = lds + AT_V; LAS float* biasT = (LAS float*)(lds + AT_B);
    for (int unit = bid; unit < BATCH * NCH * 2; unit += nb) {
        const int kvh = unit & 1, blk = (unit >> 1) % NCH, b = unit / (2 * NCH); const int t0 = b * SEQ + blk * 128;
        __syncthreads();
        { v4u kv4[4], vv4[4];
#pragma unroll
          for (int it = 0; it < 4; ++it) { const int c = tid + it * NT, row = c >> 3, part = c & 7; kv4[it] = (v4u){0u, 0u, 0u, 0u}; vv4[it] = (v4u){0u, 0u, 0u, 0u};
            if (blk > 0 || row >= 128) { const bf16* src = proj + (size_t)(t0 - 128 + row) * NP + kvh * 64 + part * 8; kv4[it] = *(const v4u*)(src + PK); vv4[it] = *(const v4u*)(src + PV); } }
#pragma unroll
          for (int it = 0; it < 4; ++it) { const int c = tid + it * NT, row = c >> 3, part = c & 7; const v4u kv = kv4[it], vv = vv4[it];
            *(LAS v4u*)(Kimg + row * AT_KST + part * 16) = kv;
            LAS unsigned short* vt = (LAS unsigned short*)(VT + (part * 8) * AT_VST + row * 2);
            vt[0 * (AT_VST / 2)] = (unsigned short)(vv.x & 0xffffu); vt[1 * (AT_VST / 2)] = (unsigned short)(vv.x >> 16);
            vt[2 * (AT_VST / 2)] = (unsigned short)(vv.y & 0xffffu); vt[3 * (AT_VST / 2)] = (unsigned short)(vv.y >> 16);
            vt[4 * (AT_VST / 2)] = (unsigned short)(vv.z & 0xffffu); vt[5 * (AT_VST / 2)] = (unsigned short)(vv.z >> 16);
            vt[6 * (AT_VST / 2)] = (unsigned short)(vv.w & 0xffffu); vt[7 * (AT_VST / 2)] = (unsigned short)(vv.w >> 16); } }
        { const int gg = tid >> 7, dist = tid & 127; biasT[gg * 128 + dist] = relb[c_bucket[dist] * 8 + kvh * 4 + gg]; }
        __syncthreads();
        const int hq = kvh * 4 + g; const float sink = sinks[hq];
#pragma unroll 1
        for (int qb = 0; qb < 2; ++qb) {
            const int q0 = half * 64 + qb * 32; const size_t tq = (size_t)(t0 + q0 + qc);
            bf16x8 qf[4];
            { const bf16* qp = proj + tq * NP + PQ + hq * 64 + 8 * hh;
#pragma unroll
              for (int ks = 0; ks < 4; ++ks) qf[ks] = *(const bf16x8*)(qp + 16 * ks); }
            f32x16 sc[5];
#pragma unroll
            for (int kb = 0; kb < 5; ++kb) {
#pragma unroll
                for (int r = 0; r < 16; ++r) sc[kb][r] = 0.f;
#pragma unroll
                for (int ks = 0; ks < 4; ++ks) { const bf16x8 kf = *(const LAS bf16x8*)(Kimg + (q0 + 32 * kb + qc) * AT_KST + (16 * ks + 8 * hh) * 2);
                    sc[kb] = __builtin_amdgcn_mfma_f32_32x32x16_bf16(kf, qf[ks], sc[kb], 0, 0, 0); } }
            float m = -INFINITY;
#pragma unroll
            for (int kb = 0; kb < 5; ++kb)
#pragma unroll
                for (int r = 0; r < 16; ++r) { const int ki = (r & 3) + 8 * (r >> 2) + 4 * hh, dist = qc + 128 - 32 * kb - ki, j = q0 + 32 * kb + ki;
                    const bool ok = dist >= 0 && dist < 128 && (blk > 0 || j >= 128);
                    const float v = ok ? sc[kb][r] * 0.125f + biasT[g * 128 + (dist & 127)] : -INFINITY; sc[kb][r] = v; m = fmaxf(m, v); }
            m = fmaxf(m, __shfl_xor(m, 32)); m = fmaxf(m, sink);
            float l = 0.f;
#pragma unroll
            for (int kb = 0; kb < 5; ++kb)
#pragma unroll
                for (int r = 0; r < 16; ++r) { const float pv = __expf(sc[kb][r] - m); sc[kb][r] = pv; l += pv; }
            l += __shfl_xor(l, 32); l += __expf(sink - m);
            f32x16 o[2];
#pragma unroll
            for (int db = 0; db < 2; ++db)
#pragma unroll
                for (int r = 0; r < 16; ++r) o[db][r] = 0.f;
#pragma unroll
            for (int kb = 0; kb < 5; ++kb)
#pragma unroll
                for (int k2 = 0; k2 < 2; ++k2) {
                    union { bf16x8 v; unsigned u[4]; } pb;
#pragma unroll
                    for (int e = 0; e < 4; ++e) pb.u[e] = cvtpk(sc[kb][8 * k2 + 2 * e], sc[kb][8 * k2 + 2 * e + 1]);
#pragma unroll
                    for (int db = 0; db < 2; ++db) { const LAS unsigned char* vp = VT + (db * 32 + qc) * AT_VST + (q0 + 32 * kb + 16 * k2 + 4 * hh) * 2;
                        union { bf16x8 v; u32x2v h2[2]; } va; va.h2[0] = *(const LAS u32x2v*)vp; va.h2[1] = *(const LAS u32x2v*)(vp + 16);
                        o[db] = __builtin_amdgcn_mfma_f32_32x32x16_bf16(va.v, pb.v, o[db], 0, 0, 0); } }
            const float inv = 1.f / l; float ss = 0.f;
#pragma unroll
            for (int db = 0; db < 2; ++db)
#pragma unroll
                for (int r = 0; r < 16; ++r) { o[db][r] *= inv; ss += o[db][r] * o[db][r]; }
            ss += __shfl_xor(ss, 32);
            if (hh == 0) ssat[tq * 8 + hq] = ss;
#pragma unroll
            for (int db = 0; db < 2; ++db)
#pragma unroll
                for (int q4 = 0; q4 < 4; ++q4) { uint2 pk; pk.x = cvtpk(o[db][4 * q4], o[db][4 * q4 + 1]); pk.y = cvtpk(o[db][4 * q4 + 2], o[db][4 * q4 + 3]);
                    *(uint2*)(ao + tq * 1024 + hq * 64 + db * 32 + 8 * q4 + 4 * hh) = pk; }
        }
    }
}
constexpr int RT_UST = 1025;
constexpr int RT_P = 0, RT_L = 32768;
constexpr int RT_HIST = TAB_OFF, RT_BASE = TAB_OFF + 128, RT_SE = TAB_OFF + 256, RT_SG = RT_SE + 512, RT_SS = RT_SG + 512;
static_assert(32 * RT_UST * 4 <= SCR_BYTES, "router LDS map");
__device__ __forceinline__ void ph_router(const Args& a, LAS unsigned char* lds, int bid, int nb) {
    const float* hh_ = a.in[0]; const bf16* dl_ = (const bf16*)(a.ws + WS_H); const float* g = a.in[13]; const float* wr = a.in[14]; const float* br = a.in[15];
    unsigned char* u2 = a.ws + WS_U2; int* toke = (int*)(a.ws + WS_TOKE); int* toks = (int*)(a.ws + WS_TOKS);
    int* ltok = (int*)(a.ws + WS_LTOK); float* lgate = (float*)(a.ws + WS_LGATE); unsigned* cnt = (unsigned*)(a.ws + WS_CTL);
    const int tid = threadIdx.x, lane = tid & 63, w = tid >> 6, qc = lane & 31, hh = lane >> 5;
    LAS float* U = (LAS float*)lds; LAS float* P = (LAS float*)(lds + RT_P); LAS float* L = (LAS float*)(lds + RT_L);
    LAS unsigned* hist = (LAS unsigned*)(lds + RT_HIST); LAS unsigned* basev = (LAS unsigned*)(lds + RT_BASE);
    LAS int* se = (LAS int*)(lds + RT_SE); LAS float* sg = (LAS float*)(lds + RT_SG); LAS unsigned* ssl = (LAS unsigned*)(lds + RT_SS);
    float breg[64];
#pragma unroll
    for (int kk = 0; kk < 64; ++kk) breg[kk] = wr[(size_t)(128 * w + 2 * kk + hh) * NE + qc];
    for (int tile = bid; tile < T / 32; tile += nb) {
        const int tk0 = tile * 32;
        __syncthreads();
        if (tid < NE) hist[tid] = 0u;
#pragma unroll 1
        for (int rr = 0; rr < 4; ++rr) { const int row = w * 4 + rr; const float4* xr = (const float4*)(hh_ + (size_t)(tk0 + row) * DM); const uint2* dr = (const uint2*)(dl_ + (size_t)(tk0 + row) * DM); float4 v[4]; float s = 0.f;
#pragma unroll
            for (int j = 0; j < 4; ++j) { v[j] = xr[lane + 64 * j]; const uint2 dw = dr[lane + 64 * j]; v[j].x += bflo(dw.x); v[j].y += bfhi(dw.x); v[j].z += bflo(dw.y); v[j].w += bfhi(dw.y);
                s += v[j].x * v[j].x + v[j].y * v[j].y + v[j].z * v[j].z + v[j].w * v[j].w; }
            const float rs = rsqrtf(wave_sum(s) * (1.f / DM) + EPS);
#pragma unroll
            for (int j = 0; j < 4; ++j) { const float4 gg = ((const float4*)g)[lane + 64 * j];
                const float un[4] = {v[j].x * rs * gg.x, v[j].y * rs * gg.y, v[j].z * rs * gg.z, v[j].w * rs * gg.w};
                *(unsigned*)(u2 + (size_t)(tk0 + row) * DM + 4 * lane + 256 * j) = pk4_fp8(un[0], un[1], un[2], un[3]);
                LAS float* ur = U + row * RT_UST + 4 * lane + 256 * j; ur[0] = un[0]; ur[1] = un[1]; ur[2] = un[2]; ur[3] = un[3]; } }
        __syncthreads();
        f32x16 acc;
#pragma unroll
        for (int i = 0; i < 16; ++i) acc[i] = 0.f;
#pragma unroll
        for (int kk = 0; kk < 64; ++kk) acc = __builtin_amdgcn_mfma_f32_32x32x2f32(U[qc * RT_UST + 128 * w + 2 * kk + hh], breg[kk], acc, 0, 0, 0);
        __syncthreads();
#pragma unroll
        for (int i = 0; i < 16; ++i) P[(w * 32 + (i & 3) + 8 * (i >> 2) + 4 * hh) * 32 + qc] = acc[i];
        __syncthreads();
#pragma unroll
        for (int o2 = 0; o2 < 2; ++o2) { const int o = tid + 512 * o2; float sacc = br[o & 31];
#pragma unroll
            for (int ww = 0; ww < 8; ++ww) sacc += P[ww * 1024 + o];
            L[o] = sacc; }
        __syncthreads();
#pragma unroll 1
        for (int it = 0; it < 2; ++it) { const int tok = w * 4 + it * 2 + hh;
            float cur = L[tok * 32 + qc]; int idx[4]; float val[4];
#pragma unroll
            for (int k = 0; k < 4; ++k) { float m = cur;
#pragma unroll
                for (int of = 1; of < 32; of <<= 1) m = fmaxf(m, __shfl_xor(m, of));
                const unsigned long long bal = __ballot(cur == m); const unsigned hb = hh ? (unsigned)(bal >> 32) : (unsigned)bal; const int wi = __ffs((int)hb) - 1;
                idx[k] = wi; val[k] = m; if (qc == wi) cur = -INFINITY; }
            if (qc < 4) { const float e1 = __expf(val[1] - val[0]), e2 = __expf(val[2] - val[0]), e3 = __expf(val[3] - val[0]); const float inv = 1.f / (1.f + e1 + e2 + e3);
                const float gsel = qc == 0 ? inv : (qc == 1 ? e1 * inv : (qc == 2 ? e2 * inv : e3 * inv)); const int esel = qc == 0 ? idx[0] : (qc == 1 ? idx[1] : (qc == 2 ? idx[2] : idx[3]));
                se[tok * 4 + qc] = esel; sg[tok * 4 + qc] = gsel; ssl[tok * 4 + qc] = atomicAdd((unsigned*)&hist[esel], 1u); } }
        __syncthreads();
        if (tid < NE) basev[tid] = atomicAdd(&cnt[tid], hist[tid]);
        __syncthreads();
        if (tid < 128) { const int tok = tid >> 2, e = se[tid]; const unsigned sl = basev[e] + ssl[tid]; const int tg = tk0 + tok;
            toke[tg * 4 + (tid & 3)] = e; toks[tg * 4 + (tid & 3)] = (int)sl; ltok[(size_t)e * T + sl] = tg; lgate[(size_t)e * T + sl] = sg[tid]; }
    }
}
__device__ __forceinline__ void moe_setup(const Args& a, LAS unsigned char* lds, int nct, int G, int c, bool gather, unsigned pitch, bool plain) {
    LAS int* s_cnt = (LAS int*)(lds + TB_CNT); LAS int* s_ptile = (LAS int*)(lds + TB_PTILE); LAS int* s_re = (LAS int*)(lds + TB_RE); LAS int* s_tstart = (LAS int*)(lds + TB_TSTART);
    LAS int* s_misc = (LAS int*)(lds + TB_MISC); LAS int* s_units = (LAS int*)(lds + TB_UNITS); LAS unsigned* rowtab = (LAS unsigned*)(lds + TB_ROWTAB);
    const unsigned* cnt = (const unsigned*)(a.ws + WS_CTL); const int* ltok = (const int*)(a.ws + WS_LTOK);
    const int tid = threadIdx.x;
    __syncthreads();
    if (tid < NE) s_cnt[tid] = (int)cnt[tid];
    __syncthreads();
    if (tid == 0) { int pt = 0, ts = 0;
        for (int e = 0; e < NE; ++e) { const int cn = s_cnt[e], re = (cn + 255) >> 8; s_ptile[e] = pt; s_re[e] = re; s_tstart[e] = ts; pt += re; ts += re * nct; }
        s_ptile[NE] = pt; s_tstart[NE] = ts; s_misc[0] = ts; s_misc[1] = (ts + G - 1) / G; }
    __syncthreads();
    if (tid < 16) { const int nwg = s_misc[0]; const long L = (long)tid * G + c; int pm = -1, pn = 0;
        if (L < nwg) { int wgid = (int)L; { const int q = nwg / 8, r = nwg % 8, xcd = wgid % 8, off = wgid / 8; wgid = (xcd < r ? xcd * (q + 1) : r * (q + 1) + (xcd - r) * q) + off; }
            int e = 0; while (wgid >= s_tstart[e + 1]) ++e;
            const int local = wgid - s_tstart[e], re = s_re[e]; pm = s_ptile[e] + local % re; pn = e * nct + local / re; }
        s_units[2 * tid] = pm; s_units[2 * tid + 1] = pn; }
    __syncthreads();
    if (gather) { const int nr = s_misc[1] < 9 ? s_misc[1] : 9;
        LAS float* btab = (LAS float*)(lds + 131072); LAS float* gtab = btab + 5 * 256;
        float bv_[5], gv_[5]; unsigned rv_[5];
#pragma unroll
        for (int q = 0; q < 5; ++q) { const int idx = tid + q * NT, i = idx >> 8, r = idx & 255; bv_[q] = 0.f; gv_[q] = 0.f; rv_[q] = 0u;
            if (i < nr) { const int pm = s_units[2 * i]; if (pm >= 0) { const int e = s_units[2 * i + 1] / nct, ct = s_units[2 * i + 1] % nct, sl = (pm - s_ptile[e]) * 256 + r; const bool ok = sl < s_cnt[e];
                if (plain) { bv_[q] = a.in[19][(size_t)e * 1024 + ct * 256 + r]; gv_[q] = ok ? ((const float*)(a.ws + WS_LGATE))[(size_t)e * T + sl] : 0.f; rv_[q] = (unsigned)(pm * 256 + r) * pitch; }
                else { bv_[q] = a.in[17][(size_t)e * 2048 + (r < 128 ? 0 : 1024 - 128) + ct * 128 + r]; rv_[q] = ok ? (unsigned)ltok[(size_t)e * T + sl] * pitch : 0u; } } } }
#pragma unroll
        for (int q = 0; q < 5; ++q) { const int idx = tid + q * NT, i = idx >> 8; if (i < nr) { btab[idx] = bv_[q]; rowtab[idx] = rv_[q]; if (plain) gtab[idx] = gv_[q]; } } }
    __syncthreads();
}
typedef float float2v __attribute__((ext_vector_type(2)));
__device__ __forceinline__ void ph_final(const Args& a, LAS unsigned char* lds, int bid, int nb) {
    const float* hh = a.in[0]; const bf16* dl = (const bf16*)(a.ws + WS_H); const unsigned char* ys = a.ws + WS_YS; const int* toke = (const int*)(a.ws + WS_TOKE); const int* toks = (const int*)(a.ws + WS_TOKS);
    const unsigned* cnt = (const unsigned*)(a.ws + WS_CTL); const float* g = a.in[20]; float* out = a.out;
    LAS int* s_ps = (LAS int*)(lds + TB_PTILE);
    __syncthreads();
    LAS int* s_c = (LAS int*)(lds + TB_CNT); if (threadIdx.x < NE) s_c[threadIdx.x] = (int)cnt[threadIdx.x];
    __syncthreads();
    if (threadIdx.x == 0) { int pt = 0; for (int e = 0; e < NE; ++e) { s_ps[e] = pt; pt += (s_c[e] + 255) >> 8; } }
    __syncthreads();
    const int lane = threadIdx.x & 63, gw = bid * 8 + (threadIdx.x >> 6), ngw = nb * 8;
    size_t myoff = 0; { const int j = lane >> 2, k = lane & 3, r = gw + j * ngw; if (lane < 32 && r < T) myoff = ((size_t)s_ps[toke[r * 4 + k]] * 256 + toks[r * 4 + k]) * 1024; }
    for (int j = 0; gw + j * ngw < T; ++j) { const int r = gw + j * ngw;
        float4 v[4]; int wq[4][4];
        if (j < 8) {
#pragma unroll
            for (int k = 0; k < 4; ++k) { const size_t off = __shfl(myoff, (j & 7) * 4 + k);
#pragma unroll
                for (int jj = 0; jj < 4; ++jj) wq[k][jj] = *(const int*)(ys + off + 4 * lane + 256 * jj); } }
        else {
#pragma unroll
            for (int k = 0; k < 4; ++k) { const size_t off = ((size_t)s_ps[toke[r * 4 + k]] * 256 + toks[r * 4 + k]) * 1024;
#pragma unroll
                for (int jj = 0; jj < 4; ++jj) wq[k][jj] = *(const int*)(ys + off + 4 * lane + 256 * jj); } }
#pragma unroll
        for (int jj = 0; jj < 4; ++jj) { v[jj] = *(const float4*)(hh + (size_t)r * DM + 4 * lane + 256 * jj); const uint2 dw = *(const uint2*)(dl + (size_t)r * DM + 4 * lane + 256 * jj);
            v[jj].x += bflo(dw.x); v[jj].y += bfhi(dw.x); v[jj].z += bflo(dw.y); v[jj].w += bfhi(dw.y); }
#pragma unroll
        for (int k = 0; k < 4; ++k)
#pragma unroll
            for (int jj = 0; jj < 4; ++jj) { const int w = wq[k][jj];
                const float2v lo = __builtin_amdgcn_cvt_pk_f32_fp8(w, false), hi = __builtin_amdgcn_cvt_pk_f32_fp8(w, true);
                v[jj].x += lo[0] * (1.f / YS8_SCALE); v[jj].y += lo[1] * (1.f / YS8_SCALE); v[jj].z += hi[0] * (1.f / YS8_SCALE); v[jj].w += hi[1] * (1.f / YS8_SCALE); }
        float s = 0.f;
#pragma unroll
        for (int jj = 0; jj < 4; ++jj) s += v[jj].x * v[jj].x + v[jj].y * v[jj].y + v[jj].z * v[jj].z + v[jj].w * v[jj].w;
        const float rs = rsqrtf(wave_sum(s) * (1.f / DM) + EPS);
#pragma unroll
        for (int jj = 0; jj < 4; ++jj) { const float4 gg = *(const float4*)(g + 4 * lane + 256 * jj);
            *(float4*)(out + (size_t)r * DM + 4 * lane + 256 * jj) = make_float4(v[jj].x * rs * gg.x, v[jj].y * rs * gg.y, v[jj].z * rs * gg.z, v[jj].w * rs * gg.w); }
    }
}

__global__ void __launch_bounds__(NT, 2) mk_fwd(Args args) {
    extern __shared__ __attribute__((aligned(16))) unsigned char smem[];
    LAS unsigned char* lds = (LAS unsigned char*)smem;
    const int tid = threadIdx.x, bid = blockIdx.x, G = gridDim.x;
    unsigned char* ws = args.ws;
    const int lo = args.ph_lo, hi = args.ph_hi;
#define IN(k) (lo <= (k) && (k) < hi)
#define BOTH(k) (IN(k) && IN((k) + 1))
    XcdBarrier bar; bar.bar = (unsigned*)(ws + WS_CTL) + CW_BAR + args.bar_sel * XCD_BAR_WORDS; bar.x = 0; bar.st = nullptr;
    if (MK_ONE_LAUNCH) {
        if (tid < 4) ((volatile LAS unsigned*)(lds + XBW_OFF))[tid] = 0u;
        __syncthreads();
        bar = xcd_barrier_post((unsigned*)(ws + WS_CTL) + CW_BAR + args.bar_sel * XCD_BAR_WORDS, (volatile LAS unsigned*)(lds + XBW_OFF));
    }
#define GRID_BAR() do { if (MK_ONE_LAUNCH) xcd_barrier(bar); } while (0)

    if (IN(0)) { ph_prologue(args, lds, bid, G); if (BOTH(0)) GRID_BAR(); }
    if (IN(1)) {
        const int gp = G > 192 ? 192 : G;
        if (bid < gp) {
            pg8::Gemm g{(const bf16*)(ws + WS_U), (const bf16*)(ws + WS_WIN), T, NP, DM}; pg8::StaticOrder S; S.init(T, NP, gp, bid);
            pg8::EpiStoreBf16 E{(bf16*)(ws + WS_PROJ), NP};
            pg8::gemm_phase<pg8::EpiStoreBf16, pg8::StaticOrder, true, true, false>(lds, g, S, E); }
        __syncthreads();
        moe_weight_queue<0>(args, lds, bid);
        if (BOTH(1)) GRID_BAR();
    }
    if (IN(3)) { ph_ssd_local(args, lds, bid, G); if (BOTH(3)) GRID_BAR(); }
    if (IN(4)) { ph_scan(args, bid, G); if (BOTH(4)) GRID_BAR(); }
    if (IN(5)) { ph_ssd_out(args, lds, bid, G); ph_attn(args, lds, bid, G); if (BOTH(5)) GRID_BAR(); }
    if (IN(7)) {
        __syncthreads();
        pg8::Gemm g{(const bf16*)(ws + WS_CAT), (const bf16*)(ws + WS_WOUT), T, DM, DM}; pg8::StaticOrder S; S.init(T, DM, G, bid);
        LAS float* r1 = (LAS float*)(lds + TAB_OFF); LAS float* r2 = r1 + 256;
        { pg8::Unit u0; if (S.next(0, u0) && tid < 256) { const size_t row = (size_t)u0.pm * 256 + tid; const float* sd = (const float*)(ws + WS_SSSD) + row * 2; const float* sa = (const float*)(ws + WS_SSAT) + row * 8;
            const float s1 = sd[0] + sd[1], s2 = ((sa[0] + sa[1]) + (sa[2] + sa[3])) + ((sa[4] + sa[5]) + (sa[6] + sa[7]));
            r1[tid] = rsqrtf(s1 * (1.f / 512) + EPS); r2[tid] = rsqrtf(s2 * (1.f / 512) + EPS); } }
        __syncthreads();
        pg8::EpiResScale E{(bf16*)(ws + WS_H), DM, r1, r2};
        pg8::gemm_phase<pg8::EpiResScale, pg8::StaticOrder, false, true, false>(lds, g, S, E);
        if (BOTH(7)) GRID_BAR();
    }
    if (IN(8)) { ph_router(args, lds, bid, G); if (BOTH(8)) GRID_BAR(); }
    if (IN(9)) {
        moe_setup(args, lds, 8, G, bid, true, 1024u, false);
        pg8::Gemm g{(const bf16*)(ws + WS_U2), (const bf16*)(ws + WS_W1), MAXROWS, NE * 2048, DM / 2};
        pg8::MoeOrder S{(const LAS int*)(lds + TB_UNITS), (const LAS unsigned*)(lds + TB_ROWTAB), __builtin_amdgcn_readfirstlane(*(const LAS int*)(lds + TB_MISC + 4))};
        pg8::EpiSwiglu E{ws + WS_ACT, (const LAS float*)(lds + 131072), 1.f / W8_SCALE, ACT8_SCALE};
        pg8::gemm_phase<pg8::EpiSwiglu, pg8::MoeOrder, true, true, true, true>(lds, g, S, E);
        moe_weight_queue<1>(args, lds, bid);
        if (BOTH(9)) GRID_BAR();
    }
    if (IN(10)) {
        moe_setup(args, lds, 4, G, bid, true, 1024u, true);
        pg8::Gemm g{(const bf16*)(ws + WS_ACT), (const bf16*)(ws + WS_W2), MAXROWS, NE * 1024, DM / 2};
        pg8::MoeOrder S{(const LAS int*)(lds + TB_UNITS), (const LAS unsigned*)(lds + TB_ROWTAB), __builtin_amdgcn_readfirstlane(*(const LAS int*)(lds + TB_MISC + 4))};
        pg8::EpiMoe2 E{ws + WS_YS, (const LAS float*)(lds + 131072), (const LAS float*)(lds + 131072) + 5 * 256, 1.f / (W8_SCALE * ACT8_SCALE), YS8_SCALE};
        pg8::gemm_phase<pg8::EpiMoe2, pg8::MoeOrder, true, true, true, true>(lds, g, S, E);
        if (BOTH(10)) GRID_BAR();
    }
    if (IN(11)) { ph_final(args, lds, bid, G); }
#undef IN
#undef BOTH
}

extern "C" void kernel_launch(void* const* d_in, const int* in_sizes, int n_in, void* d_out, int out_size, void* d_ws, size_t ws_size, hipStream_t stream) {
    static int grid = 0;
    if (grid == 0) {
        if (n_in != 21 || out_size != T * DM || ws_size < WS_END) { fprintf(stderr, "kernel_launch: unexpected shapes (n_in %d out %d ws %zu)\n", n_in, out_size, ws_size); grid = -1; return; }
        int dev = 0, cus = 0, per_cu = 0;
        if (hipGetDevice(&dev) != hipSuccess || hipDeviceGetAttribute(&cus, hipDeviceAttributeMultiprocessorCount, dev) != hipSuccess) { grid = -1; return; }
        if (hipFuncSetAttribute((const void*)mk_fwd, hipFuncAttributeMaxDynamicSharedMemorySize, LDS_BYTES) != hipSuccess) { fprintf(stderr, "kernel_launch: hipFuncSetAttribute failed\n"); grid = -1; return; }
        if (hipOccupancyMaxActiveBlocksPerMultiprocessor(&per_cu, (const void*)mk_fwd, NT, LDS_BYTES) != hipSuccess || per_cu < 1) { fprintf(stderr, "kernel_launch: occupancy query says %d blocks per CU\n", per_cu); }
        (void)hipGetLastError();
        grid = cus;
    }
    if (grid < 0) return;
    if (hipMemsetAsync((char*)d_ws + WS_CTL, 0, 65536, stream) != hipSuccess) return;
    Args a{};
    for (int i = 0; i < 21; ++i) a.in[i] = (const float*)d_in[i];
    a.out = (float*)d_out; a.ws = (unsigned char*)d_ws;
#if MK_ONE_LAUNCH
    a.ph_lo = 0; a.ph_hi = NPH;
    hipLaunchKernelGGL(mk_fwd, dim3(grid), dim3(NT), LDS_BYTES, stream, a);
#if defined(PROBE_LO)
    a.ph_lo = PROBE_LO; a.ph_hi = PROBE_HI; a.bar_sel = 1;
    hipLaunchKernelGGL(mk_fwd, dim3(grid), dim3(NT), LDS_BYTES, stream, a);
#endif
#if defined(PROBE_LO2)
    a.ph_lo = PROBE_LO2; a.ph_hi = PROBE_HI2; a.bar_sel = 2;
    hipLaunchKernelGGL(mk_fwd, dim3(grid), dim3(NT), LDS_BYTES, stream, a);
#endif
#else
    for (int ph = 0; ph < NPH; ++ph) { a.ph_lo = ph; a.ph_hi = ph + 1; hipLaunchKernelGGL(mk_fwd, dim3(grid), dim3(NT), LDS_BYTES, stream, a); }
#endif
}
```

```cpp
#include <hip/hip_runtime.h>
#include <cstdio>
#include <cstdint>

#ifndef MK_ONE_LAUNCH
#define MK_ONE_LAUNCH 1
#endif

constexpr int BATCH = 8, SEQ = 2048, T = BATCH * SEQ, DM = 1024, DPROJ = 2312;
constexpr int NCH = SEQ / 128;
constexpr int NE = 32, TOPK = 4;
constexpr int O_DT = 1536;
constexpr int NP = 2304;
constexpr int PZ = 0, PXBC = 512, PQ = 1536, PK = 2048, PV = 2176;
constexpr float EPS = 1e-5f;
constexpr int NT = 512;
constexpr int MAXROWS = T * TOPK + NE * 256;
constexpr int NPH = 12;

__constant__ int c_bucket[129] = {0, 1, 2, 3, 4, 5, 6, 7, 8, 9, 10, 11, 12, 13, 14, 15, 16, 16, 16, 17, 17, 18, 18, 18, 19, 19, 19, 20, 20, 20, 20, 21, 21, 21, 21, 22, 22, 22, 22, 22, 23, 23, 23, 23, 23, 23, 24, 24, 24, 24, 24, 24, 25, 25, 25, 25, 25, 25, 25, 26, 26, 26, 26, 26, 26, 26, 26, 27, 27, 27, 27, 27, 27, 27, 27, 27, 27, 28, 28, 28, 28, 28, 28, 28, 28, 28, 28, 29, 29, 29, 29, 29, 29, 29, 29, 29, 29, 29, 29, 30, 30, 30, 30, 30, 30, 30, 30, 30, 30, 30, 30, 30, 30, 31, 31, 31, 31, 31, 31, 31, 31, 31, 31, 31, 31, 31, 31, 31, 31};

constexpr size_t MiB = 1ull << 20;
constexpr size_t WS_CTL = 0, CTL_ZERO_BYTES = 1 * MiB;
constexpr int CW_BAR = 4096;
static_assert((CW_BAR + 3 * 3456) * 4 <= 65536, "control words inside the per-call memset");
constexpr size_t WS_WIN = 1 * MiB;
constexpr size_t WS_WOUT = WS_WIN + (size_t)NP * DM * 2;
constexpr size_t WS_W1 = WS_WOUT + (size_t)DM * DM * 2;
constexpr size_t WS_W2 = WS_W1 + (size_t)NE * 2048 * 1024 * 2;
constexpr size_t WS_U = WS_W2 + (size_t)NE * 1024 * 1024 * 2;
constexpr size_t WS_DTRAW = WS_U + (size_t)T * DM * 2;
constexpr size_t WS_PROJ = WS_DTRAW + (size_t)T * 8 * 4;
constexpr size_t WS_XC = WS_PROJ + (size_t)T * NP * 2;
constexpr size_t WS_DT = WS_XC + (size_t)T * 1024 * 4;
constexpr size_t WS_ACUM = WS_DT + (size_t)T * 8 * 4;
constexpr size_t WS_CDEC = WS_ACUM + (size_t)T * 8 * 4;
constexpr size_t WS_STATES = WS_CDEC + 1 * MiB;
constexpr size_t WS_PREV = WS_STATES + (size_t)BATCH * NCH * 8 * 8192 * 4;
constexpr size_t WS_YG = WS_PREV + (size_t)BATCH * NCH * 8 * 8192 * 4;
constexpr size_t WS_YGB = WS_YG;
constexpr size_t WS_SSSD = WS_YG + (size_t)T * 512 * 2;
constexpr size_t WS_AO = WS_YG + (size_t)T * 512 * 4;
constexpr size_t WS_SSAT = WS_AO + (size_t)T * 512 * 2;
constexpr size_t WS_CAT = WS_SSAT + (size_t)T * 8 * 4;
constexpr size_t WS_H = WS_CAT + (size_t)T * DM * 2;
constexpr size_t WS_U2 = WS_H + (size_t)T * DM * 4;
constexpr size_t WS_TOKE = WS_U2 + (size_t)T * DM * 2;
constexpr size_t WS_TOKS = WS_TOKE + (size_t)T * 4 * 4;
constexpr size_t WS_LTOK = WS_TOKS + (size_t)T * 4 * 4;
constexpr size_t WS_LGATE = WS_LTOK + (size_t)NE * T * 4;
constexpr size_t WS_ACT = WS_LGATE + (size_t)NE * T * 4;
constexpr size_t WS_YS = WS_ACT + (size_t)MAXROWS * 1024 * 2;
constexpr size_t WS_END = WS_YS + (size_t)MAXROWS * 1024 * 2;
static_assert(WS_END <= 1024 * MiB, "workspace");

constexpr int SCR_BYTES = 143360;
constexpr int TAB_OFF = SCR_BYTES;
constexpr int TB_CNT = TAB_OFF, TB_PTILE = TAB_OFF + 128, TB_RE = TAB_OFF + 272, TB_TSTART = TAB_OFF + 400, TB_MISC = TAB_OFF + 544, TB_UNITS = TAB_OFF + 576, TB_ROWTAB = TAB_OFF + 1024;
constexpr int XBW_OFF = TB_ROWTAB + 9 * 256 * 4;
constexpr int LDS_BYTES = 163840;
static_assert(XBW_OFF + 16 <= LDS_BYTES && XBW_OFF % 16 == 0, "LDS map");

#define GAS __attribute__((address_space(1)))
#define LAS __attribute__((address_space(3)))
typedef unsigned short bf16;
typedef unsigned v4u __attribute__((ext_vector_type(4)));
#define LDS_WAIT() asm volatile("s_waitcnt lgkmcnt(0)" ::: "memory")
#define VM_WAIT() asm volatile("s_waitcnt vmcnt(0)" ::: "memory")
__device__ __forceinline__ unsigned f2bf(float f) { unsigned u = __builtin_bit_cast(unsigned, f); return (u + 0x7fffu + ((u >> 16) & 1u)) >> 16; }
__device__ __forceinline__ unsigned pk2(float lo, float hi) { return f2bf(lo) | (f2bf(hi) << 16); }
__device__ __forceinline__ float bf2f(unsigned short b) { return __uint_as_float((unsigned)b << 16); }
__device__ __forceinline__ float bflo(unsigned w) { return __uint_as_float(w << 16); }
__device__ __forceinline__ float bfhi(unsigned w) { return __uint_as_float(w & 0xffff0000u); }

namespace pg8 {
#define PG8_LAS __attribute__((address_space(3)))
typedef unsigned short bf16_t;
typedef short bf16x8 __attribute__((ext_vector_type(8)));
typedef float f32x4 __attribute__((ext_vector_type(4)));
typedef unsigned u32x4 __attribute__((ext_vector_type(4)));
typedef unsigned u32x2 __attribute__((ext_vector_type(2)));
typedef int i32x8 __attribute__((ext_vector_type(8)));
typedef int i32x4 __attribute__((ext_vector_type(4)));
constexpr int BM = 256, BK = 64, HALF = 128, HTB = HALF * BK * 2  , STAGE_BYTES = 8 * HTB, NXCD = 8, WGM = 8;

__host__ __device__ __forceinline__ int lds_byte(int r, int c) { const int st = (r >> 4) * 2 + (c >> 5), rr = r & 15, cc = c & 31, ob = rr * 64 + cc * 2; return st * 1024 + (ob ^ (((ob >> 9) & 1) << 5)); }
__host__ __device__ __forceinline__ void stage_rc(int b, int& R, int& C) { const int st = b / 1024, sb = b % 1024, swz = sb ^ (((sb >> 9) & 1) << 5); R = (st >> 1) * 16 + swz / 64; C = (st & 1) * 32 + (swz % 64) / 2; }
__host__ __device__ __forceinline__ int perm32(int rho) { const int n = rho >> 4, i = rho & 15; return 8 * (i >> 2) + 4 * n + (i & 3); }

struct Unit { int pm, pn, rid; };
struct Gemm { const bf16_t* A; const bf16_t* Bt; int M, N, K; };

struct StaticOrder {
    int nM, nN, nwg, G, c;
    __host__ __device__ __forceinline__ void init(int M, int N, int G_, int c_) { nM = M / BM; nN = N / BM; nwg = nM * nN; G = G_; c = c_; }
    __host__ __device__ __forceinline__ bool next(int i, Unit& u) const {
        const long L = (long)i * G + c; if (L >= nwg) return false;
        int wgid = (int)L; { const int q = nwg / NXCD, r = nwg % NXCD, xcd = wgid % NXCD, off = wgid / NXCD; wgid = (xcd < r ? xcd * (q + 1) : r * (q + 1) + (xcd - r) * q) + off; }
        const int nig = WGM * nN, gid = wgid / nig, fm = gid * WGM, gsz = (nM - fm) < WGM ? (nM - fm) : WGM;
        u.pm = fm + ((wgid % nig) % gsz); u.pn = (wgid % nig) / gsz; u.rid = 0; return true;
    }
    __device__ __forceinline__ void a_ready(const Unit&) const {}
    __device__ __forceinline__ void done(const Unit&) const {}
};


typedef float f32x2 __attribute__((ext_vector_type(2)));
__device__ __forceinline__ unsigned cvt_pk_bf16(float lo, float hi) { unsigned r; asm volatile("v_cvt_pk_bf16_f32 %0, %1, %2" : "=v"(r) : "v"(lo), "v"(hi)); return r; }

struct EpiStoreBf16 {
    static constexpr bool PERM = true, AFTER_DRAIN = false, HAS_MID = false;
    bf16_t* O; int ldc;
    __device__ __forceinline__ void operator()(const f32x4 (&acc)[2][2][4][2], const Unit& u, int wr, int wc, int fr, int fq) const {
        const int row0 = u.pm * BM + wr * 64 + fr, col0 = u.pn * BM + wc * 32 + 8 * fq;
#pragma unroll
        for (int ai = 0; ai < 2; ++ai)
#pragma unroll
            for (int m = 0; m < 4; ++m) { bf16_t* rowp = O + (size_t)(row0 + ai * HALF + m * 16) * ldc + col0;
#pragma unroll
                for (int bj = 0; bj < 2; ++bj) { const f32x4 v0 = acc[ai][bj][m][0], v1 = acc[ai][bj][m][1];
                    u32x4 w; w.x = cvt_pk_bf16(v0[0], v0[1]); w.y = cvt_pk_bf16(v0[2], v0[3]); w.z = cvt_pk_bf16(v1[0], v1[1]); w.w = cvt_pk_bf16(v1[2], v1[3]);
                    *(u32x4*)(rowp + bj * HALF) = w; } }
    }
};
struct EpiResF32 {
    static constexpr bool PERM = false, AFTER_DRAIN = false, HAS_MID = false;
    const float* __restrict__ base; float* __restrict__ C; int ldc;
    __device__ __forceinline__ void operator()(const f32x4 (&acc)[2][2][4][2], const Unit& u, int wr, int wc, int fr, int fq) const {
        const int row0 = u.pm * BM + wr * 64 + fr, col0 = u.pn * BM + wc * 32 + 4 * fq;
#pragma unroll
        for (int ai = 0; ai < 2; ++ai)
#pragma unroll
            for (int m = 0; m < 4; ++m) { const size_t off = (size_t)(row0 + ai * HALF + m * 16) * ldc + col0; f32x4 bs[2][2];
#pragma unroll
                for (int bj = 0; bj < 2; ++bj)
#pragma unroll
                    for (int n = 0; n < 2; ++n) bs[bj][n] = __builtin_nontemporal_load((const f32x4*)(base + off + bj * HALF + n * 16));
#pragma unroll
                for (int bj = 0; bj < 2; ++bj)
#pragma unroll
                    for (int n = 0; n < 2; ++n) *(f32x4*)(C + off + bj * HALF + n * 16) = bs[bj][n] + acc[ai][bj][m][n]; }
    }
};
struct EpiResScale {
    static constexpr bool PERM = true, AFTER_DRAIN = false, HAS_MID = true;
    bf16_t* D; int ldc; const PG8_LAS float* r1; const PG8_LAS float* r2;
    __device__ __forceinline__ void mid(f32x4 (&acc)[2][2][4][2], const Unit&, int wr, int, int fr, int) const {
#pragma unroll
        for (int ai = 0; ai < 2; ++ai)
#pragma unroll
            for (int m = 0; m < 4; ++m) { const int rl = ai * HALF + wr * 64 + m * 16 + fr; const float f = r1[rl] / r2[rl];
#pragma unroll
                for (int bj = 0; bj < 2; ++bj)
#pragma unroll
                    for (int n = 0; n < 2; ++n) acc[ai][bj][m][n] *= f; }
    }
    __device__ __forceinline__ void operator()(const f32x4 (&acc)[2][2][4][2], const Unit& u, int wr, int wc, int fr, int fq) const {
        const int row0 = u.pm * BM + wr * 64 + fr, col0 = u.pn * BM + wc * 32 + 8 * fq;
#pragma unroll
        for (int ai = 0; ai < 2; ++ai)
#pragma unroll
            for (int m = 0; m < 4; ++m) { bf16_t* rowp = D + (size_t)(row0 + ai * HALF + m * 16) * ldc + col0; const float f = r2[ai * HALF + wr * 64 + m * 16 + fr];
#pragma unroll
                for (int bj = 0; bj < 2; ++bj) { const f32x4 v0 = acc[ai][bj][m][0] * f, v1 = acc[ai][bj][m][1] * f;
                    u32x4 w; w.x = cvt_pk_bf16(v0[0], v0[1]); w.y = cvt_pk_bf16(v0[2], v0[3]); w.z = cvt_pk_bf16(v1[0], v1[1]); w.w = cvt_pk_bf16(v1[2], v1[3]);
                    *(u32x4*)(rowp + bj * HALF) = w; } }
    }
};
struct EpiSwiglu {
    static constexpr bool PERM = true, AFTER_DRAIN = false, HAS_MID = false;
    unsigned char* act; const PG8_LAS float* btab; float dq, asc;
    __device__ __forceinline__ void operator()(const f32x4 (&acc)[2][2][4][2], const Unit& u, int wr, int wc, int fr, int fq) const {
        const int e = u.pn >> 3, ct = u.pn & 7, colo = ct * 128 + wc * 32 + 8 * fq;
        const PG8_LAS float* bg = btab + u.rid * 256 + wc * 32 + 8 * fq; (void)e;
        const f32x4 g0 = *(const PG8_LAS f32x4*)bg, g1 = *(const PG8_LAS f32x4*)(bg + 4), l0 = *(const PG8_LAS f32x4*)(bg + 128), l1 = *(const PG8_LAS f32x4*)(bg + 132);
        const int row0 = u.pm * BM + wr * 64 + fr;
#pragma unroll
        for (int ai = 0; ai < 2; ++ai)
#pragma unroll
            for (int m = 0; m < 4; ++m) {
                const f32x4 xg[2] = {acc[ai][0][m][0] * dq + g0, acc[ai][0][m][1] * dq + g1}; const f32x4 xl[2] = {acc[ai][1][m][0] * dq + l0, acc[ai][1][m][1] * dq + l1};
                float o[8];
#pragma unroll
                for (int q = 0; q < 4; ++q) {
                    f32x2 a2 = {xg[q >> 1][2 * (q & 1)], xg[q >> 1][2 * (q & 1) + 1]}, b2 = {xl[q >> 1][2 * (q & 1)], xl[q >> 1][2 * (q & 1) + 1]};
                    a2 = __builtin_elementwise_min(a2, (f32x2){7.f, 7.f}); b2 = __builtin_elementwise_min(__builtin_elementwise_max(b2, (f32x2){-7.f, -7.f}), (f32x2){7.f, 7.f});
                    const f32x2 t2 = a2 * (-1.702f * 1.4426950408889634f); f32x2 e2; e2.x = __builtin_amdgcn_exp2f(t2.x); e2.y = __builtin_amdgcn_exp2f(t2.y);
                    const f32x2 d2 = e2 + 1.f; f32x2 r2; r2.x = __builtin_amdgcn_rcpf(d2.x); r2.y = __builtin_amdgcn_rcpf(d2.y);
                    const f32x2 o2 = (a2 * r2) * (b2 * asc + asc); o[2 * q] = o2.x; o[2 * q + 1] = o2.y; }
                int w0 = 0, w1 = 0; w0 = __builtin_amdgcn_cvt_pk_fp8_f32(o[0], o[1], w0, false); w0 = __builtin_amdgcn_cvt_pk_fp8_f32(o[2], o[3], w0, true);
                w1 = __builtin_amdgcn_cvt_pk_fp8_f32(o[4], o[5], w1, false); w1 = __builtin_amdgcn_cvt_pk_fp8_f32(o[6], o[7], w1, true);
                u32x2 w; w.x = (unsigned)w0; w.y = (unsigned)w1;
                *(u32x2*)(act + (size_t)(row0 + ai * HALF + m * 16) * 1024 + colo) = w; }
    }
};
struct EpiMoe2 {
    static constexpr bool PERM = true, AFTER_DRAIN = false, HAS_MID = false;
    unsigned char* ys; const PG8_LAS float* btab; const PG8_LAS float* gtab; float dq, ysc;
    __device__ __forceinline__ void operator()(const f32x4 (&acc)[2][2][4][2], const Unit& u, int wr, int wc, int fr, int fq) const {
        const int e = u.pn >> 2, ct = u.pn & 3, colb = ct * 256 + wc * 32 + 8 * fq;
        (void)e;
        f32x4 bv[2][2];
#pragma unroll
        for (int bj = 0; bj < 2; ++bj)
#pragma unroll
            for (int n = 0; n < 2; ++n) bv[bj][n] = *(const PG8_LAS f32x4*)(btab + u.rid * 256 + bj * HALF + wc * 32 + 8 * fq + 4 * n);
        const int row0 = u.pm * BM + wr * 64 + fr;
#pragma unroll
        for (int ai = 0; ai < 2; ++ai)
#pragma unroll
            for (int m = 0; m < 4; ++m) { const float gt = gtab[u.rid * 256 + ai * HALF + wr * 64 + m * 16 + fr] * ysc;
                unsigned char* rowp = ys + (size_t)(row0 + ai * HALF + m * 16) * 1024 + colb;
#pragma unroll
                for (int bj = 0; bj < 2; ++bj) { f32x4 v0 = (acc[ai][bj][m][0] * dq + bv[bj][0]) * gt, v1 = (acc[ai][bj][m][1] * dq + bv[bj][1]) * gt;
                    v0 = __builtin_elementwise_min(__builtin_elementwise_max(v0, (f32x4){-440.f, -440.f, -440.f, -440.f}), (f32x4){440.f, 440.f, 440.f, 440.f});
                    v1 = __builtin_elementwise_min(__builtin_elementwise_max(v1, (f32x4){-440.f, -440.f, -440.f, -440.f}), (f32x4){440.f, 440.f, 440.f, 440.f});
                    int w0 = 0, w1 = 0; w0 = __builtin_amdgcn_cvt_pk_fp8_f32(v0[0], v0[1], w0, false); w0 = __builtin_amdgcn_cvt_pk_fp8_f32(v0[2], v0[3], w0, true);
                    w1 = __builtin_amdgcn_cvt_pk_fp8_f32(v1[0], v1[1], w1, false); w1 = __builtin_amdgcn_cvt_pk_fp8_f32(v1[2], v1[3], w1, true);
                    u32x2 w; w.x = (unsigned)w0; w.y = (unsigned)w1; *(u32x2*)(rowp + bj * HALF) = w; } }
    }
};
struct MoeOrder {
    const PG8_LAS int* units; const PG8_LAS unsigned* rowtab; int nr;
    __device__ __forceinline__ bool next(int i, Unit& u) const {
        if (i >= nr) return false;
        const int pm = __builtin_amdgcn_readfirstlane(units[2 * i]); if (pm < 0) return false;
        u.pm = pm; u.pn = __builtin_amdgcn_readfirstlane(units[2 * i + 1]); u.rid = i; return true;
    }
    __device__ __forceinline__ unsigned arow(const Unit& u, int r) const { return rowtab[u.rid * 256 + r]; }
    __device__ __forceinline__ void a_ready(const Unit&) const {}
    __device__ __forceinline__ void done(const Unit&) const {}
};

template <class Epi, class Sched, bool ALIGN_EPI = false, bool SP2 = false, bool GATHER = false, bool FP8 = false>
__device__ __forceinline__ void gemm_phase(PG8_LAS unsigned char* lds, const Gemm g, const Sched& S, const Epi& E) {
    const int tid = threadIdx.x, wid = __builtin_amdgcn_readfirstlane(tid >> 6), lane = tid & 63, wr = wid >> 2, wc = wid & 3, fr = lane & 15, fq = lane >> 4;
    const int K = g.K, nt = K / BK;
    unsigned voffA[2], voffB[2];
#pragma unroll
    for (int i = 0; i < 2; ++i) { int R, C; stage_rc(tid * 16 + i * 8192, R, C); const int Rb = Epi::PERM ? ((R & ~31) + perm32(R & 31)) : R;
        voffA[i] = (unsigned)(R * K + C) * 2u; voffB[i] = (unsigned)(Rb * K + C) * 2u; }
    const size_t kstep = (size_t)(BK * 2);
    const size_t hstep = (size_t)HALF * K * 2;
    const size_t tstep = 2 * hstep;
    const unsigned ldsw = (unsigned)wid * 1024u;
    const int aoff = lds_byte(wr * 64 + fr, fq * 8), boff = lds_byte(wc * 32 + fr, fq * 8);
#define PG8_SA(b, h) (((b) * 2 + (h)) * HTB)
#define PG8_SB(b, h) ((4 + (b) * 2 + (h)) * HTB)
#define PG8_STAGE(bufoff, gbase, voff) do { _Pragma("unroll") for (int _i = 0; _i < 2; ++_i) \
        __builtin_amdgcn_global_load_lds((const unsigned*)((const char*)(gbase) + (voff)[_i]), (PG8_LAS unsigned*)(lds + (bufoff) + ldsw + _i * 8192), 16, 0, 0); } while (0)
#define PG8_STAGE_A(b, h, U, koff) do { if constexpr (GATHER) { PG8_STAGE(PG8_SA(b, h), Ab + (koff), c_ao[h]); } else { PG8_STAGE(PG8_SA(b, h), U##_A + (size_t)(h) * hstep + (koff), voffA); } } while (0)
#define PG8_LDA(dst, b, h) do { _Pragma("unroll") for (int m = 0; m < 4; ++m) _Pragma("unroll") for (int k = 0; k < 2; ++k) dst[m][k] = *(const PG8_LAS bf16x8*)(lds + PG8_SA(b, h) + aoff + m * 2048 + k * 1024); } while (0)
#define PG8_LDB(dst, b, h) do { _Pragma("unroll") for (int n = 0; n < 2; ++n) _Pragma("unroll") for (int k = 0; k < 2; ++k) dst[n][k] = *(const PG8_LAS bf16x8*)(lds + PG8_SB(b, h) + boff + n * 2048 + k * 1024); } while (0)
#define PG8_MMA(ai, bj, At, Bt) do { __builtin_amdgcn_s_setprio(1); _Pragma("unroll") for (int m = 0; m < 4; ++m) _Pragma("unroll") for (int n = 0; n < 2; ++n) { \
        if constexpr (FP8) { const i32x8 ub_ = __builtin_shufflevector(__builtin_bit_cast(i32x4, Bt[n][0]), __builtin_bit_cast(i32x4, Bt[n][1]), 0, 1, 2, 3, 4, 5, 6, 7); \
            const i32x8 ua_ = __builtin_shufflevector(__builtin_bit_cast(i32x4, At[m][0]), __builtin_bit_cast(i32x4, At[m][1]), 0, 1, 2, 3, 4, 5, 6, 7); \
            acc[ai][bj][m][n] = __builtin_amdgcn_mfma_scale_f32_16x16x128_f8f6f4(ub_, ua_, acc[ai][bj][m][n], 0, 0, 0, 0x7f7f7f7f, 0, 0x7f7f7f7f); } \
        else { _Pragma("unroll") for (int k = 0; k < 2; ++k) acc[ai][bj][m][n] = __builtin_amdgcn_mfma_f32_16x16x32_bf16(Bt[n][k], At[m][k], acc[ai][bj][m][n], 0, 0, 0); } } \
        __builtin_amdgcn_s_setprio(0); } while (0)
#define PG8_WAIT_V(n) asm volatile("s_waitcnt vmcnt(" #n ")" ::: "memory")
#define PG8_WAIT_L(n) asm volatile("s_waitcnt lgkmcnt(" #n ")" ::: "memory")
#define PG8_BAR __builtin_amdgcn_s_barrier()
#define PG8_SCHED __builtin_amdgcn_sched_barrier(0)
    Unit cur, nxt; int ui = 0;
    if (!S.next(0, cur)) return;
    f32x4 acc[2][2][4][2];
#pragma unroll
    for (int a = 0; a < 2; ++a)
#pragma unroll
        for (int b = 0; b < 2; ++b)
#pragma unroll
            for (int m = 0; m < 4; ++m)
#pragma unroll
                for (int n = 0; n < 2; ++n) acc[a][b][m][n] = (f32x4){0.f, 0.f, 0.f, 0.f};
    bf16x8 At[4][2], B0[2][2], B1[2][2];
    const char* const Ab = (const char*)g.A; (void)Ab;
    unsigned c_ao[2][2] = {{0u, 0u}, {0u, 0u}}; (void)c_ao;
    int RA0, CA0; stage_rc(tid * 16, RA0, CA0);
    const char* c_A = (const char*)g.A + (size_t)cur.pm * tstep; const char* cB = (const char*)g.Bt + (size_t)cur.pn * tstep;
    if constexpr (GATHER) { _Pragma("unroll") for (int h_ = 0; h_ < 2; ++h_) _Pragma("unroll") for (int i_ = 0; i_ < 2; ++i_) c_ao[h_][i_] = S.arow(cur, h_ * HALF + RA0 + i_ * 64) + (unsigned)CA0 * 2u; }
    S.a_ready(cur);
    if constexpr (SP2) {
        PG8_STAGE(PG8_SB(0, 0), cB, voffB); PG8_STAGE(PG8_SB(0, 1), cB + hstep, voffB); PG8_STAGE_A(0, 0, c, (size_t)0); PG8_STAGE_A(0, 1, c, (size_t)0);
        if (wr == 1) PG8_BAR;
        PG8_WAIT_V(2); PG8_BAR;
        PG8_STAGE(PG8_SB(1, 0), cB + kstep, voffB); PG8_STAGE_A(1, 0, c, kstep); PG8_STAGE(PG8_SB(1, 1), cB + hstep + kstep, voffB);
        PG8_WAIT_V(6); PG8_BAR;
    } else {
        PG8_STAGE(PG8_SB(0, 0), cB, voffB); PG8_STAGE_A(0, 0, c, (size_t)0); PG8_STAGE(PG8_SB(0, 1), cB + hstep, voffB); PG8_STAGE_A(0, 1, c, (size_t)0);
        if (wr == 1) PG8_BAR;
        PG8_WAIT_V(4); PG8_BAR;
        PG8_STAGE(PG8_SB(1, 0), cB + kstep, voffB); PG8_STAGE_A(1, 0, c, kstep); PG8_STAGE(PG8_SB(1, 1), cB + hstep + kstep, voffB);
        PG8_WAIT_V(6); PG8_BAR;
    }
    for (;;) {
        const bool has_next = S.next(ui + 1, nxt);
        const char* n_A = has_next ? (const char*)g.A + (size_t)nxt.pm * tstep : c_A; const char* nB = has_next ? (const char*)g.Bt + (size_t)nxt.pn * tstep : cB;
#pragma unroll 1
        for (int t = 0; t < nt; t += 2) {
            const bool last = (t == nt - 2);
            if constexpr (Epi::HAS_MID) { if (t == (nt >> 1)) E.mid(acc, cur, wr, wc, fr, fq); }
            const char* s_A = last ? n_A : c_A; const size_t k2 = last ? (size_t)0 : (size_t)(t + 2) * kstep; const char* b2 = last ? nB : cB + (size_t)(t + 2) * kstep;
            const char* b3 = b2 + kstep; (void)s_A;
            if (last && has_next) S.a_ready(nxt);
            if constexpr (SP2) {
            PG8_LDB(B0, 0, 0); PG8_LDB(B1, 0, 1); PG8_SCHED; PG8_LDA(At, 0, 0); PG8_STAGE_A(1, 1, c, (size_t)(t + 1) * kstep); if constexpr (GATHER) { if (last && has_next) { _Pragma("unroll") for (int h_ = 0; h_ < 2; ++h_) _Pragma("unroll") for (int i_ = 0; i_ < 2; ++i_) c_ao[h_][i_] = S.arow(nxt, h_ * HALF + RA0 + i_ * 64) + (unsigned)CA0 * 2u; } }
            PG8_WAIT_V(8); PG8_WAIT_L(0); PG8_BAR; PG8_MMA(0, 0, At, B0); PG8_MMA(0, 1, At, B1); PG8_BAR; PG8_SCHED;
            PG8_LDA(At, 0, 1); PG8_STAGE(PG8_SB(0, 0), b2, voffB); PG8_STAGE(PG8_SB(0, 1), b2 + hstep, voffB); PG8_STAGE_A(0, 0, s, k2);
            PG8_WAIT_V(8); PG8_WAIT_L(0); PG8_BAR; PG8_MMA(1, 0, At, B0); PG8_MMA(1, 1, At, B1); PG8_BAR; PG8_SCHED;
            PG8_LDB(B0, 1, 0); PG8_LDB(B1, 1, 1); PG8_SCHED; PG8_LDA(At, 1, 0); PG8_STAGE_A(0, 1, s, k2);
            PG8_WAIT_V(8); PG8_WAIT_L(0); PG8_BAR; PG8_MMA(0, 0, At, B0); PG8_MMA(0, 1, At, B1); PG8_BAR; PG8_SCHED;
            PG8_LDA(At, 1, 1); PG8_STAGE(PG8_SB(1, 0), b3, voffB); PG8_STAGE(PG8_SB(1, 1), b3 + hstep, voffB); PG8_STAGE_A(1, 0, s, k2 + kstep);
            PG8_WAIT_V(8); PG8_WAIT_L(0); PG8_BAR; PG8_MMA(1, 0, At, B0); PG8_MMA(1, 1, At, B1); PG8_BAR; PG8_SCHED;
            } else {
            PG8_LDB(B0, 0, 0); PG8_SCHED; PG8_LDA(At, 0, 0); PG8_STAGE_A(1, 1, c, (size_t)(t + 1) * kstep); if constexpr (GATHER) { if (last && has_next) { _Pragma("unroll") for (int h_ = 0; h_ < 2; ++h_) _Pragma("unroll") for (int i_ = 0; i_ < 2; ++i_) c_ao[h_][i_] = S.arow(nxt, h_ * HALF + RA0 + i_ * 64) + (unsigned)CA0 * 2u; } }
            PG8_WAIT_L(8); PG8_BAR; PG8_WAIT_L(0); PG8_MMA(0, 0, At, B0); PG8_BAR; PG8_SCHED;
            PG8_LDB(B1, 0, 1); PG8_STAGE(PG8_SB(0, 0), b2, voffB);
            PG8_BAR; PG8_WAIT_L(0); PG8_MMA(0, 1, At, B1); PG8_BAR;
            PG8_LDA(At, 0, 1); PG8_STAGE_A(0, 0, s, k2);
            PG8_BAR; PG8_WAIT_L(0); PG8_MMA(1, 0, At, B0); PG8_BAR; PG8_SCHED;
            PG8_STAGE(PG8_SB(0, 1), b2 + hstep, voffB);
            PG8_WAIT_V(6); PG8_BAR; PG8_MMA(1, 1, At, B1); PG8_BAR;
            PG8_LDB(B0, 1, 0); PG8_SCHED; PG8_LDA(At, 1, 0); PG8_STAGE_A(0, 1, s, k2);
            PG8_WAIT_L(8); PG8_BAR; PG8_WAIT_L(0); PG8_MMA(0, 0, At, B0); PG8_BAR; PG8_SCHED;
            PG8_LDB(B1, 1, 1); PG8_STAGE(PG8_SB(1, 0), b3, voffB);
            PG8_BAR; PG8_WAIT_L(0); PG8_MMA(0, 1, At, B1); PG8_BAR;
            PG8_LDA(At, 1, 1); PG8_STAGE_A(1, 0, s, k2 + kstep);
            PG8_BAR; PG8_WAIT_L(0); PG8_MMA(1, 0, At, B0); PG8_BAR; PG8_SCHED;
            PG8_STAGE(PG8_SB(1, 1), b3 + hstep, voffB);
            PG8_WAIT_V(6); PG8_BAR; PG8_MMA(1, 1, At, B1); PG8_BAR;
            }
        }
        if constexpr (ALIGN_EPI) { if (wr == 0) PG8_BAR; }
        if constexpr (!Epi::AFTER_DRAIN) { E(acc, cur, wr, wc, fr, fq); S.done(cur); }
        if (!has_next) break;
#pragma unroll
        for (int a = 0; a < 2; ++a)
#pragma unroll
            for (int b = 0; b < 2; ++b)
#pragma unroll
                for (int m = 0; m < 4; ++m)
#pragma unroll
                    for (int n = 0; n < 2; ++n) acc[a][b][m][n] = (f32x4){0.f, 0.f, 0.f, 0.f};
        cur = nxt; c_A = n_A; cB = nB; ++ui;
        if constexpr (ALIGN_EPI) { if (wr == 1) PG8_BAR; }
    }
    PG8_WAIT_V(0);
    if constexpr (!ALIGN_EPI) { if (wr == 0) PG8_BAR; }
    PG8_BAR;
    if constexpr (Epi::AFTER_DRAIN) { E.fused(acc, cur, wr, wc, fr, fq, lds, wid, lane); S.done(cur); }
#undef PG8_SA
#undef PG8_SB
#undef PG8_STAGE
#undef PG8_STAGE_A
#undef PG8_LDA
#undef PG8_LDB
#undef PG8_MMA
#undef PG8_WAIT_V
#undef PG8_WAIT_L
#undef PG8_BAR
#undef PG8_SCHED
}
}

#define XB_TMO      128
#define XB_XCNT(j)  (256  + 64 * (j))
#define XB_XSUB(j)  (1280 + 64 * (j))
#define XB_XGEN(j)  (2304 + 64 * (j))
#define XB_TOP      3328
#define XB_TOPGEN   3392
#define XCD_BAR_WORDS 3456
#define XB_SPIN_CAP (1u << 18)

__device__ __forceinline__ unsigned xb_ld(unsigned* p)              { return __hip_atomic_load(p, __ATOMIC_RELAXED, __HIP_MEMORY_SCOPE_AGENT); }
__device__ __forceinline__ unsigned xb_add(unsigned* p, unsigned v) { return __hip_atomic_fetch_add(p, v, __ATOMIC_RELAXED, __HIP_MEMORY_SCOPE_AGENT); }
__device__ __forceinline__ unsigned xb_xcc_id() { return (unsigned)__builtin_amdgcn_s_getreg((3 << 11) | 20) & 0xFu; }
#define XB_SPIN(cond, bar) do { unsigned _sp = 0; while (cond) { __builtin_amdgcn_s_sleep(1); \
    if ((++_sp & 255u) == 0u) { if (xb_ld(&(bar)[XB_TMO])) break; if (_sp > XB_SPIN_CAP) { atomicAdd(&(bar)[XB_TMO], 1u); break; } } } } while (0)

struct XcdBarrier {
    unsigned* bar; unsigned x;
    volatile LAS unsigned* st;
};

__device__ __forceinline__ XcdBarrier xcd_barrier_post(unsigned* bar, volatile LAS unsigned* st) {
    XcdBarrier b; b.bar = bar; b.x = xb_xcc_id(); b.st = st;
    if (threadIdx.x == 0) (void)xb_add(&bar[XB_XCNT(b.x)], 1u);
    return b;
}
__device__ __forceinline__ void xcd_barrier_complete(unsigned* bar, unsigned x, unsigned& nloc, unsigned& nx) {
    const unsigned G = gridDim.x * gridDim.y * gridDim.z;
    unsigned sum, cnt, mine, sp = 0u;
    for (;;) {
        sum = 0u; cnt = 0u; mine = 0u;
#pragma unroll
        for (unsigned j = 0; j < 16; ++j) { const unsigned c = xb_ld(&bar[XB_XCNT(j)]); sum += c; cnt += (c > 0u) ? 1u : 0u; mine = (j == x) ? c : mine; }
        if (sum == G) break;
        __builtin_amdgcn_s_sleep(1);
        if ((++sp & 255u) == 0u) { if (xb_ld(&bar[XB_TMO])) break; if (sp > XB_SPIN_CAP) { atomicAdd(&bar[XB_TMO], 1u); break; } }
    }
    nloc = mine > 0u ? mine : 1u; nx = cnt > 0u ? cnt : 1u;
}

__device__ __forceinline__ void xcd_barrier(const XcdBarrier& b) {
    asm volatile("s_waitcnt vmcnt(0)" ::: "memory");
    __syncthreads();
    if (threadIdx.x == 0) {
        unsigned* bar = b.bar;
        __builtin_amdgcn_s_waitcnt(0);
        unsigned nloc = b.st[0], nx = b.st[1];
        if (nloc == 0u) { xcd_barrier_complete(bar, b.x, nloc, nx); b.st[0] = nloc; b.st[1] = nx; }
        const unsigned old = xb_add(&bar[XB_XSUB(b.x)], 1u);
        const unsigned gen = old / nloc;
        if (old + 1u == (gen + 1u) * nloc) {
            __builtin_amdgcn_fence(__ATOMIC_RELEASE, "agent");
            asm volatile("s_waitcnt vmcnt(0)" ::: "memory");
            const unsigned og = xb_add(&bar[XB_TOP], 1u);
            const unsigned tg = og / nx;
            if (og + 1u == (tg + 1u) * nx) xb_add(&bar[XB_TOPGEN], 1u);
            else XB_SPIN(xb_ld(&bar[XB_TOPGEN]) == tg, bar);
            __builtin_amdgcn_fence(__ATOMIC_ACQUIRE, "agent");
            xb_add(&bar[XB_XGEN(b.x)], 1u);
            asm volatile("s_waitcnt vmcnt(0)" ::: "memory");
        } else {
            XB_SPIN(xb_ld(&bar[XB_XGEN(b.x)]) == gen, bar);
            __builtin_amdgcn_fence(__ATOMIC_ACQUIRE, "agent");
            asm volatile("s_waitcnt vmcnt(0)" ::: "memory");
        }
    }
    __syncthreads();
}

typedef short bf16x8 __attribute__((ext_vector_type(8)));
typedef float f32x16 __attribute__((ext_vector_type(16)));
typedef float f32x4v __attribute__((ext_vector_type(4)));
typedef unsigned u32x2v __attribute__((ext_vector_type(2)));
struct Args { const float* in[21]; float* out; unsigned char* ws; int ph_lo, ph_hi, bar_sel, pad; };

__device__ __forceinline__ float wave_sum(float v) {
#pragma unroll
    for (int o = 1; o < 64; o <<= 1) v += __shfl_xor(v, o);
    return v;
}
__device__ __forceinline__ float wave_max(float v) {
#pragma unroll
    for (int o = 1; o < 64; o <<= 1) v = fmaxf(v, __shfl_xor(v, o));
    return v;
}
__device__ __forceinline__ float silu_f(float x) { return x / (1.f + __expf(-x)); }

template <bool GAIN>
__device__ __forceinline__ void cvt_item(const float* W, int ldw, int n0src, bf16* WT, int K, int drow0, int k0, LAS float* scr, int lane, const float* gk = nullptr) {
#pragma unroll 16
    for (int i = 0; i < 32; ++i) { const int kk = 2 * i + (lane >> 5); float v = W[(size_t)(k0 + kk) * ldw + n0src + (lane & 31)]; if (GAIN) v *= gk[kk]; scr[kk * 33 + (lane & 31)] = v; }
    LDS_WAIT(); asm volatile("" ::: "memory");
    const int c = lane & 7;
#pragma unroll
    for (int j = 0; j < 4; ++j) { const int n = (lane >> 3) + 8 * j; const LAS float* s = scr + (8 * c) * 33 + n;
        v4u o; o.x = pk2(s[0 * 33], s[1 * 33]); o.y = pk2(s[2 * 33], s[3 * 33]); o.z = pk2(s[4 * 33], s[5 * 33]); o.w = pk2(s[6 * 33], s[7 * 33]);
        *(GAS v4u*)(WT + (size_t)(drow0 + n) * K + k0 + 8 * c) = o; }
    LDS_WAIT(); asm volatile("" ::: "memory");
}
constexpr float W8_SCALE = 64.f, ACT8_SCALE = 4.f, YS8_SCALE = 16.f;
__device__ __forceinline__ unsigned pk4_fp8(float a, float b, float c, float d) { int w = 0; w = __builtin_amdgcn_cvt_pk_fp8_f32(a, b, w, false); w = __builtin_amdgcn_cvt_pk_fp8_f32(c, d, w, true); return (unsigned)w; }
__device__ __forceinline__ void cvt_item_fp8(const float* W, int ldw, int n0src, unsigned char* WT, int K, int drow0, int k0, LAS float* scr, int lane) {
#pragma unroll 16
    for (int i = 0; i < 32; ++i) { const int kk = 2 * i + (lane >> 5); scr[kk * 33 + (lane & 31)] = W[(size_t)(k0 + kk) * ldw + n0src + (lane & 31)] * W8_SCALE; }
    LDS_WAIT(); asm volatile("" ::: "memory");
    const int c = lane & 3;
#pragma unroll
    for (int j = 0; j < 2; ++j) { const int n = (lane >> 2) + 16 * j; const LAS float* s = scr + (16 * c) * 33 + n;
        v4u o; o.x = pk4_fp8(s[0 * 33], s[1 * 33], s[2 * 33], s[3 * 33]); o.y = pk4_fp8(s[4 * 33], s[5 * 33], s[6 * 33], s[7 * 33]);
        o.z = pk4_fp8(s[8 * 33], s[9 * 33], s[10 * 33], s[11 * 33]); o.w = pk4_fp8(s[12 * 33], s[13 * 33], s[14 * 33], s[15 * 33]);
        *(GAS v4u*)(WT + (size_t)(drow0 + n) * K + k0 + 16 * c) = o; }
    LDS_WAIT(); asm volatile("" ::: "memory");
}
__device__ __forceinline__ void ph_prologue(const Args& a, LAS unsigned char* lds, int bid, int nb) {
    const int tid = threadIdx.x, lane = tid & 63, wave = tid >> 6;
    unsigned char* ws = a.ws;
    LAS float* scr = (LAS float*)(lds + wave * 16384);
    const int gw = bid * 8 + wave, ngw = nb * 8;
    constexpr int I_IN = 16 * 72, I_OUT = 16 * 32;
    for (int it0 = gw; it0 < I_IN + I_OUT; it0 += ngw) {
        int it = it0;
        if (it < I_IN) { const int kb = it / 72, d0 = 32 * (it % 72); cvt_item<false>(a.in[2], DPROJ, d0 < 1536 ? d0 : d0 + 8, (bf16*)(ws + WS_WIN), DM, d0, 64 * kb, scr, lane); continue; }
        it -= I_IN;
        { const int kb = it / 32, d0 = 32 * (it % 32); cvt_item<true>(a.in[12], DM, d0, (bf16*)(ws + WS_WOUT), DM, d0, 64 * kb, scr, lane, (kb < 8 ? a.in[8] : a.in[11] - 512) + 64 * kb); }
    }
    __syncthreads();
    LAS float* wdt = (LAS float*)lds;
    for (int i = tid; i < 1024 * 8; i += NT) wdt[i] = a.in[2][(size_t)(i >> 3) * DPROJ + O_DT + (i & 7)];
    __syncthreads();
    const float* x = a.in[0]; const float* g = a.in[1]; bf16* u = (bf16*)(ws + WS_U); float* dtraw = (float*)(ws + WS_DTRAW);
    float wreg[16][8];
#pragma unroll
    for (int jc = 0; jc < 16; ++jc) { const LAS float* wd = wdt + (size_t)(4 * lane + 256 * (jc >> 2) + (jc & 3)) * 8; const f32x4v w0 = *(const LAS f32x4v*)wd, w1 = *(const LAS f32x4v*)(wd + 4);
        wreg[jc][0] = w0[0]; wreg[jc][1] = w0[1]; wreg[jc][2] = w0[2]; wreg[jc][3] = w0[3]; wreg[jc][4] = w1[0]; wreg[jc][5] = w1[1]; wreg[jc][6] = w1[2]; wreg[jc][7] = w1[3]; }
    for (int r0 = gw; r0 < T; r0 += 2 * ngw) {
        float4 vv[2][4];
#pragma unroll
        for (int q = 0; q < 2; ++q) { const int r = r0 + q * ngw; if (r < T) { const float4* xr = (const float4*)(x + (size_t)r * DM);
#pragma unroll
            for (int j = 0; j < 4; ++j) vv[q][j] = xr[lane + 64 * j]; } }
#pragma unroll
        for (int q = 0; q < 2; ++q) { const int r = r0 + q * ngw; if (r < T) {
        float4 (&v)[4] = vv[q]; float s = 0.f;
#pragma unroll
        for (int j = 0; j < 4; ++j) s += v[j].x * v[j].x + v[j].y * v[j].y + v[j].z * v[j].z + v[j].w * v[j].w;
        const float rs = rsqrtf(wave_sum(s) * (1.f / DM) + EPS);
        float dacc[8];
#pragma unroll
        for (int h = 0; h < 8; ++h) dacc[h] = 0.f;
#pragma unroll
        for (int j = 0; j < 4; ++j) { const float4 gg = ((const float4*)g)[lane + 64 * j];
            const float un[4] = {v[j].x * rs * gg.x, v[j].y * rs * gg.y, v[j].z * rs * gg.z, v[j].w * rs * gg.w};
            uint2 o; o.x = pk2(un[0], un[1]); o.y = pk2(un[2], un[3]);
            *(uint2*)(u + (size_t)r * DM + 4 * lane + 256 * j) = o;
#pragma unroll
            for (int c = 0; c < 4; ++c)
#pragma unroll
                for (int h = 0; h < 8; ++h) dacc[h] += un[c] * wreg[j * 4 + c][h]; }
#pragma unroll
        for (int h = 0; h < 8; ++h) dacc[h] = wave_sum(dacc[h]);
        if (lane == 0) {
#pragma unroll
            for (int h = 0; h < 8; ++h) dtraw[(size_t)r * 8 + h] = dacc[h]; }
        } }
    }
}

constexpr int CW_QHEAD = 1024;
constexpr int I_W1 = NE * 8 * 64, I_W2 = NE * 8 * 32;
struct CvtItem { const float* W; unsigned char* WT; int ldw, n0src, drow0, k0; };
__device__ __forceinline__ CvtItem moe_item(const Args& a, int it) {
    CvtItem c; unsigned char* ws = a.ws;
    if (it < I_W1) { const int e = it >> 9, r = it & 511, kb = r >> 6, d0 = 32 * (r & 63), pn = d0 >> 8, j0 = d0 & 255;
        c.W = a.in[16] + (size_t)e * 1024 * 2048; c.ldw = 2048; c.n0src = j0 < 128 ? pn * 128 + j0 : 1024 + pn * 128 + (j0 - 128); c.WT = ws + WS_W1 + (size_t)e * 2048 * 1024; c.drow0 = d0; c.k0 = 128 * kb; }
    else { it -= I_W1; const int e = it >> 8, r = it & 255, kb = r >> 5, d0 = 32 * (r & 31);
        c.W = a.in[18] + (size_t)e * 1024 * 1024; c.ldw = 1024; c.n0src = d0; c.WT = ws + WS_W2 + (size_t)e * 1024 * 1024; c.drow0 = d0; c.k0 = 128 * kb; }
    return c;
}
__device__ __forceinline__ void cvt8_load(const CvtItem& c, int lane, f32x4v (&v)[16]) {
    const float* p = c.W + (size_t)(c.k0 + 16 * (lane >> 3)) * c.ldw + c.n0src + (lane & 7) * 4;
#pragma unroll
    for (int i = 0; i < 16; ++i) v[i] = __builtin_nontemporal_load((const f32x4v*)(p + (size_t)i * c.ldw));
}
__device__ __forceinline__ void cvt8_finish(const CvtItem& c, int lane, const f32x4v (&v)[16]) {
    unsigned char* q = c.WT + (size_t)(c.drow0 + 4 * (lane & 7)) * DM + c.k0 + 16 * (lane >> 3);
#pragma unroll
    for (int cc = 0; cc < 4; ++cc) { v4u o;
        o.x = pk4_fp8(v[0][cc] * W8_SCALE, v[1][cc] * W8_SCALE, v[2][cc] * W8_SCALE, v[3][cc] * W8_SCALE); o.y = pk4_fp8(v[4][cc] * W8_SCALE, v[5][cc] * W8_SCALE, v[6][cc] * W8_SCALE, v[7][cc] * W8_SCALE);
        o.z = pk4_fp8(v[8][cc] * W8_SCALE, v[9][cc] * W8_SCALE, v[10][cc] * W8_SCALE, v[11][cc] * W8_SCALE); o.w = pk4_fp8(v[12][cc] * W8_SCALE, v[13][cc] * W8_SCALE, v[14][cc] * W8_SCALE, v[15][cc] * W8_SCALE);
        *(GAS v4u*)(q + (size_t)cc * DM) = o; }
}
constexpr int I_MOE = I_W1 + I_W2, QB8 = 4, QPART = I_MOE / 8;
static_assert(QPART % QB8 == 0, "queue partition");
__device__ __forceinline__ void moe_weight_queue(const Args& a, LAS unsigned char* lds, int bid) {
    const int tid = threadIdx.x, lane = tid & 63; (void)lds;
    unsigned* heads = (unsigned*)(a.ws + WS_CTL) + CW_QHEAD;
    for (int k = 0; k < 8; ++k) { const int part = (bid + k) & 7;
        for (;;) { unsigned b0 = 0u; if (lane == 0) b0 = atomicAdd(&heads[64 * part], (unsigned)QB8); b0 = (unsigned)__builtin_amdgcn_readfirstlane((int)b0);
            if (b0 >= (unsigned)QPART) break;
            const int base = part * QPART + (int)b0;
            f32x4v A[16], B[16];
#define QL(j, R) cvt8_load(moe_item(a, base + (j)), lane, R)
#define QF(j, R) cvt8_finish(moe_item(a, base + (j)), lane, R)
            QL(0, A); QL(1, B);
            QF(0, A); QL(2, A); QF(1, B); QL(3, B);
            QF(2, A); QF(3, B); } }
#undef QL
#undef QF
}
__device__ __forceinline__ void ph_conv(const Args& a, int bid, int nb) {
    const bf16* proj = (const bf16*)(a.ws + WS_PROJ); const float* cw = a.in[3]; const float* cb = a.in[4]; const float* dtb = a.in[5]; const float* dtraw = (const float*)(a.ws + WS_DTRAW);
    float* xc = (float*)(a.ws + WS_XC); float* dt = (float*)(a.ws + WS_DT);
    const size_t n = (size_t)T * 1024;
    for (size_t i = (size_t)bid * NT + threadIdx.x; i < n; i += (size_t)nb * NT) {
        const int t = (int)(i >> 10), c = (int)(i & 1023), s = t % SEQ;
        float v = cb[c];
#pragma unroll
        for (int k = 0; k < 4; ++k) { const int ss = s - 3 + k; if (ss >= 0) v += cw[k * 1024 + c] * bf2f(proj[(size_t)(t - 3 + k) * NP + PXBC + c]); }
        xc[i] = silu_f(v);
    }
    for (int i = bid * NT + threadIdx.x; i < T * 8; i += nb * NT) {
        const float v = dtraw[i] + dtb[i & 7];
        dt[i] = v > 20.f ? v : log1pf(__expf(v));
    }
}
__device__ __forceinline__ unsigned cvtpk(float lo, float hi) { unsigned r; asm volatile("v_cvt_pk_bf16_f32 %0, %1, %2" : "=v"(r) : "v"(lo), "v"(hi)); return r; }
__device__ __forceinline__ float silu_fast(float x) { return x * __builtin_amdgcn_rcpf(1.f + __expf(-x)); }
__device__ __forceinline__ void conv_load(const bf16* proj, int t0, int s0, int l0, int ch, unsigned (&raw)[11]) {
#pragma unroll
    for (int i = 0; i < 11; ++i) { const int l = l0 - 3 + i; unsigned wv = 0u; if (s0 + l >= 0) wv = *(const unsigned*)(proj + (size_t)(t0 + l) * NP + PXBC + ch); raw[i] = wv; }
}
__device__ __forceinline__ void conv_compute(const unsigned (&raw)[11], const float* cw, const float* cb, int ch, float (&o0)[8], float (&o1)[8]) {
    float w0[4], w1[4];
#pragma unroll
    for (int k = 0; k < 4; ++k) { const float2 wv = *(const float2*)(cw + k * 1024 + ch); w0[k] = wv.x; w1[k] = wv.y; }
    const float2 bb = *(const float2*)(cb + ch);
#pragma unroll
    for (int j = 0; j < 8; ++j) { float v0 = bb.x, v1 = bb.y;
#pragma unroll
        for (int k = 0; k < 4; ++k) { v0 += w0[k] * bflo(raw[j + k]); v1 += w1[k] * bfhi(raw[j + k]); }
        o0[j] = silu_fast(v0); o1[j] = silu_fast(v1); }
}
constexpr int SL_ST = 272, SL_XW = 0, SL_BMT = 256 * SL_ST, SL_WL = SL_BMT + 128 * SL_ST, SL_TMP = SL_WL + 2048;
__device__ __forceinline__ void ph_ssd_local(const Args& a, LAS unsigned char* lds, int bid, int nb) {
    const bf16* proj = (const bf16*)(a.ws + WS_PROJ); const float* dtraw = (const float*)(a.ws + WS_DTRAW); const float* dtb = a.in[5]; const float* alog = a.in[6];
    float* dtg = (float*)(a.ws + WS_DT); float* acum = (float*)(a.ws + WS_ACUM); float* cdec = (float*)(a.ws + WS_CDEC); float* states = (float*)(a.ws + WS_STATES);
    const int tid = threadIdx.x, lane = tid & 63, w = tid >> 6;
    LAS unsigned char* XW = lds + SL_XW; LAS unsigned char* BMT = lds + SL_BMT; LAS float* wl = (LAS float*)(lds + SL_WL); LAS float* tmp = (LAS float*)(lds + SL_TMP);
    for (int unit = bid; unit < BATCH * NCH * 2; unit += nb) {
        const int g = unit & 1, c = (unit >> 1) % NCH, b = unit / (2 * NCH); const int t0 = b * SEQ + c * 128;
        __syncthreads();
        { const int r = tid >> 7, l = tid & 127, h = g * 4 + r;
          const float v = dtraw[(size_t)(t0 + l) * 8 + h] + dtb[h]; const float dtv = fmaxf(v, 0.f) + log1pf(__expf(-fabsf(v))); const float av = -__expf(alog[h]);
          float x = dtv * av;
#pragma unroll
          for (int o = 1; o < 64; o <<= 1) { const float y = __shfl_up(x, o); if (lane >= o) x += y; }
          if (lane == 63) tmp[w] = x;
          __syncthreads();
          if (w & 1) x += tmp[w - 1];
          const float last = tmp[2 * r] + tmp[2 * r + 1];
          dtg[(size_t)(t0 + l) * 8 + h] = dtv; acum[(size_t)(t0 + l) * 8 + h] = x; wl[r * 128 + l] = dtv * __expf(last - x);
          if (l == 127) cdec[(b * NCH + c) * 8 + h] = __expf(x); }
        __syncthreads();
        { unsigned raw[6][11];
#pragma unroll
          for (int it = 0; it < 6; ++it) { const int task = tid + it * NT, pi = task % 192, l0 = (task / 192) * 8;
              const int ch = pi < 128 ? g * 256 + 2 * pi : 512 + g * 128 + 2 * (pi - 128); conv_load(proj, t0, c * 128, l0, ch, raw[it]); }
#pragma unroll
          for (int it = 0; it < 6; ++it) { const int task = tid + it * NT, pi = task % 192, l0 = (task / 192) * 8;
            const int ch = pi < 128 ? g * 256 + 2 * pi : 512 + g * 128 + 2 * (pi - 128);
            float o0[8], o1[8]; conv_compute(raw[it], a.in[3], a.in[4], ch, o0, o1);
            if (pi < 128) { const int row = 2 * pi; const LAS float* ws_ = wl + (row >> 6) * 128 + l0;
#pragma unroll
                for (int j = 0; j < 8; ++j) { o0[j] *= ws_[j]; o1[j] *= ws_[j]; }
                v4u p0, p1; p0.x = cvtpk(o0[0], o0[1]); p0.y = cvtpk(o0[2], o0[3]); p0.z = cvtpk(o0[4], o0[5]); p0.w = cvtpk(o0[6], o0[7]);
                p1.x = cvtpk(o1[0], o1[1]); p1.y = cvtpk(o1[2], o1[3]); p1.z = cvtpk(o1[4], o1[5]); p1.w = cvtpk(o1[6], o1[7]);
                *(LAS v4u*)(XW + row * SL_ST + l0 * 2) = p0; *(LAS v4u*)(XW + (row + 1) * SL_ST + l0 * 2) = p1; }
            else { const int row = 2 * (pi - 128);
                v4u p0, p1; p0.x = cvtpk(o0[0], o0[1]); p0.y = cvtpk(o0[2], o0[3]); p0.z = cvtpk(o0[4], o0[5]); p0.w = cvtpk(o0[6], o0[7]);
                p1.x = cvtpk(o1[0], o1[1]); p1.y = cvtpk(o1[2], o1[3]); p1.z = cvtpk(o1[4], o1[5]); p1.w = cvtpk(o1[6], o1[7]);
                *(LAS v4u*)(BMT + row * SL_ST + l0 * 2) = p0; *(LAS v4u*)(BMT + (row + 1) * SL_ST + l0 * 2) = p1; } } }
        __syncthreads();
        { const int r = w >> 1, ph = w & 1, qc = lane & 31, hh = lane >> 5, h = g * 4 + r;
          f32x16 acc[4];
#pragma unroll
          for (int n4 = 0; n4 < 4; ++n4)
#pragma unroll
              for (int i = 0; i < 16; ++i) acc[n4][i] = 0.f;
#pragma unroll
          for (int ks = 0; ks < 8; ++ks) { const bf16x8 af = *(const LAS bf16x8*)(XW + (r * 64 + ph * 32 + qc) * SL_ST + (16 * ks + 8 * hh) * 2);
#pragma unroll
              for (int n4 = 0; n4 < 4; ++n4) { const bf16x8 bfr = *(const LAS bf16x8*)(BMT + (n4 * 32 + qc) * SL_ST + (16 * ks + 8 * hh) * 2);
                  acc[n4] = __builtin_amdgcn_mfma_f32_32x32x16_bf16(af, bfr, acc[n4], 0, 0, 0); } }
          float* st = states + ((size_t)((b * NCH + c) * 8 + h)) * 8192;
#pragma unroll
          for (int n4 = 0; n4 < 4; ++n4)
#pragma unroll
              for (int i = 0; i < 16; ++i) { const int pp = ph * 32 + (i & 3) + 8 * (i >> 2) + 4 * hh; st[pp * 128 + n4 * 32 + qc] = acc[n4][i]; } }
    }
}
__device__ __forceinline__ void ph_scan(const Args& a, int bid, int nb) {
    const float* states = (const float*)(a.ws + WS_STATES); const float* cdec = (const float*)(a.ws + WS_CDEC); bf16* prev = (bf16*)(a.ws + WS_PREV);
    const int n4 = BATCH * 8 * 2048;
    for (int i = bid * NT + threadIdx.x; i < n4; i += nb * NT) {
        const int e4 = i & 2047, h = (i >> 11) & 7, b = i >> 14;
        f32x4v st[NCH]; float dc[NCH];
#pragma unroll
        for (int c = 0; c < NCH; ++c) { st[c] = *(const f32x4v*)(states + ((size_t)((b * NCH + c) * 8 + h)) * 8192 + e4 * 4); dc[c] = cdec[(b * NCH + c) * 8 + h]; }
        f32x4v hc = {0.f, 0.f, 0.f, 0.f};
#pragma unroll
        for (int c = 0; c < NCH; ++c) { u32x2v pk; pk.x = cvtpk(hc[0], hc[1]); pk.y = cvtpk(hc[2], hc[3]); *(u32x2v*)(prev + ((size_t)((b * NCH + c) * 8 + h)) * 8192 + e4 * 4) = pk; hc = hc * dc[c] + st[c]; }
    }
}
constexpr int SO_XST = 264, SO_NST = 272, SO_XS = 0, SO_BM = 256 * SO_XST, SO_CM = SO_BM + 128 * SO_NST, SO_AC = SO_CM + 128 * SO_NST, SO_DT = SO_AC + 2048, SO_EA = SO_DT + 2048, SO_END = SO_EA + 2048;
constexpr int SO_YST = 260;
static_assert(128 * SO_YST * 4 <= SO_AC && SO_END <= SCR_BYTES, "ssd_out LDS map");
__device__ __forceinline__ void ph_ssd_out(const Args& a, LAS unsigned char* lds, int bid, int nb) {
    const bf16* proj = (const bf16*)(a.ws + WS_PROJ); const float* dtg = (const float*)(a.ws + WS_DT); const float* acum = (const float*)(a.ws + WS_ACUM);
    const bf16* prev = (const bf16*)(a.ws + WS_PREV); const float* dsk = a.in[7];
    bf16* ygb = (bf16*)(a.ws + WS_CAT); float* ssd = (float*)(a.ws + WS_SSSD);
    const int tid = threadIdx.x, lane = tid & 63, w = tid >> 6, r = w >> 1, lsel = w & 1, qc = lane & 31, hh = lane >> 5;
    LAS unsigned char* XS = lds + SO_XS; LAS unsigned char* BM = lds + SO_BM; LAS unsigned char* CM = lds + SO_CM;
    LAS float* AC = (LAS float*)(lds + SO_AC); LAS float* DT = (LAS float*)(lds + SO_DT); LAS float* EA = (LAS float*)(lds + SO_EA); LAS float* YS = (LAS float*)lds;
    for (int unit = bid; unit < BATCH * NCH * 2; unit += nb) {
        const int g = unit & 1, c = (unit >> 1) % NCH, b = unit / (2 * NCH); const int t0 = b * SEQ + c * 128;
        __syncthreads();
        bf16x8 pf[2][8];
        { const bf16* pvb = prev + ((size_t)((b * NCH + c) * 8 + g * 4 + r)) * 8192 + qc * 128 + 8 * hh;
#pragma unroll
          for (int pb = 0; pb < 2; ++pb)
#pragma unroll
              for (int ks = 0; ks < 8; ++ks) pf[pb][ks] = *(const bf16x8*)(pvb + pb * 32 * 128 + 16 * ks); }
        { const int rr = tid >> 7, l = tid & 127, h = g * 4 + rr; const float ac = acum[(size_t)(t0 + l) * 8 + h];
          AC[rr * 128 + l] = ac; DT[rr * 128 + l] = dtg[(size_t)(t0 + l) * 8 + h]; EA[rr * 128 + l] = __expf(ac); }
#pragma unroll 1
        for (int bt = 0; bt < 2; ++bt) { unsigned raw[4][11];
#pragma unroll
          for (int it = 0; it < 4; ++it) { const int task = tid + (bt * 4 + it) * NT, pi = task & 255, l0 = (task >> 8) * 8;
              const int ch = pi < 128 ? g * 256 + 2 * pi : (pi < 192 ? 512 + g * 128 + 2 * (pi - 128) : 768 + g * 128 + 2 * (pi - 192)); conv_load(proj, t0, c * 128, l0, ch, raw[it]); }
#pragma unroll
          for (int it = 0; it < 4; ++it) { const int task = tid + (bt * 4 + it) * NT, pi = task & 255, l0 = (task >> 8) * 8;
            const int ch = pi < 128 ? g * 256 + 2 * pi : (pi < 192 ? 512 + g * 128 + 2 * (pi - 128) : 768 + g * 128 + 2 * (pi - 192));
            float o0[8], o1[8]; conv_compute(raw[it], a.in[3], a.in[4], ch, o0, o1);
            if (pi < 128) { const int row = 2 * pi; u32x2v q0, q1;
                q0.x = cvtpk(o0[0], o0[1]); q0.y = cvtpk(o0[2], o0[3]); q1.x = cvtpk(o0[4], o0[5]); q1.y = cvtpk(o0[6], o0[7]);
                *(LAS u32x2v*)(XS + row * SO_XST + l0 * 2) = q0; *(LAS u32x2v*)(XS + row * SO_XST + l0 * 2 + 8) = q1;
                q0.x = cvtpk(o1[0], o1[1]); q0.y = cvtpk(o1[2], o1[3]); q1.x = cvtpk(o1[4], o1[5]); q1.y = cvtpk(o1[6], o1[7]);
                *(LAS u32x2v*)(XS + (row + 1) * SO_XST + l0 * 2) = q0; *(LAS u32x2v*)(XS + (row + 1) * SO_XST + l0 * 2 + 8) = q1; }
            else { LAS unsigned char* img = pi < 192 ? BM : CM; const int n = 2 * ((pi - 128) & 63);
#pragma unroll
                for (int j = 0; j < 8; ++j) *(LAS unsigned*)(img + (l0 + j) * SO_NST + n * 2) = cvtpk(o0[j], o1[j]); } } }
        __syncthreads();
        const int h = g * 4 + r; const float dskip = dsk[h];
        f32x16 Y[2][2];
#pragma unroll
        for (int li = 0; li < 2; ++li) {
            const int lb = lsel ? (1 + li) : (li ? 3 : 0);
#pragma unroll
            for (int pb = 0; pb < 2; ++pb)
#pragma unroll
                for (int i = 0; i < 16; ++i) Y[li][pb][i] = 0.f;
#pragma unroll
            for (int ks = 0; ks < 8; ++ks) { const bf16x8 bfr = *(const LAS bf16x8*)(CM + (lb * 32 + qc) * SO_NST + (16 * ks + 8 * hh) * 2);
#pragma unroll
                for (int pb = 0; pb < 2; ++pb) Y[li][pb] = __builtin_amdgcn_mfma_f32_32x32x16_bf16(pf[pb][ks], bfr, Y[li][pb], 0, 0, 0); }
            const float ea = EA[r * 128 + lb * 32 + qc], acl = AC[r * 128 + lb * 32 + qc];
#pragma unroll
            for (int pb = 0; pb < 2; ++pb)
#pragma unroll
                for (int i = 0; i < 16; ++i) Y[li][pb][i] *= ea;
            for (int sb = 0; sb <= lb; ++sb) {
                f32x16 X;
#pragma unroll
                for (int i = 0; i < 16; ++i) X[i] = 0.f;
#pragma unroll
                for (int ks = 0; ks < 8; ++ks) { const bf16x8 af = *(const LAS bf16x8*)(BM + (sb * 32 + qc) * SO_NST + (16 * ks + 8 * hh) * 2);
                    const bf16x8 bfr = *(const LAS bf16x8*)(CM + (lb * 32 + qc) * SO_NST + (16 * ks + 8 * hh) * 2);
                    X = __builtin_amdgcn_mfma_f32_32x32x16_bf16(af, bfr, X, 0, 0, 0); }
                const bool dg = (sb == lb);
#pragma unroll
                for (int q = 0; q < 4; ++q) { const f32x4v as4 = *(const LAS f32x4v*)(AC + r * 128 + sb * 32 + 8 * q + 4 * hh), ds4 = *(const LAS f32x4v*)(DT + r * 128 + sb * 32 + 8 * q + 4 * hh);
#pragma unroll
                    for (int i = 0; i < 4; ++i) { const int sl = 8 * q + 4 * hh + i;
                        const float e = __expf(acl - as4[i]) * ds4[i]; const bool ok = !dg || sl <= qc; float f = ok ? e : 0.f;
                        float xv = X[4 * q + i] * f; if (dg && sl == qc) xv += dskip; X[4 * q + i] = xv; } }
#pragma unroll
                for (int k2 = 0; k2 < 2; ++k2) { union { bf16x8 v; unsigned u[4]; } gb;
#pragma unroll
                    for (int e = 0; e < 4; ++e) gb.u[e] = cvtpk(X[8 * k2 + 2 * e], X[8 * k2 + 2 * e + 1]);
#pragma unroll
                    for (int pb = 0; pb < 2; ++pb) { const LAS unsigned char* xp = XS + (r * 64 + pb * 32 + qc) * SO_XST + (sb * 32 + 16 * k2 + 4 * hh) * 2;
                        union { bf16x8 v; u32x2v h2[2]; } af; af.h2[0] = *(const LAS u32x2v*)xp; af.h2[1] = *(const LAS u32x2v*)(xp + 16);
                        Y[li][pb] = __builtin_amdgcn_mfma_f32_32x32x16_bf16(af.v, gb.v, Y[li][pb], 0, 0, 0); } }
            }
        }
        __syncthreads();
#pragma unroll
        for (int li = 0; li < 2; ++li) { const int lb = lsel ? (1 + li) : (li ? 3 : 0);
#pragma unroll
            for (int pb = 0; pb < 2; ++pb)
#pragma unroll
                for (int q = 0; q < 4; ++q) { f32x4v v4; v4[0] = Y[li][pb][4 * q]; v4[1] = Y[li][pb][4 * q + 1]; v4[2] = Y[li][pb][4 * q + 2]; v4[3] = Y[li][pb][4 * q + 3];
                    *(LAS f32x4v*)(YS + (lb * 32 + qc) * SO_YST + r * 64 + pb * 32 + 8 * q + 4 * hh) = v4; } }
        __syncthreads();
        { v4u zz8[8];
#pragma unroll
          for (int it = 0; it < 8; ++it) { const int task = tid + it * NT, row = task >> 5, ck = task & 31; zz8[it] = *(const v4u*)(proj + (size_t)(t0 + row) * NP + PZ + g * 256 + ck * 8); }
#pragma unroll
          for (int it = 0; it < 8; ++it) { const int task = tid + it * NT, row = task >> 5, ck = task & 31; const v4u zz = zz8[it];
            const f32x4v y0 = *(const LAS f32x4v*)(YS + row * SO_YST + ck * 8), y1 = *(const LAS f32x4v*)(YS + row * SO_YST + ck * 8 + 4);
            float o[8]; o[0] = y0[0] * silu_fast(bflo(zz.x)); o[1] = y0[1] * silu_fast(bfhi(zz.x)); o[2] = y0[2] * silu_fast(bflo(zz.y)); o[3] = y0[3] * silu_fast(bfhi(zz.y));
            o[4] = y1[0] * silu_fast(bflo(zz.z)); o[5] = y1[1] * silu_fast(bfhi(zz.z)); o[6] = y1[2] * silu_fast(bflo(zz.w)); o[7] = y1[3] * silu_fast(bfhi(zz.w));
            float ss = 0.f;
#pragma unroll
            for (int e = 0; e < 8; ++e) ss += o[e] * o[e];
#pragma unroll
            for (int of = 1; of < 32; of <<= 1) ss += __shfl_xor(ss, of);
            if (ck == 0) ssd[(size_t)(t0 + row) * 2 + g] = ss;
            v4u ov; ov.x = cvtpk(o[0], o[1]); ov.y = cvtpk(o[2], o[3]); ov.z = cvtpk(o[4], o[5]); ov.w = cvtpk(o[6], o[7]);
            *(v4u*)(ygb + (size_t)(t0 + row) * 1024 + g * 256 + ck * 8) = ov; } }
    }
}
constexpr int AT_KST = 144, AT_VST = 520, AT_K = 0, AT_V = 256 * AT_KST, AT_B = AT_V + 64 * AT_VST;
__device__ __forceinline__ void ph_attn(const Args& a, LAS unsigned char* lds, int bid, int nb) {
    const bf16* proj = (const bf16*)(a.ws + WS_PROJ); const float* sinks = a.in[9]; const float* relb = a.in[10];
    bf16* ao = (bf16*)(a.ws + WS_CAT) + 512; float* ssat = (float*)(a.ws + WS_SSAT);
    const int tid = threadIdx.x, lane = tid & 63, w = tid >> 6, g = w >> 1, half = w & 1, qc = lane & 31, hh = lane >> 5;
    LAS unsigned char* Kimg = lds + AT_K; LAS unsigned char* VT = lds + AT_V; LAS float* biasT = (LAS float*)(lds + AT_B);
    for (int unit = bid; unit < BATCH * NCH * 2; unit += nb) {
        const int kvh = unit & 1, blk = (unit >> 1) % NCH, b = unit / (2 * NCH); const int t0 = b * SEQ + blk * 128;
        __syncthreads();
        { v4u kv4[4], vv4[4];
#pragma unroll
          for (int it = 0; it < 4; ++it) { const int c = tid + it * NT, row = c >> 3, part = c & 7; kv4[it] = (v4u){0u, 0u, 0u, 0u}; vv4[it] = (v4u){0u, 0u, 0u, 0u};
            if (blk > 0 || row >= 128) { const bf16* src = proj + (size_t)(t0 - 128 + row) * NP + kvh * 64 + part * 8; kv4[it] = *(const v4u*)(src + PK); vv4[it] = *(const v4u*)(src + PV); } }
#pragma unroll
          for (int it = 0; it < 4; ++it) { const int c = tid + it * NT, row = c >> 3, part = c & 7; const v4u kv = kv4[it], vv = vv4[it];
            *(LAS v4u*)(Kimg + row * AT_KST + part * 16) = kv;
            LAS unsigned short* vt = (LAS unsigned short*)(VT + (part * 8) * AT_VST + row * 2);
            vt[0 * (AT_VST / 2)] = (unsigned short)(vv.x & 0xffffu); vt[1 * (AT_VST / 2)] = (unsigned short)(vv.x >> 16);
            vt[2 * (AT_VST / 2)] = (unsigned short)(vv.y & 0xffffu); vt[3 * (AT_VST / 2)] = (unsigned short)(vv.y >> 16);
            vt[4 * (AT_VST / 2)] = (unsigned short)(vv.z & 0xffffu); vt[5 * (AT_VST / 2)] = (unsigned short)(vv.z >> 16);
            vt[6 * (AT_VST / 2)] = (unsigned short)(vv.w & 0xffffu); vt[7 * (AT_VST / 2)] = (unsigned short)(vv.w >> 16); } }
        { const int gg = tid >> 7, dist = tid & 127; biasT[gg * 128 + dist] = relb[c_bucket[dist] * 8 + kvh * 4 + gg]; }
        __syncthreads();
        const int hq = kvh * 4 + g; const float sink = sinks[hq];
#pragma unroll 1
        for (int qb = 0; qb < 2; ++qb) {
            const int q0 = half * 64 + qb * 32; const size_t tq = (size_t)(t0 + q0 + qc);
            bf16x8 qf[4];
            { const bf16* qp = proj + tq * NP + PQ + hq * 64 + 8 * hh;
#pragma unroll
              for (int ks = 0; ks < 4; ++ks) qf[ks] = *(const bf16x8*)(qp + 16 * ks); }
            f32x16 sc[5];
#pragma unroll
            for (int kb = 0; kb < 5; ++kb) {
#pragma unroll
                for (int r = 0; r < 16; ++r) sc[kb][r] = 0.f;
#pragma unroll
                for (int ks = 0; ks < 4; ++ks) { const bf16x8 kf = *(const LAS bf16x8*)(Kimg + (q0 + 32 * kb + qc) * AT_KST + (16 * ks + 8 * hh) * 2);
                    sc[kb] = __builtin_amdgcn_mfma_f32_32x32x16_bf16(kf, qf[ks], sc[kb], 0, 0, 0); } }
            float m = -INFINITY;
#pragma unroll
            for (int kb = 0; kb < 5; ++kb)
#pragma unroll
                for (int r = 0; r < 16; ++r) { const int ki = (r & 3) + 8 * (r >> 2) + 4 * hh, dist = qc + 128 - 32 * kb - ki, j = q0 + 32 * kb + ki;
                    const bool ok = dist >= 0 && dist < 128 && (blk > 0 || j >= 128);
                    const float v = ok ? sc[kb][r] * 0.125f + biasT[g * 128 + (dist & 127)] : -INFINITY; sc[kb][r] = v; m = fmaxf(m, v); }
            m = fmaxf(m, __shfl_xor(m, 32)); m = fmaxf(m, sink);
            float l = 0.f;
#pragma unroll
            for (int kb = 0; kb < 5; ++kb)
#pragma unroll
                for (int r = 0; r < 16; ++r) { const float pv = __expf(sc[kb][r] - m); sc[kb][r] = pv; l += pv; }
            l += __shfl_xor(l, 32); l += __expf(sink - m);
            f32x16 o[2];
#pragma unroll
            for (int db = 0; db < 2; ++db)
#pragma unroll
                for (int r = 0; r < 16; ++r) o[db][r] = 0.f;
#pragma unroll
            for (int kb = 0; kb < 5; ++kb)
#pragma unroll
                for (int k2 = 0; k2 < 2; ++k2) {
                    union { bf16x8 v; unsigned u[4]; } pb;
#pragma unroll
                    for (int e = 0; e < 4; ++e) pb.u[e] = cvtpk(sc[kb][8 * k2 + 2 * e], sc[kb][8 * k2 + 2 * e + 1]);
#pragma unroll
                    for (int db = 0; db < 2; ++db) { const LAS unsigned char* vp = VT + (db * 32 + qc) * AT_VST + (q0 + 32 * kb + 16 * k2 + 4 * hh) * 2;
                        union { bf16x8 v; u32x2v h2[2]; } va; va.h2[0] = *(const LAS u32x2v*)vp; va.h2[1] = *(const LAS u32x2v*)(vp + 16);
                        o[db] = __builtin_amdgcn_mfma_f32_32x32x16_bf16(va.v, pb.v, o[db], 0, 0, 0); } }
            const float inv = 1.f / l; float ss = 0.f;
#pragma unroll
            for (int db = 0; db < 2; ++db)
#pragma unroll
                for (int r = 0; r < 16; ++r) { o[db][r] *= inv; ss += o[db][r] * o[db][r]; }
            ss += __shfl_xor(ss, 32);
            if (hh == 0) ssat[tq * 8 + hq] = ss;
#pragma unroll
            for (int db = 0; db < 2; ++db)
#pragma unroll
                for (int q4 = 0; q4 < 4; ++q4) { uint2 pk; pk.x = cvtpk(o[db][4 * q4], o[db][4 * q4 + 1]); pk.y = cvtpk(o[db][4 * q4 + 2], o[db][4 * q4 + 3]);
                    *(uint2*)(ao + tq * 1024 + hq * 64 + db * 32 + 8 * q4 + 4 * hh) = pk; }
        }
    }
}
constexpr int RT_UST = 1025;
constexpr int RT_P = 0, RT_L = 32768;
constexpr int RT_HIST = TAB_OFF, RT_BASE = TAB_OFF + 128, RT_SE = TAB_OFF + 256, RT_SG = RT_SE + 512, RT_SS = RT_SG + 512;
static_assert(32 * RT_UST * 4 <= SCR_BYTES, "router LDS map");
__device__ __forceinline__ void ph_router(const Args& a, LAS unsigned char* lds, int bid, int nb) {
    const float* hh_ = a.in[0]; const bf16* dl_ = (const bf16*)(a.ws + WS_H); const float* g = a.in[13]; const float* wr = a.in[14]; const float* br = a.in[15];
    unsigned char* u2 = a.ws + WS_U2; int* toke = (int*)(a.ws + WS_TOKE); int* toks = (int*)(a.ws + WS_TOKS);
    int* ltok = (int*)(a.ws + WS_LTOK); float* lgate = (float*)(a.ws + WS_LGATE); unsigned* cnt = (unsigned*)(a.ws + WS_CTL);
    const int tid = threadIdx.x, lane = tid & 63, w = tid >> 6, qc = lane & 31, hh = lane >> 5;
    LAS float* U = (LAS float*)lds; LAS float* P = (LAS float*)(lds + RT_P); LAS float* L = (LAS float*)(lds + RT_L);
    LAS unsigned* hist = (LAS unsigned*)(lds + RT_HIST); LAS unsigned* basev = (LAS unsigned*)(lds + RT_BASE);
    LAS int* se = (LAS int*)(lds + RT_SE); LAS float* sg = (LAS float*)(lds + RT_SG); LAS unsigned* ssl = (LAS unsigned*)(lds + RT_SS);
    float breg[64];
#pragma unroll
    for (int kk = 0; kk < 64; ++kk) breg[kk] = wr[(size_t)(128 * w + 2 * kk + hh) * NE + qc];
    for (int tile = bid; tile < T / 32; tile += nb) {
        const int tk0 = tile * 32;
        __syncthreads();
        if (tid < NE) hist[tid] = 0u;
#pragma unroll 1
        for (int rr = 0; rr < 4; ++rr) { const int row = w * 4 + rr; const float4* xr = (const float4*)(hh_ + (size_t)(tk0 + row) * DM); const uint2* dr = (const uint2*)(dl_ + (size_t)(tk0 + row) * DM); float4 v[4]; float s = 0.f;
#pragma unroll
            for (int j = 0; j < 4; ++j) { v[j] = xr[lane + 64 * j]; const uint2 dw = dr[lane + 64 * j]; v[j].x += bflo(dw.x); v[j].y += bfhi(dw.x); v[j].z += bflo(dw.y); v[j].w += bfhi(dw.y);
                s += v[j].x * v[j].x + v[j].y * v[j].y + v[j].z * v[j].z + v[j].w * v[j].w; }
            const float rs = rsqrtf(wave_sum(s) * (1.f / DM) + EPS);
#pragma unroll
            for (int j = 0; j < 4; ++j) { const float4 gg = ((const float4*)g)[lane + 64 * j];
                const float un[4] = {v[j].x * rs * gg.x, v[j].y * rs * gg.y, v[j].z * rs * gg.z, v[j].w * rs * gg.w};
                *(unsigned*)(u2 + (size_t)(tk0 + row) * DM + 4 * lane + 256 * j) = pk4_fp8(un[0], un[1], un[2], un[3]);
                LAS float* ur = U + row * RT_UST + 4 * lane + 256 * j; ur[0] = un[0]; ur[1] = un[1]; ur[2] = un[2]; ur[3] = un[3]; } }
        __syncthreads();
        f32x16 acc;
#pragma unroll
        for (int i = 0; i < 16; ++i) acc[i] = 0.f;
#pragma unroll
        for (int kk = 0; kk < 64; ++kk) acc = __builtin_amdgcn_mfma_f32_32x32x2f32(U[qc * RT_UST + 128 * w + 2 * kk + hh], breg[kk], acc, 0, 0, 0);
        __syncthreads();
#pragma unroll
        for (int i = 0; i < 16; ++i) P[(w * 32 + (i & 3) + 8 * (i >> 2) + 4 * hh) * 32 + qc] = acc[i];
        __syncthreads();
#pragma unroll
        for (int o2 = 0; o2 < 2; ++o2) { const int o = tid + 512 * o2; float sacc = br[o & 31];
#pragma unroll
            for (int ww = 0; ww < 8; ++ww) sacc += P[ww * 1024 + o];
            L[o] = sacc; }
        __syncthreads();
#pragma unroll 1
        for (int it = 0; it < 2; ++it) { const int tok = w * 4 + it * 2 + hh;
            float cur = L[tok * 32 + qc]; int idx[4]; float val[4];
#pragma unroll
            for (int k = 0; k < 4; ++k) { float m = cur;
#pragma unroll
                for (int of = 1; of < 32; of <<= 1) m = fmaxf(m, __shfl_xor(m, of));
                const unsigned long long bal = __ballot(cur == m); const unsigned hb = hh ? (unsigned)(bal >> 32) : (unsigned)bal; const int wi = __ffs((int)hb) - 1;
                idx[k] = wi; val[k] = m; if (qc == wi) cur = -INFINITY; }
            if (qc < 4) { const float e1 = __expf(val[1] - val[0]), e2 = __expf(val[2] - val[0]), e3 = __expf(val[3] - val[0]); const float inv = 1.f / (1.f + e1 + e2 + e3);
                const float gsel = qc == 0 ? inv : (qc == 1 ? e1 * inv : (qc == 2 ? e2 * inv : e3 * inv)); const int esel = qc == 0 ? idx[0] : (qc == 1 ? idx[1] : (qc == 2 ? idx[2] : idx[3]));
                se[tok * 4 + qc] = esel; sg[tok * 4 + qc] = gsel; ssl[tok * 4 + qc] = atomicAdd((unsigned*)&hist[esel], 1u); } }
        __syncthreads();
        if (tid < NE) basev[tid] = atomicAdd(&cnt[tid], hist[tid]);
        __syncthreads();
        if (tid < 128) { const int tok = tid >> 2, e = se[tid]; const unsigned sl = basev[e] + ssl[tid]; const int tg = tk0 + tok;
            toke[tg * 4 + (tid & 3)] = e; toks[tg * 4 + (tid & 3)] = (int)sl; ltok[(size_t)e * T + sl] = tg; lgate[(size_t)e * T + sl] = sg[tid]; }
    }
}
__device__ __forceinline__ void moe_setup(const Args& a, LAS unsigned char* lds, int nct, int G, int c, bool gather, unsigned pitch, bool plain) {
    LAS int* s_cnt = (LAS int*)(lds + TB_CNT); LAS int* s_ptile = (LAS int*)(lds + TB_PTILE); LAS int* s_re = (LAS int*)(lds + TB_RE); LAS int* s_tstart = (LAS int*)(lds + TB_TSTART);
    LAS int* s_misc = (LAS int*)(lds + TB_MISC); LAS int* s_units = (LAS int*)(lds + TB_UNITS); LAS unsigned* rowtab = (LAS unsigned*)(lds + TB_ROWTAB);
    const unsigned* cnt = (const unsigned*)(a.ws + WS_CTL); const int* ltok = (const int*)(a.ws + WS_LTOK);
    const int tid = threadIdx.x;
    __syncthreads();
    if (tid < NE) s_cnt[tid] = (int)cnt[tid];
    __syncthreads();
    if (tid == 0) { int pt = 0, ts = 0;
        for (int e = 0; e < NE; ++e) { const int cn = s_cnt[e], re = (cn + 255) >> 8; s_ptile[e] = pt; s_re[e] = re; s_tstart[e] = ts; pt += re; ts += re * nct; }
        s_ptile[NE] = pt; s_tstart[NE] = ts; s_misc[0] = ts; s_misc[1] = (ts + G - 1) / G; }
    __syncthreads();
    if (tid < 16) { const int nwg = s_misc[0]; const long L = (long)tid * G + c; int pm = -1, pn = 0;
        if (L < nwg) { int wgid = (int)L; { const int q = nwg / 8, r = nwg % 8, xcd = wgid % 8, off = wgid / 8; wgid = (xcd < r ? xcd * (q + 1) : r * (q + 1) + (xcd - r) * q) + off; }
            int e = 0; while (wgid >= s_tstart[e + 1]) ++e;
            const int local = wgid - s_tstart[e], re = s_re[e]; pm = s_ptile[e] + local % re; pn = e * nct + local / re; }
        s_units[2 * tid] = pm; s_units[2 * tid + 1] = pn; }
    __syncthreads();
    if (gather) { const int nr = s_misc[1] < 9 ? s_misc[1] : 9;
        LAS float* btab = (LAS float*)(lds + 131072); LAS float* gtab = btab + 5 * 256;
        float bv_[5], gv_[5]; unsigned rv_[5];
#pragma unroll
        for (int q = 0; q < 5; ++q) { const int idx = tid + q * NT, i = idx >> 8, r = idx & 255; bv_[q] = 0.f; gv_[q] = 0.f; rv_[q] = 0u;
            if (i < nr) { const int pm = s_units[2 * i]; if (pm >= 0) { const int e = s_units[2 * i + 1] / nct, ct = s_units[2 * i + 1] % nct, sl = (pm - s_ptile[e]) * 256 + r; const bool ok = sl < s_cnt[e];
                if (plain) { bv_[q] = a.in[19][(size_t)e * 1024 + ct * 256 + r]; gv_[q] = ok ? ((const float*)(a.ws + WS_LGATE))[(size_t)e * T + sl] : 0.f; rv_[q] = (unsigned)(pm * 256 + r) * pitch; }
                else { bv_[q] = a.in[17][(size_t)e * 2048 + (r < 128 ? 0 : 1024 - 128) + ct * 128 + r]; rv_[q] = ok ? (unsigned)ltok[(size_t)e * T + sl] * pitch : 0u; } } } }
#pragma unroll
        for (int q = 0; q < 5; ++q) { const int idx = tid + q * NT, i = idx >> 8; if (i < nr) { btab[idx] = bv_[q]; rowtab[idx] = rv_[q]; if (plain) gtab[idx] = gv_[q]; } } }
    __syncthreads();
}
typedef float float2v __attribute__((ext_vector_type(2)));
__device__ __forceinline__ void ph_final(const Args& a, LAS unsigned char* lds, int bid, int nb) {
    const float* hh = a.in[0]; const bf16* dl = (const bf16*)(a.ws + WS_H); const unsigned char* ys = a.ws + WS_YS; const int* toke = (const int*)(a.ws + WS_TOKE); const int* toks = (const int*)(a.ws + WS_TOKS);
    const unsigned* cnt = (const unsigned*)(a.ws + WS_CTL); const float* g = a.in[20]; float* out = a.out;
    LAS int* s_ps = (LAS int*)(lds + TB_PTILE);
    __syncthreads();
    LAS int* s_c = (LAS int*)(lds + TB_CNT); if (threadIdx.x < NE) s_c[threadIdx.x] = (int)cnt[threadIdx.x];
    __syncthreads();
    if (threadIdx.x == 0) { int pt = 0; for (int e = 0; e < NE; ++e) { s_ps[e] = pt; pt += (s_c[e] + 255) >> 8; } }
    __syncthreads();
    const int lane = threadIdx.x & 63, gw = bid * 8 + (threadIdx.x >> 6), ngw = nb * 8;
    size_t myoff = 0; { const int j = lane >> 2, k = lane & 3, r = gw + j * ngw; if (lane < 32 && r < T) myoff = ((size_t)s_ps[toke[r * 4 + k]] * 256 + toks[r * 4 + k]) * 1024; }
    for (int j = 0; gw + j * ngw < T; ++j) { const int r = gw + j * ngw;
        float4 v[4]; int wq[4][4];
        if (j < 8) {
#pragma unroll
            for (int k = 0; k < 4; ++k) { const size_t off = __shfl(myoff, (j & 7) * 4 + k);
#pragma unroll
                for (int jj = 0; jj < 4; ++jj) wq[k][jj] = *(const int*)(ys + off + 4 * lane + 256 * jj); } }
        else {
#pragma unroll
            for (int k = 0; k < 4; ++k) { const size_t off = ((size_t)s_ps[toke[r * 4 + k]] * 256 + toks[r * 4 + k]) * 1024;
#pragma unroll
                for (int jj = 0; jj < 4; ++jj) wq[k][jj] = *(const int*)(ys + off + 4 * lane + 256 * jj); } }
#pragma unroll
        for (int jj = 0; jj < 4; ++jj) { v[jj] = *(const float4*)(hh + (size_t)r * DM + 4 * lane + 256 * jj); const uint2 dw = *(const uint2*)(dl + (size_t)r * DM + 4 * lane + 256 * jj);
            v[jj].x += bflo(dw.x); v[jj].y += bfhi(dw.x); v[jj].z += bflo(dw.y); v[jj].w += bfhi(dw.y); }
#pragma unroll
        for (int k = 0; k < 4; ++k)
#pragma unroll
            for (int jj = 0; jj < 4; ++jj) { const int w = wq[k][jj];
                const float2v lo = __builtin_amdgcn_cvt_pk_f32_fp8(w, false), hi = __builtin_amdgcn_cvt_pk_f32_fp8(w, true);
                v[jj].x += lo[0] * (1.f / YS8_SCALE); v[jj].y += lo[1] * (1.f / YS8_SCALE); v[jj].z += hi[0] * (1.f / YS8_SCALE); v[jj].w += hi[1] * (1.f / YS8_SCALE); }
        float s = 0.f;
#pragma unroll
        for (int jj = 0; jj < 4; ++jj) s += v[jj].x * v[jj].x + v[jj].y * v[jj].y + v[jj].z * v[jj].z + v[jj].w * v[jj].w;
        const float rs = rsqrtf(wave_sum(s) * (1.f / DM) + EPS);
#pragma unroll
        for (int jj = 0; jj < 4; ++jj) { const float4 gg = *(const float4*)(g + 4 * lane + 256 * jj);
            *(float4*)(out + (size_t)r * DM + 4 * lane + 256 * jj) = make_float4(v[jj].x * rs * gg.x, v[jj].y * rs * gg.y, v[jj].z * rs * gg.z, v[jj].w * rs * gg.w); }
    }
}

__global__ void __launch_bounds__(NT, 2) mk_fwd(Args args) {
    extern __shared__ __attribute__((aligned(16))) unsigned char smem[];
    LAS unsigned char* lds = (LAS unsigned char*)smem;
    const int tid = threadIdx.x, bid = blockIdx.x, G = gridDim.x;
    unsigned char* ws = args.ws;
    const int lo = args.ph_lo, hi = args.ph_hi;
#define IN(k) (lo <= (k) && (k) < hi)
#define BOTH(k) (IN(k) && IN((k) + 1))
    XcdBarrier bar; bar.bar = (unsigned*)(ws + WS_CTL) + CW_BAR + args.bar_sel * XCD_BAR_WORDS; bar.x = 0; bar.st = nullptr;
    if (MK_ONE_LAUNCH) {
        if (tid < 4) ((volatile LAS unsigned*)(lds + XBW_OFF))[tid] = 0u;
        __syncthreads();
        bar = xcd_barrier_post((unsigned*)(ws + WS_CTL) + CW_BAR + args.bar_sel * XCD_BAR_WORDS, (volatile LAS unsigned*)(lds + XBW_OFF));
    }
#define GRID_BAR() do { if (MK_ONE_LAUNCH) xcd_barrier(bar); } while (0)

    if (IN(0)) { ph_prologue(args, lds, bid, G); if (BOTH(0)) GRID_BAR(); }
    if (IN(1)) {
        const int gp = G > 192 ? 192 : G;
        if (bid < gp) {
            pg8::Gemm g{(const bf16*)(ws + WS_U), (const bf16*)(ws + WS_WIN), T, NP, DM}; pg8::StaticOrder S; S.init(T, NP, gp, bid);
            pg8::EpiStoreBf16 E{(bf16*)(ws + WS_PROJ), NP};
            pg8::gemm_phase<pg8::EpiStoreBf16, pg8::StaticOrder, true, true, false>(lds, g, S, E); }
        __syncthreads();
        moe_weight_queue(args, lds, bid);
        if (BOTH(1)) GRID_BAR();
    }
    if (IN(3)) { ph_ssd_local(args, lds, bid, G); if (BOTH(3)) GRID_BAR(); }
    if (IN(4)) { ph_scan(args, bid, G); if (BOTH(4)) GRID_BAR(); }
    if (IN(5)) { ph_ssd_out(args, lds, bid, G); ph_attn(args, lds, bid, G); if (BOTH(5)) GRID_BAR(); }
    if (IN(7)) {
        __syncthreads();
        pg8::Gemm g{(const bf16*)(ws + WS_CAT), (const bf16*)(ws + WS_WOUT), T, DM, DM}; pg8::StaticOrder S; S.init(T, DM, G, bid);
        LAS float* r1 = (LAS float*)(lds + TAB_OFF); LAS float* r2 = r1 + 256;
        { pg8::Unit u0; if (S.next(0, u0) && tid < 256) { const size_t row = (size_t)u0.pm * 256 + tid; const float* sd = (const float*)(ws + WS_SSSD) + row * 2; const float* sa = (const float*)(ws + WS_SSAT) + row * 8;
            const float s1 = sd[0] + sd[1], s2 = ((sa[0] + sa[1]) + (sa[2] + sa[3])) + ((sa[4] + sa[5]) + (sa[6] + sa[7]));
            r1[tid] = rsqrtf(s1 * (1.f / 512) + EPS); r2[tid] = rsqrtf(s2 * (1.f / 512) + EPS); } }
        __syncthreads();
        pg8::EpiResScale E{(bf16*)(ws + WS_H), DM, r1, r2};
        pg8::gemm_phase<pg8::EpiResScale, pg8::StaticOrder, false, true, false>(lds, g, S, E);
        if (BOTH(7)) GRID_BAR();
    }
    if (IN(8)) { ph_router(args, lds, bid, G); if (BOTH(8)) GRID_BAR(); }
    if (IN(9)) {
        moe_setup(args, lds, 8, G, bid, true, 1024u, false);
        pg8::Gemm g{(const bf16*)(ws + WS_U2), (const bf16*)(ws + WS_W1), MAXROWS, NE * 2048, DM / 2};
        pg8::MoeOrder S{(const LAS int*)(lds + TB_UNITS), (const LAS unsigned*)(lds + TB_ROWTAB), __builtin_amdgcn_readfirstlane(*(const LAS int*)(lds + TB_MISC + 4))};
        pg8::EpiSwiglu E{ws + WS_ACT, (const LAS float*)(lds + 131072), 1.f / W8_SCALE, ACT8_SCALE};
        pg8::gemm_phase<pg8::EpiSwiglu, pg8::MoeOrder, true, true, true, true>(lds, g, S, E);
        if (BOTH(9)) GRID_BAR();
    }
    if (IN(10)) {
        moe_setup(args, lds, 4, G, bid, true, 1024u, true);
        pg8::Gemm g{(const bf16*)(ws + WS_ACT), (const bf16*)(ws + WS_W2), MAXROWS, NE * 1024, DM / 2};
        pg8::MoeOrder S{(const LAS int*)(lds + TB_UNITS), (const LAS unsigned*)(lds + TB_ROWTAB), __builtin_amdgcn_readfirstlane(*(const LAS int*)(lds + TB_MISC + 4))};
        pg8::EpiMoe2 E{ws + WS_YS, (const LAS float*)(lds + 131072), (const LAS float*)(lds + 131072) + 5 * 256, 1.f / (W8_SCALE * ACT8_SCALE), YS8_SCALE};
        pg8::gemm_phase<pg8::EpiMoe2, pg8::MoeOrder, true, true, true, true>(lds, g, S, E);
        if (BOTH(10)) GRID_BAR();
    }
    if (IN(11)) { ph_final(args, lds, bid, G); }
#undef IN
#undef BOTH
}

extern "C" void kernel_launch(void* const* d_in, const int* in_sizes, int n_in, void* d_out, int out_size, void* d_ws, size_t ws_size, hipStream_t stream) {
    static int grid = 0;
    if (grid == 0) {
        if (n_in != 21 || out_size != T * DM || ws_size < WS_END) { fprintf(stderr, "kernel_launch: unexpected shapes (n_in %d out %d ws %zu)\n", n_in, out_size, ws_size); grid = -1; return; }
        int dev = 0, cus = 0, per_cu = 0;
        if (hipGetDevice(&dev) != hipSuccess || hipDeviceGetAttribute(&cus, hipDeviceAttributeMultiprocessorCount, dev) != hipSuccess) { grid = -1; return; }
        if (hipFuncSetAttribute((const void*)mk_fwd, hipFuncAttributeMaxDynamicSharedMemorySize, LDS_BYTES) != hipSuccess) { fprintf(stderr, "kernel_launch: hipFuncSetAttribute failed\n"); grid = -1; return; }
        if (hipOccupancyMaxActiveBlocksPerMultiprocessor(&per_cu, (const void*)mk_fwd, NT, LDS_BYTES) != hipSuccess || per_cu < 1) { fprintf(stderr, "kernel_launch: occupancy query says %d blocks per CU\n", per_cu); }
        (void)hipGetLastError();
        grid = cus;
    }
    if (grid < 0) return;
    if (hipMemsetAsync((char*)d_ws + WS_CTL, 0, 65536, stream) != hipSuccess) return;
    Args a{};
    for (int i = 0; i < 21; ++i) a.in[i] = (const float*)d_in[i];
    a.out = (float*)d_out; a.ws = (unsigned char*)d_ws;
#if MK_ONE_LAUNCH
    a.ph_lo = 0; a.ph_hi = NPH;
    hipLaunchKernelGGL(mk_fwd, dim3(grid), dim3(NT), LDS_BYTES, stream, a);
#if defined(PROBE_LO)
    a.ph_lo = PROBE_LO; a.ph_hi = PROBE_HI; a.bar_sel = 1;
    hipLaunchKernelGGL(mk_fwd, dim3(grid), dim3(NT), LDS_BYTES, stream, a);
#endif
#if defined(PROBE_LO2)
    a.ph_lo = PROBE_LO2; a.ph_hi = PROBE_HI2; a.bar_sel = 2;
    hipLaunchKernelGGL(mk_fwd, dim3(grid), dim3(NT), LDS_BYTES, stream, a);
#endif
#else
    for (int ph = 0; ph < NPH; ++ph) { a.ph_lo = ph; a.ph_hi = ph + 1; hipLaunchKernelGGL(mk_fwd, dim3(grid), dim3(NT), LDS_BYTES, stream, a); }
#endif
}
```

```cpp
#include <hip/hip_runtime.h>
#include <cstdio>
#include <cstdint>

#ifndef MK_ONE_LAUNCH
#define MK_ONE_LAUNCH 1
#endif

constexpr int BATCH = 8, SEQ = 2048, T = BATCH * SEQ, DM = 1024, DPROJ = 2312;
constexpr int NCH = SEQ / 128;
constexpr int NE = 32, TOPK = 4;
constexpr int O_DT = 1536;
constexpr int NP = 2304;
constexpr int PZ = 0, PXBC = 512, PQ = 1536, PK = 2048, PV = 2176;
constexpr float EPS = 1e-5f;
constexpr int NT = 512;
constexpr int MAXROWS = T * TOPK + NE * 256;
constexpr int NPH = 12;

__constant__ int c_bucket[129] = {0, 1, 2, 3, 4, 5, 6, 7, 8, 9, 10, 11, 12, 13, 14, 15, 16, 16, 16, 17, 17, 18, 18, 18, 19, 19, 19, 20, 20, 20, 20, 21, 21, 21, 21, 22, 22, 22, 22, 22, 23, 23, 23, 23, 23, 23, 24, 24, 24, 24, 24, 24, 25, 25, 25, 25, 25, 25, 25, 26, 26, 26, 26, 26, 26, 26, 26, 27, 27, 27, 27, 27, 27, 27, 27, 27, 27, 28, 28, 28, 28, 28, 28, 28, 28, 28, 28, 29, 29, 29, 29, 29, 29, 29, 29, 29, 29, 29, 29, 30, 30, 30, 30, 30, 30, 30, 30, 30, 30, 30, 30, 30, 30, 31, 31, 31, 31, 31, 31, 31, 31, 31, 31, 31, 31, 31, 31, 31, 31};

constexpr size_t MiB = 1ull << 20;
constexpr size_t WS_CTL = 0, CTL_ZERO_BYTES = 1 * MiB;
constexpr int CW_BAR = 4096;
static_assert((CW_BAR + 3 * 3456) * 4 <= 65536, "control words inside the per-call memset");
constexpr size_t WS_WIN = 1 * MiB;
constexpr size_t WS_WOUT = WS_WIN + (size_t)NP * DM * 2;
constexpr size_t WS_W1 = WS_WOUT + (size_t)DM * DM * 2;
constexpr size_t WS_W2 = WS_W1 + (size_t)NE * 2048 * 1024 * 2;
constexpr size_t WS_U = WS_W2 + (size_t)NE * 1024 * 1024 * 2;
constexpr size_t WS_DTRAW = WS_U + (size_t)T * DM * 2;
constexpr size_t WS_PROJ = WS_DTRAW + (size_t)T * 8 * 4;
constexpr size_t WS_XC = WS_PROJ + (size_t)T * NP * 2;
constexpr size_t WS_DT = WS_XC + (size_t)T * 1024 * 4;
constexpr size_t WS_ACUM = WS_DT + (size_t)T * 8 * 4;
constexpr size_t WS_CDEC = WS_ACUM + (size_t)T * 8 * 4;
constexpr size_t WS_STATES = WS_CDEC + 1 * MiB;
constexpr size_t WS_PREV = WS_STATES + (size_t)BATCH * NCH * 8 * 8192 * 4;
constexpr size_t WS_YG = WS_PREV + (size_t)BATCH * NCH * 8 * 8192 * 4;
constexpr size_t WS_YGB = WS_YG;
constexpr size_t WS_SSSD = WS_YG + (size_t)T * 512 * 2;
constexpr size_t WS_AO = WS_YG + (size_t)T * 512 * 4;
constexpr size_t WS_SSAT = WS_AO + (size_t)T * 512 * 2;
constexpr size_t WS_CAT = WS_SSAT + (size_t)T * 8 * 4;
constexpr size_t WS_H = WS_CAT + (size_t)T * DM * 2;
constexpr size_t WS_U2 = WS_H + (size_t)T * DM * 4;
constexpr size_t WS_TOKE = WS_U2 + (size_t)T * DM * 2;
constexpr size_t WS_TOKS = WS_TOKE + (size_t)T * 4 * 4;
constexpr size_t WS_LTOK = WS_TOKS + (size_t)T * 4 * 4;
constexpr size_t WS_LGATE = WS_LTOK + (size_t)NE * T * 4;
constexpr size_t WS_ACT = WS_LGATE + (size_t)NE * T * 4;
constexpr size_t WS_YS = WS_ACT + (size_t)MAXROWS * 1024 * 2;
constexpr size_t WS_END = WS_YS + (size_t)MAXROWS * 1024 * 2;
static_assert(WS_END <= 1024 * MiB, "workspace");

constexpr int SCR_BYTES = 143360;
constexpr int TAB_OFF = SCR_BYTES;
constexpr int TB_CNT = TAB_OFF, TB_PTILE = TAB_OFF + 128, TB_RE = TAB_OFF + 272, TB_TSTART = TAB_OFF + 400, TB_MISC = TAB_OFF + 544, TB_UNITS = TAB_OFF + 576, TB_ROWTAB = TAB_OFF + 1024;
constexpr int XBW_OFF = TB_ROWTAB + 9 * 256 * 4;
constexpr int LDS_BYTES = 163840;
static_assert(XBW_OFF + 16 <= LDS_BYTES && XBW_OFF % 16 == 0, "LDS map");

#define GAS __attribute__((address_space(1)))
#define LAS __attribute__((address_space(3)))
typedef unsigned short bf16;
typedef unsigned v4u __attribute__((ext_vector_type(4)));
#define LDS_WAIT() asm volatile("s_waitcnt lgkmcnt(0)" ::: "memory")
#define VM_WAIT() asm volatile("s_waitcnt vmcnt(0)" ::: "memory")
__device__ __forceinline__ unsigned f2bf(float f) { unsigned u = __builtin_bit_cast(unsigned, f); return (u + 0x7fffu + ((u >> 16) & 1u)) >> 16; }
__device__ __forceinline__ unsigned pk2(float lo, float hi) { return f2bf(lo) | (f2bf(hi) << 16); }
__device__ __forceinline__ float bf2f(unsigned short b) { return __uint_as_float((unsigned)b << 16); }
__device__ __forceinline__ float bflo(unsigned w) { return __uint_as_float(w << 16); }
__device__ __forceinline__ float bfhi(unsigned w) { return __uint_as_float(w & 0xffff0000u); }

namespace pg8 {
#define PG8_LAS __attribute__((address_space(3)))
typedef unsigned short bf16_t;
typedef short bf16x8 __attribute__((ext_vector_type(8)));
typedef float f32x4 __attribute__((ext_vector_type(4)));
typedef unsigned u32x4 __attribute__((ext_vector_type(4)));
typedef unsigned u32x2 __attribute__((ext_vector_type(2)));
typedef int i32x8 __attribute__((ext_vector_type(8)));
typedef int i32x4 __attribute__((ext_vector_type(4)));
constexpr int BM = 256, BK = 64, HALF = 128, HTB = HALF * BK * 2  , STAGE_BYTES = 8 * HTB, NXCD = 8, WGM = 8;

__host__ __device__ __forceinline__ int lds_byte(int r, int c) { const int st = (r >> 4) * 2 + (c >> 5), rr = r & 15, cc = c & 31, ob = rr * 64 + cc * 2; return st * 1024 + (ob ^ (((ob >> 9) & 1) << 5)); }
__host__ __device__ __forceinline__ void stage_rc(int b, int& R, int& C) { const int st = b / 1024, sb = b % 1024, swz = sb ^ (((sb >> 9) & 1) << 5); R = (st >> 1) * 16 + swz / 64; C = (st & 1) * 32 + (swz % 64) / 2; }
__host__ __device__ __forceinline__ int perm32(int rho) { const int n = rho >> 4, i = rho & 15; return 8 * (i >> 2) + 4 * n + (i & 3); }

struct Unit { int pm, pn, rid; };
struct Gemm { const bf16_t* A; const bf16_t* Bt; int M, N, K; };

struct StaticOrder {
    int nM, nN, nwg, G, c;
    __host__ __device__ __forceinline__ void init(int M, int N, int G_, int c_) { nM = M / BM; nN = N / BM; nwg = nM * nN; G = G_; c = c_; }
    __host__ __device__ __forceinline__ bool next(int i, Unit& u) const {
        const long L = (long)i * G + c; if (L >= nwg) return false;
        int wgid = (int)L; { const int q = nwg / NXCD, r = nwg % NXCD, xcd = wgid % NXCD, off = wgid / NXCD; wgid = (xcd < r ? xcd * (q + 1) : r * (q + 1) + (xcd - r) * q) + off; }
        const int nig = WGM * nN, gid = wgid / nig, fm = gid * WGM, gsz = (nM - fm) < WGM ? (nM - fm) : WGM;
        u.pm = fm + ((wgid % nig) % gsz); u.pn = (wgid % nig) / gsz; u.rid = 0; return true;
    }
    __device__ __forceinline__ void a_ready(const Unit&) const {}
    __device__ __forceinline__ void done(const Unit&) const {}
};


typedef float f32x2 __attribute__((ext_vector_type(2)));
__device__ __forceinline__ unsigned cvt_pk_bf16(float lo, float hi) { unsigned r; asm volatile("v_cvt_pk_bf16_f32 %0, %1, %2" : "=v"(r) : "v"(lo), "v"(hi)); return r; }

struct EpiStoreBf16 {
    static constexpr bool PERM = true, AFTER_DRAIN = false, HAS_MID = false;
    bf16_t* O; int ldc;
    __device__ __forceinline__ void operator()(const f32x4 (&acc)[2][2][4][2], const Unit& u, int wr, int wc, int fr, int fq) const {
        const int row0 = u.pm * BM + wr * 64 + fr, col0 = u.pn * BM + wc * 32 + 8 * fq;
#pragma unroll
        for (int ai = 0; ai < 2; ++ai)
#pragma unroll
            for (int m = 0; m < 4; ++m) { bf16_t* rowp = O + (size_t)(row0 + ai * HALF + m * 16) * ldc + col0;
#pragma unroll
                for (int bj = 0; bj < 2; ++bj) { const f32x4 v0 = acc[ai][bj][m][0], v1 = acc[ai][bj][m][1];
                    u32x4 w; w.x = cvt_pk_bf16(v0[0], v0[1]); w.y = cvt_pk_bf16(v0[2], v0[3]); w.z = cvt_pk_bf16(v1[0], v1[1]); w.w = cvt_pk_bf16(v1[2], v1[3]);
                    *(u32x4*)(rowp + bj * HALF) = w; } }
    }
};
struct EpiResF32 {
    static constexpr bool PERM = false, AFTER_DRAIN = false, HAS_MID = false;
    const float* __restrict__ base; float* __restrict__ C; int ldc;
    __device__ __forceinline__ void operator()(const f32x4 (&acc)[2][2][4][2], const Unit& u, int wr, int wc, int fr, int fq) const {
        const int row0 = u.pm * BM + wr * 64 + fr, col0 = u.pn * BM + wc * 32 + 4 * fq;
#pragma unroll
        for (int ai = 0; ai < 2; ++ai)
#pragma unroll
            for (int m = 0; m < 4; ++m) { const size_t off = (size_t)(row0 + ai * HALF + m * 16) * ldc + col0; f32x4 bs[2][2];
#pragma unroll
                for (int bj = 0; bj < 2; ++bj)
#pragma unroll
                    for (int n = 0; n < 2; ++n) bs[bj][n] = __builtin_nontemporal_load((const f32x4*)(base + off + bj * HALF + n * 16));
#pragma unroll
                for (int bj = 0; bj < 2; ++bj)
#pragma unroll
                    for (int n = 0; n < 2; ++n) *(f32x4*)(C + off + bj * HALF + n * 16) = bs[bj][n] + acc[ai][bj][m][n]; }
    }
};
struct EpiResScale {
    static constexpr bool PERM = true, AFTER_DRAIN = false, HAS_MID = true;
    bf16_t* D; int ldc; const PG8_LAS float* r1; const PG8_LAS float* r2;
    __device__ __forceinline__ void mid(f32x4 (&acc)[2][2][4][2], const Unit&, int wr, int, int fr, int) const {
#pragma unroll
        for (int ai = 0; ai < 2; ++ai)
#pragma unroll
            for (int m = 0; m < 4; ++m) { const int rl = ai * HALF + wr * 64 + m * 16 + fr; const float f = r1[rl] / r2[rl];
#pragma unroll
                for (int bj = 0; bj < 2; ++bj)
#pragma unroll
                    for (int n = 0; n < 2; ++n) acc[ai][bj][m][n] *= f; }
    }
    __device__ __forceinline__ void operator()(const f32x4 (&acc)[2][2][4][2], const Unit& u, int wr, int wc, int fr, int fq) const {
        const int row0 = u.pm * BM + wr * 64 + fr, col0 = u.pn * BM + wc * 32 + 8 * fq;
#pragma unroll
        for (int ai = 0; ai < 2; ++ai)
#pragma unroll
            for (int m = 0; m < 4; ++m) { bf16_t* rowp = D + (size_t)(row0 + ai * HALF + m * 16) * ldc + col0; const float f = r2[ai * HALF + wr * 64 + m * 16 + fr];
#pragma unroll
                for (int bj = 0; bj < 2; ++bj) { const f32x4 v0 = acc[ai][bj][m][0] * f, v1 = acc[ai][bj][m][1] * f;
                    u32x4 w; w.x = cvt_pk_bf16(v0[0], v0[1]); w.y = cvt_pk_bf16(v0[2], v0[3]); w.z = cvt_pk_bf16(v1[0], v1[1]); w.w = cvt_pk_bf16(v1[2], v1[3]);
                    *(u32x4*)(rowp + bj * HALF) = w; } }
    }
};
struct EpiSwiglu {
    static constexpr bool PERM = true, AFTER_DRAIN = false, HAS_MID = false;
    unsigned char* act; const PG8_LAS float* btab; float dq, asc;
    __device__ __forceinline__ void operator()(const f32x4 (&acc)[2][2][4][2], const Unit& u, int wr, int wc, int fr, int fq) const {
        const int e = u.pn >> 3, ct = u.pn & 7, colo = ct * 128 + wc * 32 + 8 * fq;
        const PG8_LAS float* bg = btab + u.rid * 256 + wc * 32 + 8 * fq; (void)e;
        const f32x4 g0 = *(const PG8_LAS f32x4*)bg, g1 = *(const PG8_LAS f32x4*)(bg + 4), l0 = *(const PG8_LAS f32x4*)(bg + 128), l1 = *(const PG8_LAS f32x4*)(bg + 132);
        const int row0 = u.pm * BM + wr * 64 + fr;
#pragma unroll
        for (int ai = 0; ai < 2; ++ai)
#pragma unroll
            for (int m = 0; m < 4; ++m) {
                const f32x4 xg[2] = {acc[ai][0][m][0] * dq + g0, acc[ai][0][m][1] * dq + g1}; const f32x4 xl[2] = {acc[ai][1][m][0] * dq + l0, acc[ai][1][m][1] * dq + l1};
                float o[8];
#pragma unroll
                for (int q = 0; q < 4; ++q) {
                    f32x2 a2 = {xg[q >> 1][2 * (q & 1)], xg[q >> 1][2 * (q & 1) + 1]}, b2 = {xl[q >> 1][2 * (q & 1)], xl[q >> 1][2 * (q & 1) + 1]};
                    a2 = __builtin_elementwise_min(a2, (f32x2){7.f, 7.f}); b2 = __builtin_elementwise_min(__builtin_elementwise_max(b2, (f32x2){-7.f, -7.f}), (f32x2){7.f, 7.f});
                    const f32x2 t2 = a2 * (-1.702f * 1.4426950408889634f); f32x2 e2; e2.x = __builtin_amdgcn_exp2f(t2.x); e2.y = __builtin_amdgcn_exp2f(t2.y);
                    const f32x2 d2 = e2 + 1.f; f32x2 r2; r2.x = __builtin_amdgcn_rcpf(d2.x); r2.y = __builtin_amdgcn_rcpf(d2.y);
                    const f32x2 o2 = (a2 * r2) * (b2 * asc + asc); o[2 * q] = o2.x; o[2 * q + 1] = o2.y; }
                int w0 = 0, w1 = 0; w0 = __builtin_amdgcn_cvt_pk_fp8_f32(o[0], o[1], w0, false); w0 = __builtin_amdgcn_cvt_pk_fp8_f32(o[2], o[3], w0, true);
                w1 = __builtin_amdgcn_cvt_pk_fp8_f32(o[4], o[5], w1, false); w1 = __builtin_amdgcn_cvt_pk_fp8_f32(o[6], o[7], w1, true);
                u32x2 w; w.x = (unsigned)w0; w.y = (unsigned)w1;
                *(u32x2*)(act + (size_t)(row0 + ai * HALF + m * 16) * 1024 + colo) = w; }
    }
};
struct EpiMoe2 {
    static constexpr bool PERM = true, AFTER_DRAIN = false, HAS_MID = false;
    unsigned char* ys; const PG8_LAS float* btab; const PG8_LAS float* gtab; float dq, ysc;
    __device__ __forceinline__ void operator()(const f32x4 (&acc)[2][2][4][2], const Unit& u, int wr, int wc, int fr, int fq) const {
        const int e = u.pn >> 2, ct = u.pn & 3, colb = ct * 256 + wc * 32 + 8 * fq;
        (void)e;
        f32x4 bv[2][2];
#pragma unroll
        for (int bj = 0; bj < 2; ++bj)
#pragma unroll
            for (int n = 0; n < 2; ++n) bv[bj][n] = *(const PG8_LAS f32x4*)(btab + u.rid * 256 + bj * HALF + wc * 32 + 8 * fq + 4 * n);
        const int row0 = u.pm * BM + wr * 64 + fr;
#pragma unroll
        for (int ai = 0; ai < 2; ++ai)
#pragma unroll
            for (int m = 0; m < 4; ++m) { const float gt = gtab[u.rid * 256 + ai * HALF + wr * 64 + m * 16 + fr] * ysc;
                unsigned char* rowp = ys + (size_t)(row0 + ai * HALF + m * 16) * 1024 + colb;
#pragma unroll
                for (int bj = 0; bj < 2; ++bj) { f32x4 v0 = (acc[ai][bj][m][0] * dq + bv[bj][0]) * gt, v1 = (acc[ai][bj][m][1] * dq + bv[bj][1]) * gt;
                    v0 = __builtin_elementwise_min(__builtin_elementwise_max(v0, (f32x4){-440.f, -440.f, -440.f, -440.f}), (f32x4){440.f, 440.f, 440.f, 440.f});
                    v1 = __builtin_elementwise_min(__builtin_elementwise_max(v1, (f32x4){-440.f, -440.f, -440.f, -440.f}), (f32x4){440.f, 440.f, 440.f, 440.f});
                    int w0 = 0, w1 = 0; w0 = __builtin_amdgcn_cvt_pk_fp8_f32(v0[0], v0[1], w0, false); w0 = __builtin_amdgcn_cvt_pk_fp8_f32(v0[2], v0[3], w0, true);
                    w1 = __builtin_amdgcn_cvt_pk_fp8_f32(v1[0], v1[1], w1, false); w1 = __builtin_amdgcn_cvt_pk_fp8_f32(v1[2], v1[3], w1, true);
                    u32x2 w; w.x = (unsigned)w0; w.y = (unsigned)w1; *(u32x2*)(rowp + bj * HALF) = w; } }
    }
};
struct MoeOrder {
    const PG8_LAS int* units; const PG8_LAS unsigned* rowtab; int nr;
    __device__ __forceinline__ bool next(int i, Unit& u) const {
        if (i >= nr) return false;
        const int pm = __builtin_amdgcn_readfirstlane(units[2 * i]); if (pm < 0) return false;
        u.pm = pm; u.pn = __builtin_amdgcn_readfirstlane(units[2 * i + 1]); u.rid = i; return true;
    }
    __device__ __forceinline__ unsigned arow(const Unit& u, int r) const { return rowtab[u.rid * 256 + r]; }
    __device__ __forceinline__ void a_ready(const Unit&) const {}
    __device__ __forceinline__ void done(const Unit&) const {}
};

template <class Epi, class Sched, bool ALIGN_EPI = false, bool SP2 = false, bool GATHER = false, bool FP8 = false>
__device__ __forceinline__ void gemm_phase(PG8_LAS unsigned char* lds, const Gemm g, const Sched& S, const Epi& E) {
    const int tid = threadIdx.x, wid = __builtin_amdgcn_readfirstlane(tid >> 6), lane = tid & 63, wr = wid >> 2, wc = wid & 3, fr = lane & 15, fq = lane >> 4;
    const int K = g.K, nt = K / BK;
    unsigned voffA[2], voffB[2];
#pragma unroll
    for (int i = 0; i < 2; ++i) { int R, C; stage_rc(tid * 16 + i * 8192, R, C); const int Rb = Epi::PERM ? ((R & ~31) + perm32(R & 31)) : R;
        voffA[i] = (unsigned)(R * K + C) * 2u; voffB[i] = (unsigned)(Rb * K + C) * 2u; }
    const size_t kstep = (size_t)(BK * 2);
    const size_t hstep = (size_t)HALF * K * 2;
    const size_t tstep = 2 * hstep;
    const unsigned ldsw = (unsigned)wid * 1024u;
    const int aoff = lds_byte(wr * 64 + fr, fq * 8), boff = lds_byte(wc * 32 + fr, fq * 8);
#define PG8_SA(b, h) (((b) * 2 + (h)) * HTB)
#define PG8_SB(b, h) ((4 + (b) * 2 + (h)) * HTB)
#define PG8_STAGE(bufoff, gbase, voff) do { _Pragma("unroll") for (int _i = 0; _i < 2; ++_i) \
        __builtin_amdgcn_global_load_lds((const unsigned*)((const char*)(gbase) + (voff)[_i]), (PG8_LAS unsigned*)(lds + (bufoff) + ldsw + _i * 8192), 16, 0, 0); } while (0)
#define PG8_STAGE_A(b, h, U, koff) do { if constexpr (GATHER) { PG8_STAGE(PG8_SA(b, h), Ab + (koff), c_ao[h]); } else { PG8_STAGE(PG8_SA(b, h), U##_A + (size_t)(h) * hstep + (koff), voffA); } } while (0)
#define PG8_LDA(dst, b, h) do { _Pragma("unroll") for (int m = 0; m < 4; ++m) _Pragma("unroll") for (int k = 0; k < 2; ++k) dst[m][k] = *(const PG8_LAS bf16x8*)(lds + PG8_SA(b, h) + aoff + m * 2048 + k * 1024); } while (0)
#define PG8_LDB(dst, b, h) do { _Pragma("unroll") for (int n = 0; n < 2; ++n) _Pragma("unroll") for (int k = 0; k < 2; ++k) dst[n][k] = *(const PG8_LAS bf16x8*)(lds + PG8_SB(b, h) + boff + n * 2048 + k * 1024); } while (0)
#define PG8_MMA(ai, bj, At, Bt) do { __builtin_amdgcn_s_setprio(1); _Pragma("unroll") for (int m = 0; m < 4; ++m) _Pragma("unroll") for (int n = 0; n < 2; ++n) { \
        if constexpr (FP8) { const i32x8 ub_ = __builtin_shufflevector(__builtin_bit_cast(i32x4, Bt[n][0]), __builtin_bit_cast(i32x4, Bt[n][1]), 0, 1, 2, 3, 4, 5, 6, 7); \
            const i32x8 ua_ = __builtin_shufflevector(__builtin_bit_cast(i32x4, At[m][0]), __builtin_bit_cast(i32x4, At[m][1]), 0, 1, 2, 3, 4, 5, 6, 7); \
            acc[ai][bj][m][n] = __builtin_amdgcn_mfma_scale_f32_16x16x128_f8f6f4(ub_, ua_, acc[ai][bj][m][n], 0, 0, 0, 0x7f7f7f7f, 0, 0x7f7f7f7f); } \
        else { _Pragma("unroll") for (int k = 0; k < 2; ++k) acc[ai][bj][m][n] = __builtin_amdgcn_mfma_f32_16x16x32_bf16(Bt[n][k], At[m][k], acc[ai][bj][m][n], 0, 0, 0); } } \
        __builtin_amdgcn_s_setprio(0); } while (0)
#define PG8_WAIT_V(n) asm volatile("s_waitcnt vmcnt(" #n ")" ::: "memory")
#define PG8_WAIT_L(n) asm volatile("s_waitcnt lgkmcnt(" #n ")" ::: "memory")
#define PG8_BAR __builtin_amdgcn_s_barrier()
#define PG8_SCHED __builtin_amdgcn_sched_barrier(0)
    Unit cur, nxt; int ui = 0;
    if (!S.next(0, cur)) return;
    f32x4 acc[2][2][4][2];
#pragma unroll
    for (int a = 0; a < 2; ++a)
#pragma unroll
        for (int b = 0; b < 2; ++b)
#pragma unroll
            for (int m = 0; m < 4; ++m)
#pragma unroll
                for (int n = 0; n < 2; ++n) acc[a][b][m][n] = (f32x4){0.f, 0.f, 0.f, 0.f};
    bf16x8 At[4][2], B0[2][2], B1[2][2];
    const char* const Ab = (const char*)g.A; (void)Ab;
    unsigned c_ao[2][2] = {{0u, 0u}, {0u, 0u}}; (void)c_ao;
    int RA0, CA0; stage_rc(tid * 16, RA0, CA0);
    const char* c_A = (const char*)g.A + (size_t)cur.pm * tstep; const char* cB = (const char*)g.Bt + (size_t)cur.pn * tstep;
    if constexpr (GATHER) { _Pragma("unroll") for (int h_ = 0; h_ < 2; ++h_) _Pragma("unroll") for (int i_ = 0; i_ < 2; ++i_) c_ao[h_][i_] = S.arow(cur, h_ * HALF + RA0 + i_ * 64) + (unsigned)CA0 * 2u; }
    S.a_ready(cur);
    if constexpr (SP2) {
        PG8_STAGE(PG8_SB(0, 0), cB, voffB); PG8_STAGE(PG8_SB(0, 1), cB + hstep, voffB); PG8_STAGE_A(0, 0, c, (size_t)0); PG8_STAGE_A(0, 1, c, (size_t)0);
        if (wr == 1) PG8_BAR;
        PG8_WAIT_V(2); PG8_BAR;
        PG8_STAGE(PG8_SB(1, 0), cB + kstep, voffB); PG8_STAGE_A(1, 0, c, kstep); PG8_STAGE(PG8_SB(1, 1), cB + hstep + kstep, voffB);
        PG8_WAIT_V(6); PG8_BAR;
    } else {
        PG8_STAGE(PG8_SB(0, 0), cB, voffB); PG8_STAGE_A(0, 0, c, (size_t)0); PG8_STAGE(PG8_SB(0, 1), cB + hstep, voffB); PG8_STAGE_A(0, 1, c, (size_t)0);
        if (wr == 1) PG8_BAR;
        PG8_WAIT_V(4); PG8_BAR;
        PG8_STAGE(PG8_SB(1, 0), cB + kstep, voffB); PG8_STAGE_A(1, 0, c, kstep); PG8_STAGE(PG8_SB(1, 1), cB + hstep + kstep, voffB);
        PG8_WAIT_V(6); PG8_BAR;
    }
    for (;;) {
        const bool has_next = S.next(ui + 1, nxt);
        const char* n_A = has_next ? (const char*)g.A + (size_t)nxt.pm * tstep : c_A; const char* nB = has_next ? (const char*)g.Bt + (size_t)nxt.pn * tstep : cB;
#pragma unroll 1
        for (int t = 0; t < nt; t += 2) {
            const bool last = (t == nt - 2);
            if constexpr (Epi::HAS_MID) { if (t == (nt >> 1)) E.mid(acc, cur, wr, wc, fr, fq); }
            const char* s_A = last ? n_A : c_A; const size_t k2 = last ? (size_t)0 : (size_t)(t + 2) * kstep; const char* b2 = last ? nB : cB + (size_t)(t + 2) * kstep;
            const char* b3 = b2 + kstep; (void)s_A;
            if (last && has_next) S.a_ready(nxt);
            if constexpr (SP2) {
            PG8_LDB(B0, 0, 0); PG8_LDB(B1, 0, 1); PG8_SCHED; PG8_LDA(At, 0, 0); PG8_STAGE_A(1, 1, c, (size_t)(t + 1) * kstep); if constexpr (GATHER) { if (last && has_next) { _Pragma("unroll") for (int h_ = 0; h_ < 2; ++h_) _Pragma("unroll") for (int i_ = 0; i_ < 2; ++i_) c_ao[h_][i_] = S.arow(nxt, h_ * HALF + RA0 + i_ * 64) + (unsigned)CA0 * 2u; } }
            PG8_WAIT_V(8); PG8_WAIT_L(0); PG8_BAR; PG8_MMA(0, 0, At, B0); PG8_MMA(0, 1, At, B1); PG8_BAR; PG8_SCHED;
            PG8_LDA(At, 0, 1); PG8_STAGE(PG8_SB(0, 0), b2, voffB); PG8_STAGE(PG8_SB(0, 1), b2 + hstep, voffB); PG8_STAGE_A(0, 0, s, k2);
            PG8_WAIT_V(8); PG8_WAIT_L(0); PG8_BAR; PG8_MMA(1, 0, At, B0); PG8_MMA(1, 1, At, B1); PG8_BAR; PG8_SCHED;
            PG8_LDB(B0, 1, 0); PG8_LDB(B1, 1, 1); PG8_SCHED; PG8_LDA(At, 1, 0); PG8_STAGE_A(0, 1, s, k2);
            PG8_WAIT_V(8); PG8_WAIT_L(0); PG8_BAR; PG8_MMA(0, 0, At, B0); PG8_MMA(0, 1, At, B1); PG8_BAR; PG8_SCHED;
            PG8_LDA(At, 1, 1); PG8_STAGE(PG8_SB(1, 0), b3, voffB); PG8_STAGE(PG8_SB(1, 1), b3 + hstep, voffB); PG8_STAGE_A(1, 0, s, k2 + kstep);
            PG8_WAIT_V(8); PG8_WAIT_L(0); PG8_BAR; PG8_MMA(1, 0, At, B0); PG8_MMA(1, 1, At, B1); PG8_BAR; PG8_SCHED;
            } else {
            PG8_LDB(B0, 0, 0); PG8_SCHED; PG8_LDA(At, 0, 0); PG8_STAGE_A(1, 1, c, (size_t)(t + 1) * kstep); if constexpr (GATHER) { if (last && has_next) { _Pragma("unroll") for (int h_ = 0; h_ < 2; ++h_) _Pragma("unroll") for (int i_ = 0; i_ < 2; ++i_) c_ao[h_][i_] = S.arow(nxt, h_ * HALF + RA0 + i_ * 64) + (unsigned)CA0 * 2u; } }
            PG8_WAIT_L(8); PG8_BAR; PG8_WAIT_L(0); PG8_MMA(0, 0, At, B0); PG8_BAR; PG8_SCHED;
            PG8_LDB(B1, 0, 1); PG8_STAGE(PG8_SB(0, 0), b2, voffB);
            PG8_BAR; PG8_WAIT_L(0); PG8_MMA(0, 1, At, B1); PG8_BAR;
            PG8_LDA(At, 0, 1); PG8_STAGE_A(0, 0, s, k2);
            PG8_BAR; PG8_WAIT_L(0); PG8_MMA(1, 0, At, B0); PG8_BAR; PG8_SCHED;
            PG8_STAGE(PG8_SB(0, 1), b2 + hstep, voffB);
            PG8_WAIT_V(6); PG8_BAR; PG8_MMA(1, 1, At, B1); PG8_BAR;
            PG8_LDB(B0, 1, 0); PG8_SCHED; PG8_LDA(At, 1, 0); PG8_STAGE_A(0, 1, s, k2);
            PG8_WAIT_L(8); PG8_BAR; PG8_WAIT_L(0); PG8_MMA(0, 0, At, B0); PG8_BAR; PG8_SCHED;
            PG8_LDB(B1, 1, 1); PG8_STAGE(PG8_SB(1, 0), b3, voffB);
            PG8_BAR; PG8_WAIT_L(0); PG8_MMA(0, 1, At, B1); PG8_BAR;
            PG8_LDA(At, 1, 1); PG8_STAGE_A(1, 0, s, k2 + kstep);
            PG8_BAR; PG8_WAIT_L(0); PG8_MMA(1, 0, At, B0); PG8_BAR; PG8_SCHED;
            PG8_STAGE(PG8_SB(1, 1), b3 + hstep, voffB);
            PG8_WAIT_V(6); PG8_BAR; PG8_MMA(1, 1, At, B1); PG8_BAR;
            }
        }
        if constexpr (ALIGN_EPI) { if (wr == 0) PG8_BAR; }
        if constexpr (!Epi::AFTER_DRAIN) { E(acc, cur, wr, wc, fr, fq); S.done(cur); }
        if (!has_next) break;
#pragma unroll
        for (int a = 0; a < 2; ++a)
#pragma unroll
            for (int b = 0; b < 2; ++b)
#pragma unroll
                for (int m = 0; m < 4; ++m)
#pragma unroll
                    for (int n = 0; n < 2; ++n) acc[a][b][m][n] = (f32x4){0.f, 0.f, 0.f, 0.f};
        cur = nxt; c_A = n_A; cB = nB; ++ui;
        if constexpr (ALIGN_EPI) { if (wr == 1) PG8_BAR; }
    }
    PG8_WAIT_V(0);
    if constexpr (!ALIGN_EPI) { if (wr == 0) PG8_BAR; }
    PG8_BAR;
    if constexpr (Epi::AFTER_DRAIN) { E.fused(acc, cur, wr, wc, fr, fq, lds, wid, lane); S.done(cur); }
#undef PG8_SA
#undef PG8_SB
#undef PG8_STAGE
#undef PG8_STAGE_A
#undef PG8_LDA
#undef PG8_LDB
#undef PG8_MMA
#undef PG8_WAIT_V
#undef PG8_WAIT_L
#undef PG8_BAR
#undef PG8_SCHED
}
}

#define XB_TMO      128
#define XB_XCNT(j)  (256  + 64 * (j))
#define XB_XSUB(j)  (1280 + 64 * (j))
#define XB_XGEN(j)  (2304 + 64 * (j))
#define XB_TOP      3328
#define XB_TOPGEN   3392
#define XCD_BAR_WORDS 3456
#define XB_SPIN_CAP (1u << 18)

__device__ __forceinline__ unsigned xb_ld(unsigned* p)              { return __hip_atomic_load(p, __ATOMIC_RELAXED, __HIP_MEMORY_SCOPE_AGENT); }
__device__ __forceinline__ unsigned xb_add(unsigned* p, unsigned v) { return __hip_atomic_fetch_add(p, v, __ATOMIC_RELAXED, __HIP_MEMORY_SCOPE_AGENT); }
__device__ __forceinline__ unsigned xb_xcc_id() { return (unsigned)__builtin_amdgcn_s_getreg((3 << 11) | 20) & 0xFu; }
#define XB_SPIN(cond, bar) do { unsigned _sp = 0; while (cond) { __builtin_amdgcn_s_sleep(1); \
    if ((++_sp & 255u) == 0u) { if (xb_ld(&(bar)[XB_TMO])) break; if (_sp > XB_SPIN_CAP) { atomicAdd(&(bar)[XB_TMO], 1u); break; } } } } while (0)

struct XcdBarrier {
    unsigned* bar; unsigned x;
    volatile LAS unsigned* st;
};

__device__ __forceinline__ XcdBarrier xcd_barrier_post(unsigned* bar, volatile LAS unsigned* st) {
    XcdBarrier b; b.bar = bar; b.x = xb_xcc_id(); b.st = st;
    if (threadIdx.x == 0) (void)xb_add(&bar[XB_XCNT(b.x)], 1u);
    return b;
}
__device__ __forceinline__ void xcd_barrier_complete(unsigned* bar, unsigned x, unsigned& nloc, unsigned& nx) {
    const unsigned G = gridDim.x * gridDim.y * gridDim.z;
    unsigned sum, cnt, mine, sp = 0u;
    for (;;) {
        sum = 0u; cnt = 0u; mine = 0u;
#pragma unroll
        for (unsigned j = 0; j < 16; ++j) { const unsigned c = xb_ld(&bar[XB_XCNT(j)]); sum += c; cnt += (c > 0u) ? 1u : 0u; mine = (j == x) ? c : mine; }
        if (sum == G) break;
        __builtin_amdgcn_s_sleep(1);
        if ((++sp & 255u) == 0u) { if (xb_ld(&bar[XB_TMO])) break; if (sp > XB_SPIN_CAP) { atomicAdd(&bar[XB_TMO], 1u); break; } }
    }
    nloc = mine > 0u ? mine : 1u; nx = cnt > 0u ? cnt : 1u;
}

__device__ __forceinline__ void xcd_barrier(const XcdBarrier& b) {
    asm volatile("s_waitcnt vmcnt(0)" ::: "memory");
    __syncthreads();
    if (threadIdx.x == 0) {
        unsigned* bar = b.bar;
        __builtin_amdgcn_s_waitcnt(0);
        unsigned nloc = b.st[0], nx = b.st[1];
        if (nloc == 0u) { xcd_barrier_complete(bar, b.x, nloc, nx); b.st[0] = nloc; b.st[1] = nx; }
        const unsigned old = xb_add(&bar[XB_XSUB(b.x)], 1u);
        const unsigned gen = old / nloc;
        if (old + 1u == (gen + 1u) * nloc) {
            __builtin_amdgcn_fence(__ATOMIC_RELEASE, "agent");
            asm volatile("s_waitcnt vmcnt(0)" ::: "memory");
            const unsigned og = xb_add(&bar[XB_TOP], 1u);
            const unsigned tg = og / nx;
            if (og + 1u == (tg + 1u) * nx) xb_add(&bar[XB_TOPGEN], 1u);
            else XB_SPIN(xb_ld(&bar[XB_TOPGEN]) == tg, bar);
            __builtin_amdgcn_fence(__ATOMIC_ACQUIRE, "agent");
            xb_add(&bar[XB_XGEN(b.x)], 1u);
            asm volatile("s_waitcnt vmcnt(0)" ::: "memory");
        } else {
            XB_SPIN(xb_ld(&bar[XB_XGEN(b.x)]) == gen, bar);
            __builtin_amdgcn_fence(__ATOMIC_ACQUIRE, "agent");
            asm volatile("s_waitcnt vmcnt(0)" ::: "memory");
        }
    }
    __syncthreads();
}

typedef short bf16x8 __attribute__((ext_vector_type(8)));
typedef float f32x16 __attribute__((ext_vector_type(16)));
typedef float f32x4v __attribute__((ext_vector_type(4)));
typedef unsigned u32x2v __attribute__((ext_vector_type(2)));
struct Args { const float* in[21]; float* out; unsigned char* ws; int ph_lo, ph_hi, bar_sel, pad; };

__device__ __forceinline__ float wave_sum(float v) {
#pragma unroll
    for (int o = 1; o < 64; o <<= 1) v += __shfl_xor(v, o);
    return v;
}
__device__ __forceinline__ float wave_max(float v) {
#pragma unroll
    for (int o = 1; o < 64; o <<= 1) v = fmaxf(v, __shfl_xor(v, o));
    return v;
}
__device__ __forceinline__ float silu_f(float x) { return x / (1.f + __expf(-x)); }

template <bool GAIN>
__device__ __forceinline__ void cvt_item(const float* W, int ldw, int n0src, bf16* WT, int K, int drow0, int k0, LAS float* scr, int lane, const float* gk = nullptr) {
#pragma unroll 16
    for (int i = 0; i < 32; ++i) { const int kk = 2 * i + (lane >> 5); float v = W[(size_t)(k0 + kk) * ldw + n0src + (lane & 31)]; if (GAIN) v *= gk[kk]; scr[kk * 33 + (lane & 31)] = v; }
    LDS_WAIT(); asm volatile("" ::: "memory");
    const int c = lane & 7;
#pragma unroll
    for (int j = 0; j < 4; ++j) { const int n = (lane >> 3) + 8 * j; const LAS float* s = scr + (8 * c) * 33 + n;
        v4u o; o.x = pk2(s[0 * 33], s[1 * 33]); o.y = pk2(s[2 * 33], s[3 * 33]); o.z = pk2(s[4 * 33], s[5 * 33]); o.w = pk2(s[6 * 33], s[7 * 33]);
        *(GAS v4u*)(WT + (size_t)(drow0 + n) * K + k0 + 8 * c) = o; }
    LDS_WAIT(); asm volatile("" ::: "memory");
}
constexpr float W8_SCALE = 64.f, ACT8_SCALE = 4.f, YS8_SCALE = 16.f;
__device__ __forceinline__ unsigned pk4_fp8(float a, float b, float c, float d) { int w = 0; w = __builtin_amdgcn_cvt_pk_fp8_f32(a, b, w, false); w = __builtin_amdgcn_cvt_pk_fp8_f32(c, d, w, true); return (unsigned)w; }
__device__ __forceinline__ void cvt_item_fp8(const float* W, int ldw, int n0src, unsigned char* WT, int K, int drow0, int k0, LAS float* scr, int lane) {
#pragma unroll 16
    for (int i = 0; i < 32; ++i) { const int kk = 2 * i + (lane >> 5); scr[kk * 33 + (lane & 31)] = W[(size_t)(k0 + kk) * ldw + n0src + (lane & 31)] * W8_SCALE; }
    LDS_WAIT(); asm volatile("" ::: "memory");
    const int c = lane & 3;
#pragma unroll
    for (int j = 0; j < 2; ++j) { const int n = (lane >> 2) + 16 * j; const LAS float* s = scr + (16 * c) * 33 + n;
        v4u o; o.x = pk4_fp8(s[0 * 33], s[1 * 33], s[2 * 33], s[3 * 33]); o.y = pk4_fp8(s[4 * 33], s[5 * 33], s[6 * 33], s[7 * 33]);
        o.z = pk4_fp8(s[8 * 33], s[9 * 33], s[10 * 33], s[11 * 33]); o.w = pk4_fp8(s[12 * 33], s[13 * 33], s[14 * 33], s[15 * 33]);
        *(GAS v4u*)(WT + (size_t)(drow0 + n) * K + k0 + 16 * c) = o; }
    LDS_WAIT(); asm volatile("" ::: "memory");
}
__device__ __forceinline__ void ph_prologue(const Args& a, LAS unsigned char* lds, int bid, int nb) {
    const int tid = threadIdx.x, lane = tid & 63, wave = tid >> 6;
    unsigned char* ws = a.ws;
    LAS float* scr = (LAS float*)(lds + wave * 16384);
    const int gw = bid * 8 + wave, ngw = nb * 8;
    constexpr int I_IN = 16 * 72, I_OUT = 16 * 32;
    for (int it0 = gw; it0 < I_IN + I_OUT; it0 += ngw) {
        int it = it0;
        if (it < I_IN) { const int kb = it / 72, d0 = 32 * (it % 72); cvt_item<false>(a.in[2], DPROJ, d0 < 1536 ? d0 : d0 + 8, (bf16*)(ws + WS_WIN), DM, d0, 64 * kb, scr, lane); continue; }
        it -= I_IN;
        { const int kb = it / 32, d0 = 32 * (it % 32); cvt_item<true>(a.in[12], DM, d0, (bf16*)(ws + WS_WOUT), DM, d0, 64 * kb, scr, lane, (kb < 8 ? a.in[8] : a.in[11] - 512) + 64 * kb); }
    }
    __syncthreads();
    LAS float* wdt = (LAS float*)lds;
    for (int i = tid; i < 1024 * 8; i += NT) wdt[i] = a.in[2][(size_t)(i >> 3) * DPROJ + O_DT + (i & 7)];
    __syncthreads();
    const float* x = a.in[0]; const float* g = a.in[1]; bf16* u = (bf16*)(ws + WS_U); float* dtraw = (float*)(ws + WS_DTRAW);
    float wreg[16][8];
#pragma unroll
    for (int jc = 0; jc < 16; ++jc) { const LAS float* wd = wdt + (size_t)(4 * lane + 256 * (jc >> 2) + (jc & 3)) * 8; const f32x4v w0 = *(const LAS f32x4v*)wd, w1 = *(const LAS f32x4v*)(wd + 4);
        wreg[jc][0] = w0[0]; wreg[jc][1] = w0[1]; wreg[jc][2] = w0[2]; wreg[jc][3] = w0[3]; wreg[jc][4] = w1[0]; wreg[jc][5] = w1[1]; wreg[jc][6] = w1[2]; wreg[jc][7] = w1[3]; }
    for (int r0 = gw; r0 < T; r0 += 2 * ngw) {
        float4 vv[2][4];
#pragma unroll
        for (int q = 0; q < 2; ++q) { const int r = r0 + q * ngw; if (r < T) { const float4* xr = (const float4*)(x + (size_t)r * DM);
#pragma unroll
            for (int j = 0; j < 4; ++j) vv[q][j] = xr[lane + 64 * j]; } }
#pragma unroll
        for (int q = 0; q < 2; ++q) { const int r = r0 + q * ngw; if (r < T) {
        float4 (&v)[4] = vv[q]; float s = 0.f;
#pragma unroll
        for (int j = 0; j < 4; ++j) s += v[j].x * v[j].x + v[j].y * v[j].y + v[j].z * v[j].z + v[j].w * v[j].w;
        const float rs = rsqrtf(wave_sum(s) * (1.f / DM) + EPS);
        float dacc[8];
#pragma unroll
        for (int h = 0; h < 8; ++h) dacc[h] = 0.f;
#pragma unroll
        for (int j = 0; j < 4; ++j) { const float4 gg = ((const float4*)g)[lane + 64 * j];
            const float un[4] = {v[j].x * rs * gg.x, v[j].y * rs * gg.y, v[j].z * rs * gg.z, v[j].w * rs * gg.w};
            uint2 o; o.x = pk2(un[0], un[1]); o.y = pk2(un[2], un[3]);
            *(uint2*)(u + (size_t)r * DM + 4 * lane + 256 * j) = o;
#pragma unroll
            for (int c = 0; c < 4; ++c)
#pragma unroll
                for (int h = 0; h < 8; ++h) dacc[h] += un[c] * wreg[j * 4 + c][h]; }
#pragma unroll
        for (int h = 0; h < 8; ++h) dacc[h] = wave_sum(dacc[h]);
        if (lane == 0) {
#pragma unroll
            for (int h = 0; h < 8; ++h) dtraw[(size_t)r * 8 + h] = dacc[h]; }
        } }
    }
}

constexpr int CW_QHEAD = 1024;
constexpr int I_W1 = NE * 8 * 64, I_W2 = NE * 8 * 32;
struct CvtItem { const float* W; unsigned char* WT; int ldw, n0src, drow0, k0; };
__device__ __forceinline__ CvtItem moe_item(const Args& a, int it) {
    CvtItem c; unsigned char* ws = a.ws;
    if (it < I_W1) { const int e = it >> 9, r = it & 511, kb = r >> 6, d0 = 32 * (r & 63), pn = d0 >> 8, j0 = d0 & 255;
        c.W = a.in[16] + (size_t)e * 1024 * 2048; c.ldw = 2048; c.n0src = j0 < 128 ? pn * 128 + j0 : 1024 + pn * 128 + (j0 - 128); c.WT = ws + WS_W1 + (size_t)e * 2048 * 1024; c.drow0 = d0; c.k0 = 128 * kb; }
    else { it -= I_W1; const int e = it >> 8, r = it & 255, kb = r >> 5, d0 = 32 * (r & 31);
        c.W = a.in[18] + (size_t)e * 1024 * 1024; c.ldw = 1024; c.n0src = d0; c.WT = ws + WS_W2 + (size_t)e * 1024 * 1024; c.drow0 = d0; c.k0 = 128 * kb; }
    return c;
}
__device__ __forceinline__ void cvt8_load(const CvtItem& c, int lane, f32x4v (&v)[16]) {
    const float* p = c.W + (size_t)(c.k0 + 16 * (lane >> 3)) * c.ldw + c.n0src + (lane & 7) * 4;
#pragma unroll
    for (int i = 0; i < 16; ++i) v[i] = __builtin_nontemporal_load((const f32x4v*)(p + (size_t)i * c.ldw));
}
__device__ __forceinline__ void cvt8_finish(const CvtItem& c, int lane, const f32x4v (&v)[16]) {
    unsigned char* q = c.WT + (size_t)(c.drow0 + 4 * (lane & 7)) * DM + c.k0 + 16 * (lane >> 3);
#pragma unroll
    for (int cc = 0; cc < 4; ++cc) { v4u o;
        o.x = pk4_fp8(v[0][cc] * W8_SCALE, v[1][cc] * W8_SCALE, v[2][cc] * W8_SCALE, v[3][cc] * W8_SCALE); o.y = pk4_fp8(v[4][cc] * W8_SCALE, v[5][cc] * W8_SCALE, v[6][cc] * W8_SCALE, v[7][cc] * W8_SCALE);
        o.z = pk4_fp8(v[8][cc] * W8_SCALE, v[9][cc] * W8_SCALE, v[10][cc] * W8_SCALE, v[11][cc] * W8_SCALE); o.w = pk4_fp8(v[12][cc] * W8_SCALE, v[13][cc] * W8_SCALE, v[14][cc] * W8_SCALE, v[15][cc] * W8_SCALE);
        *(GAS v4u*)(q + (size_t)cc * DM) = o; }
}
constexpr int I_MOE = I_W1 + I_W2, QB8 = 4, QPART = I_MOE / 8;
static_assert(QPART % QB8 == 0, "queue partition");
__device__ __forceinline__ void moe_weight_queue(const Args& a, LAS unsigned char* lds, int bid) {
    const int tid = threadIdx.x, lane = tid & 63; (void)lds;
    unsigned* heads = (unsigned*)(a.ws + WS_CTL) + CW_QHEAD;
    for (int k = 0; k < 8; ++k) { const int part = (bid + k) & 7;
        for (;;) { unsigned b0 = 0u; if (lane == 0) b0 = atomicAdd(&heads[64 * part], (unsigned)QB8); b0 = (unsigned)__builtin_amdgcn_readfirstlane((int)b0);
            if (b0 >= (unsigned)QPART) break;
            const int base = part * QPART + (int)b0;
            f32x4v A[16], B[16];
#define QL(j, R) cvt8_load(moe_item(a, base + (j)), lane, R)
#define QF(j, R) cvt8_finish(moe_item(a, base + (j)), lane, R)
            QL(0, A); QL(1, B);
            QF(0, A); QL(2, A); QF(1, B); QL(3, B);
            QF(2, A); QF(3, B); } }
#undef QL
#undef QF
}
__device__ __forceinline__ void ph_conv(const Args& a, int bid, int nb) {
    const bf16* proj = (const bf16*)(a.ws + WS_PROJ); const float* cw = a.in[3]; const float* cb = a.in[4]; const float* dtb = a.in[5]; const float* dtraw = (const float*)(a.ws + WS_DTRAW);
    float* xc = (float*)(a.ws + WS_XC); float* dt = (float*)(a.ws + WS_DT);
    const size_t n = (size_t)T * 1024;
    for (size_t i = (size_t)bid * NT + threadIdx.x; i < n; i += (size_t)nb * NT) {
        const int t = (int)(i >> 10), c = (int)(i & 1023), s = t % SEQ;
        float v = cb[c];
#pragma unroll
        for (int k = 0; k < 4; ++k) { const int ss = s - 3 + k; if (ss >= 0) v += cw[k * 1024 + c] * bf2f(proj[(size_t)(t - 3 + k) * NP + PXBC + c]); }
        xc[i] = silu_f(v);
    }
    for (int i = bid * NT + threadIdx.x; i < T * 8; i += nb * NT) {
        const float v = dtraw[i] + dtb[i & 7];
        dt[i] = v > 20.f ? v : log1pf(__expf(v));
    }
}
__device__ __forceinline__ unsigned cvtpk(float lo, float hi) { unsigned r; asm volatile("v_cvt_pk_bf16_f32 %0, %1, %2" : "=v"(r) : "v"(lo), "v"(hi)); return r; }
__device__ __forceinline__ float silu_fast(float x) { return x * __builtin_amdgcn_rcpf(1.f + __expf(-x)); }
__device__ __forceinline__ void conv_load(const bf16* proj, int t0, int s0, int l0, int ch, unsigned (&raw)[11]) {
#pragma unroll
    for (int i = 0; i < 11; ++i) { const int l = l0 - 3 + i; unsigned wv = 0u; if (s0 + l >= 0) wv = *(const unsigned*)(proj + (size_t)(t0 + l) * NP + PXBC + ch); raw[i] = wv; }
}
__device__ __forceinline__ void conv_compute(const unsigned (&raw)[11], const float* cw, const float* cb, int ch, float (&o0)[8], float (&o1)[8]) {
    float w0[4], w1[4];
#pragma unroll
    for (int k = 0; k < 4; ++k) { const float2 wv = *(const float2*)(cw + k * 1024 + ch); w0[k] = wv.x; w1[k] = wv.y; }
    const float2 bb = *(const float2*)(cb + ch);
#pragma unroll
    for (int j = 0; j < 8; ++j) { float v0 = bb.x, v1 = bb.y;
#pragma unroll
        for (int k = 0; k < 4; ++k) { v0 += w0[k] * bflo(raw[j + k]); v1 += w1[k] * bfhi(raw[j + k]); }
        o0[j] = silu_fast(v0); o1[j] = silu_fast(v1); }
}
constexpr int SL_ST = 272, SL_XW = 0, SL_BMT = 256 * SL_ST, SL_WL = SL_BMT + 128 * SL_ST, SL_TMP = SL_WL + 2048;
__device__ __forceinline__ void ph_ssd_local(const Args& a, LAS unsigned char* lds, int bid, int nb) {
    const bf16* proj = (const bf16*)(a.ws + WS_PROJ); const float* dtraw = (const float*)(a.ws + WS_DTRAW); const float* dtb = a.in[5]; const float* alog = a.in[6];
    float* dtg = (float*)(a.ws + WS_DT); float* acum = (float*)(a.ws + WS_ACUM); float* cdec = (float*)(a.ws + WS_CDEC); float* states = (float*)(a.ws + WS_STATES);
    const int tid = threadIdx.x, lane = tid & 63, w = tid >> 6;
    LAS unsigned char* XW = lds + SL_XW; LAS unsigned char* BMT = lds + SL_BMT; LAS float* wl = (LAS float*)(lds + SL_WL); LAS float* tmp = (LAS float*)(lds + SL_TMP);
    for (int unit = bid; unit < BATCH * NCH * 2; unit += nb) {
        const int g = unit & 1, c = (unit >> 1) % NCH, b = unit / (2 * NCH); const int t0 = b * SEQ + c * 128;
        __syncthreads();
        { const int r = tid >> 7, l = tid & 127, h = g * 4 + r;
          const float v = dtraw[(size_t)(t0 + l) * 8 + h] + dtb[h]; const float dtv = fmaxf(v, 0.f) + log1pf(__expf(-fabsf(v))); const float av = -__expf(alog[h]);
          float x = dtv * av;
#pragma unroll
          for (int o = 1; o < 64; o <<= 1) { const float y = __shfl_up(x, o); if (lane >= o) x += y; }
          if (lane == 63) tmp[w] = x;
          __syncthreads();
          if (w & 1) x += tmp[w - 1];
          const float last = tmp[2 * r] + tmp[2 * r + 1];
          dtg[(size_t)(t0 + l) * 8 + h] = dtv; acum[(size_t)(t0 + l) * 8 + h] = x; wl[r * 128 + l] = dtv * __expf(last - x);
          if (l == 127) cdec[(b * NCH + c) * 8 + h] = __expf(x); }
        __syncthreads();
        { unsigned raw[6][11];
#pragma unroll
          for (int it = 0; it < 6; ++it) { const int task = tid + it * NT, pi = task % 192, l0 = (task / 192) * 8;
              const int ch = pi < 128 ? g * 256 + 2 * pi : 512 + g * 128 + 2 * (pi - 128); conv_load(proj, t0, c * 128, l0, ch, raw[it]); }
#pragma unroll
          for (int it = 0; it < 6; ++it) { const int task = tid + it * NT, pi = task % 192, l0 = (task / 192) * 8;
            const int ch = pi < 128 ? g * 256 + 2 * pi : 512 + g * 128 + 2 * (pi - 128);
            float o0[8], o1[8]; conv_compute(raw[it], a.in[3], a.in[4], ch, o0, o1);
            if (pi < 128) { const int row = 2 * pi; const LAS float* ws_ = wl + (row >> 6) * 128 + l0;
#pragma unroll
                for (int j = 0; j < 8; ++j) { o0[j] *= ws_[j]; o1[j] *= ws_[j]; }
                v4u p0, p1; p0.x = cvtpk(o0[0], o0[1]); p0.y = cvtpk(o0[2], o0[3]); p0.z = cvtpk(o0[4], o0[5]); p0.w = cvtpk(o0[6], o0[7]);
                p1.x = cvtpk(o1[0], o1[1]); p1.y = cvtpk(o1[2], o1[3]); p1.z = cvtpk(o1[4], o1[5]); p1.w = cvtpk(o1[6], o1[7]);
                *(LAS v4u*)(XW + row * SL_ST + l0 * 2) = p0; *(LAS v4u*)(XW + (row + 1) * SL_ST + l0 * 2) = p1; }
            else { const int row = 2 * (pi - 128);
                v4u p0, p1; p0.x = cvtpk(o0[0], o0[1]); p0.y = cvtpk(o0[2], o0[3]); p0.z = cvtpk(o0[4], o0[5]); p0.w = cvtpk(o0[6], o0[7]);
                p1.x = cvtpk(o1[0], o1[1]); p1.y = cvtpk(o1[2], o1[3]); p1.z = cvtpk(o1[4], o1[5]); p1.w = cvtpk(o1[6], o1[7]);
                *(LAS v4u*)(BMT + row * SL_ST + l0 * 2) = p0; *(LAS v4u*)(BMT + (row + 1) * SL_ST + l0 * 2) = p1; } } }
        __syncthreads();
        { const int r = w >> 1, ph = w & 1, qc = lane & 31, hh = lane >> 5, h = g * 4 + r;
          f32x16 acc[4];
#pragma unroll
          for (int n4 = 0; n4 < 4; ++n4)
#pragma unroll
              for (int i = 0; i < 16; ++i) acc[n4][i] = 0.f;
#pragma unroll
          for (int ks = 0; ks < 8; ++ks) { const bf16x8 af = *(const LAS bf16x8*)(XW + (r * 64 + ph * 32 + qc) * SL_ST + (16 * ks + 8 * hh) * 2);
#pragma unroll
              for (int n4 = 0; n4 < 4; ++n4) { const bf16x8 bfr = *(const LAS bf16x8*)(BMT + (n4 * 32 + qc) * SL_ST + (16 * ks + 8 * hh) * 2);
                  acc[n4] = __builtin_amdgcn_mfma_f32_32x32x16_bf16(af, bfr, acc[n4], 0, 0, 0); } }
          float* st = states + ((size_t)((b * NCH + c) * 8 + h)) * 8192;
#pragma unroll
          for (int n4 = 0; n4 < 4; ++n4)
#pragma unroll
              for (int i = 0; i < 16; ++i) { const int pp = ph * 32 + (i & 3) + 8 * (i >> 2) + 4 * hh; st[pp * 128 + n4 * 32 + qc] = acc[n4][i]; } }
    }
}
__device__ __forceinline__ void ph_scan(const Args& a, int bid, int nb) {
    const float* states = (const float*)(a.ws + WS_STATES); const float* cdec = (const float*)(a.ws + WS_CDEC); bf16* prev = (bf16*)(a.ws + WS_PREV);
    const int n4 = BATCH * 8 * 2048;
    for (int i = bid * NT + threadIdx.x; i < n4; i += nb * NT) {
        const int e4 = i & 2047, h = (i >> 11) & 7, b = i >> 14;
        f32x4v st[NCH]; float dc[NCH];
#pragma unroll
        for (int c = 0; c < NCH; ++c) { st[c] = *(const f32x4v*)(states + ((size_t)((b * NCH + c) * 8 + h)) * 8192 + e4 * 4); dc[c] = cdec[(b * NCH + c) * 8 + h]; }
        f32x4v hc = {0.f, 0.f, 0.f, 0.f};
#pragma unroll
        for (int c = 0; c < NCH; ++c) { u32x2v pk; pk.x = cvtpk(hc[0], hc[1]); pk.y = cvtpk(hc[2], hc[3]); *(u32x2v*)(prev + ((size_t)((b * NCH + c) * 8 + h)) * 8192 + e4 * 4) = pk; hc = hc * dc[c] + st[c]; }
    }
}
constexpr int SO_XST = 264, SO_NST = 272, SO_XS = 0, SO_BM = 256 * SO_XST, SO_CM = SO_BM + 128 * SO_NST, SO_AC = SO_CM + 128 * SO_NST, SO_DT = SO_AC + 2048, SO_EA = SO_DT + 2048, SO_END = SO_EA + 2048;
constexpr int SO_YST = 260;
static_assert(128 * SO_YST * 4 <= SO_AC && SO_END <= SCR_BYTES, "ssd_out LDS map");
__device__ __forceinline__ void ph_ssd_out(const Args& a, LAS unsigned char* lds, int bid, int nb) {
    const bf16* proj = (const bf16*)(a.ws + WS_PROJ); const float* dtg = (const float*)(a.ws + WS_DT); const float* acum = (const float*)(a.ws + WS_ACUM);
    const bf16* prev = (const bf16*)(a.ws + WS_PREV); const float* dsk = a.in[7];
    bf16* ygb = (bf16*)(a.ws + WS_CAT); float* ssd = (float*)(a.ws + WS_SSSD);
    const int tid = threadIdx.x, lane = tid & 63, w = tid >> 6, r = w >> 1, lsel = w & 1, qc = lane & 31, hh = lane >> 5;
    LAS unsigned char* XS = lds + SO_XS; LAS unsigned char* BM = lds + SO_BM; LAS unsigned char* CM = lds + SO_CM;
    LAS float* AC = (LAS float*)(lds + SO_AC); LAS float* DT = (LAS float*)(lds + SO_DT); LAS float* EA = (LAS float*)(lds + SO_EA); LAS float* YS = (LAS float*)lds;
    for (int unit = bid; unit < BATCH * NCH * 2; unit += nb) {
        const int g = unit & 1, c = (unit >> 1) % NCH, b = unit / (2 * NCH); const int t0 = b * SEQ + c * 128;
        __syncthreads();
        bf16x8 pf[2][8];
        { const bf16* pvb = prev + ((size_t)((b * NCH + c) * 8 + g * 4 + r)) * 8192 + qc * 128 + 8 * hh;
#pragma unroll
          for (int pb = 0; pb < 2; ++pb)
#pragma unroll
              for (int ks = 0; ks < 8; ++ks) pf[pb][ks] = *(const bf16x8*)(pvb + pb * 32 * 128 + 16 * ks); }
        { const int rr = tid >> 7, l = tid & 127, h = g * 4 + rr; const float ac = acum[(size_t)(t0 + l) * 8 + h];
          AC[rr * 128 + l] = ac; DT[rr * 128 + l] = dtg[(size_t)(t0 + l) * 8 + h]; EA[rr * 128 + l] = __expf(ac); }
#pragma unroll 1
        for (int bt = 0; bt < 2; ++bt) { unsigned raw[4][11];
#pragma unroll
          for (int it = 0; it < 4; ++it) { const int task = tid + (bt * 4 + it) * NT, pi = task & 255, l0 = (task >> 8) * 8;
              const int ch = pi < 128 ? g * 256 + 2 * pi : (pi < 192 ? 512 + g * 128 + 2 * (pi - 128) : 768 + g * 128 + 2 * (pi - 192)); conv_load(proj, t0, c * 128, l0, ch, raw[it]); }
#pragma unroll
          for (int it = 0; it < 4; ++it) { const int task = tid + (bt * 4 + it) * NT, pi = task & 255, l0 = (task >> 8) * 8;
            const int ch = pi < 128 ? g * 256 + 2 * pi : (pi < 192 ? 512 + g * 128 + 2 * (pi - 128) : 768 + g * 128 + 2 * (pi - 192));
            float o0[8], o1[8]; conv_compute(raw[it], a.in[3], a.in[4], ch, o0, o1);
            if (pi < 128) { const int row = 2 * pi; u32x2v q0, q1;
                q0.x = cvtpk(o0[0], o0[1]); q0.y = cvtpk(o0[2], o0[3]); q1.x = cvtpk(o0[4], o0[5]); q1.y = cvtpk(o0[6], o0[7]);
                *(LAS u32x2v*)(XS + row * SO_XST + l0 * 2) = q0; *(LAS u32x2v*)(XS + row * SO_XST + l0 * 2 + 8) = q1;
                q0.x = cvtpk(o1[0], o1[1]); q0.y = cvtpk(o1[2], o1[3]); q1.x = cvtpk(o1[4], o1[5]); q1.y = cvtpk(o1[6], o1[7]);
                *(LAS u32x2v*)(XS + (row + 1) * SO_XST + l0 * 2) = q0; *(LAS u32x2v*)(XS + (row + 1) * SO_XST + l0 * 2 + 8) = q1; }
            else { LAS unsigned char* img = pi < 192 ? BM : CM; const int n = 2 * ((pi - 128) & 63);
#pragma unroll
                for (int j = 0; j < 8; ++j) *(LAS unsigned*)(img + (l0 + j) * SO_NST + n * 2) = cvtpk(o0[j], o1[j]); } } }
        __syncthreads();
        const int h = g * 4 + r; const float dskip = dsk[h];
        f32x16 Y[2][2];
#pragma unroll
        for (int li = 0; li < 2; ++li) {
            const int lb = lsel ? (1 + li) : (li ? 3 : 0);
#pragma unroll
            for (int pb = 0; pb < 2; ++pb)
#pragma unroll
                for (int i = 0; i < 16; ++i) Y[li][pb][i] = 0.f;
#pragma unroll
            for (int ks = 0; ks < 8; ++ks) { const bf16x8 bfr = *(const LAS bf16x8*)(CM + (lb * 32 + qc) * SO_NST + (16 * ks + 8 * hh) * 2);
#pragma unroll
                for (int pb = 0; pb < 2; ++pb) Y[li][pb] = __builtin_amdgcn_mfma_f32_32x32x16_bf16(pf[pb][ks], bfr, Y[li][pb], 0, 0, 0); }
            const float ea = EA[r * 128 + lb * 32 + qc], acl = AC[r * 128 + lb * 32 + qc];
#pragma unroll
            for (int pb = 0; pb < 2; ++pb)
#pragma unroll
                for (int i = 0; i < 16; ++i) Y[li][pb][i] *= ea;
            for (int sb = 0; sb <= lb; ++sb) {
                f32x16 X;
#pragma unroll
                for (int i = 0; i < 16; ++i) X[i] = 0.f;
#pragma unroll
                for (int ks = 0; ks < 8; ++ks) { const bf16x8 af = *(const LAS bf16x8*)(BM + (sb * 32 + qc) * SO_NST + (16 * ks + 8 * hh) * 2);
                    const bf16x8 bfr = *(const LAS bf16x8*)(CM + (lb * 32 + qc) * SO_NST + (16 * ks + 8 * hh) * 2);
                    X = __builtin_amdgcn_mfma_f32_32x32x16_bf16(af, bfr, X, 0, 0, 0); }
                const bool dg = (sb == lb);
#pragma unroll
                for (int q = 0; q < 4; ++q) { const f32x4v as4 = *(const LAS f32x4v*)(AC + r * 128 + sb * 32 + 8 * q + 4 * hh), ds4 = *(const LAS f32x4v*)(DT + r * 128 + sb * 32 + 8 * q + 4 * hh);
#pragma unroll
                    for (int i = 0; i < 4; ++i) { const int sl = 8 * q + 4 * hh + i;
                        const float e = __expf(acl - as4[i]) * ds4[i]; const bool ok = !dg || sl <= qc; float f = ok ? e : 0.f;
                        float xv = X[4 * q + i] * f; if (dg && sl == qc) xv += dskip; X[4 * q + i] = xv; } }
#pragma unroll
                for (int k2 = 0; k2 < 2; ++k2) { union { bf16x8 v; unsigned u[4]; } gb;
#pragma unroll
                    for (int e = 0; e < 4; ++e) gb.u[e] = cvtpk(X[8 * k2 + 2 * e], X[8 * k2 + 2 * e + 1]);
#pragma unroll
                    for (int pb = 0; pb < 2; ++pb) { const LAS unsigned char* xp = XS + (r * 64 + pb * 32 + qc) * SO_XST + (sb * 32 + 16 * k2 + 4 * hh) * 2;
                        union { bf16x8 v; u32x2v h2[2]; } af; af.h2[0] = *(const LAS u32x2v*)xp; af.h2[1] = *(const LAS u32x2v*)(xp + 16);
                        Y[li][pb] = __builtin_amdgcn_mfma_f32_32x32x16_bf16(af.v, gb.v, Y[li][pb], 0, 0, 0); } }
            }
        }
        __syncthreads();
#pragma unroll
        for (int li = 0; li < 2; ++li) { const int lb = lsel ? (1 + li) : (li ? 3 : 0);
#pragma unroll
            for (int pb = 0; pb < 2; ++pb)
#pragma unroll
                for (int q = 0; q < 4; ++q) { f32x4v v4; v4[0] = Y[li][pb][4 * q]; v4[1] = Y[li][pb][4 * q + 1]; v4[2] = Y[li][pb][4 * q + 2]; v4[3] = Y[li][pb][4 * q + 3];
                    *(LAS f32x4v*)(YS + (lb * 32 + qc) * SO_YST + r * 64 + pb * 32 + 8 * q + 4 * hh) = v4; } }
        __syncthreads();
        { v4u zz8[8];
#pragma unroll
          for (int it = 0; it < 8; ++it) { const int task = tid + it * NT, row = task >> 5, ck = task & 31; zz8[it] = *(const v4u*)(proj + (size_t)(t0 + row) * NP + PZ + g * 256 + ck * 8); }
#pragma unroll
          for (int it = 0; it < 8; ++it) { const int task = tid + it * NT, row = task >> 5, ck = task & 31; const v4u zz = zz8[it];
            const f32x4v y0 = *(const LAS f32x4v*)(YS + row * SO_YST + ck * 8), y1 = *(const LAS f32x4v*)(YS + row * SO_YST + ck * 8 + 4);
            float o[8]; o[0] = y0[0] * silu_fast(bflo(zz.x)); o[1] = y0[1] * silu_fast(bfhi(zz.x)); o[2] = y0[2] * silu_fast(bflo(zz.y)); o[3] = y0[3] * silu_fast(bfhi(zz.y));
            o[4] = y1[0] * silu_fast(bflo(zz.z)); o[5] = y1[1] * silu_fast(bfhi(zz.z)); o[6] = y1[2] * silu_fast(bflo(zz.w)); o[7] = y1[3] * silu_fast(bfhi(zz.w));
            float ss = 0.f;
#pragma unroll
            for (int e = 0; e < 8; ++e) ss += o[e] * o[e];
#pragma unroll
            for (int of = 1; of < 32; of <<= 1) ss += __shfl_xor(ss, of);
            if (ck == 0) ssd[(size_t)(t0 + row) * 2 + g] = ss;
            v4u ov; ov.x = cvtpk(o[0], o[1]); ov.y = cvtpk(o[2], o[3]); ov.z = cvtpk(o[4], o[5]); ov.w = cvtpk(o[6], o[7]);
            *(v4u*)(ygb + (size_t)(t0 + row) * 1024 + g * 256 + ck * 8) = ov; } }
    }
}
constexpr int AT_KST = 144, AT_VST = 520, AT_K = 0, AT_V = 256 * AT_KST, AT_B = AT_V + 64 * AT_VST;
__device__ __forceinline__ void ph_attn(const Args& a, LAS unsigned char* lds, int bid, int nb) {
    const bf16* proj = (const bf16*)(a.ws + WS_PROJ); const float* sinks = a.in[9]; const float* relb = a.in[10];
    bf16* ao = (bf16*)(a.ws + WS_CAT) + 512; float* ssat = (float*)(a.ws + WS_SSAT);
    const int tid = threadIdx.x, lane = tid & 63, w = tid >> 6, g = w >> 1, half = w & 1, qc = lane & 31, hh = lane >> 5;
    LAS unsigned char* Kimg = lds + AT_K; LAS unsigned char* VT = lds + AT_V; LAS float* biasT = (LAS float*)(lds + AT_B);
    for (int unit = bid; unit < BATCH * NCH * 2; unit += nb) {
        const int kvh = unit & 1, blk = (unit >> 1) % NCH, b = unit / (2 * NCH); const int t0 = b * SEQ + blk * 128;
        __syncthreads();
        { v4u kv4[4], vv4[4];
#pragma unroll
          for (int it = 0; it < 4; ++it) { const int c = tid + it * NT, row = c >> 3, part = c & 7; kv4[it] = (v4u){0u, 0u, 0u, 0u}; vv4[it] = (v4u){0u, 0u, 0u, 0u};
            if (blk > 0 || row >= 128) { const bf16* src = proj + (size_t)(t0 - 128 + row) * NP + kvh * 64 + part * 8; kv4[it] = *(const v4u*)(src + PK); vv4[it] = *(const v4u*)(src + PV); } }
#pragma unroll
          for (int it = 0; it < 4; ++it) { const int c = tid + it * NT, row = c >> 3, part = c & 7; const v4u kv = kv4[it], vv = vv4[it];
            *(LAS v4u*)(Kimg + row * AT_KST + part * 16) = kv;
            LAS unsigned short* vt = (LAS unsigned short*)(VT + (part * 8) * AT_VST + row * 2);
            vt[0 * (AT_VST / 2)] = (unsigned short)(vv.x & 0xffffu); vt[1 * (AT_VST / 2)] = (unsigned short)(vv.x >> 16);
            vt[2 * (AT_VST / 2)] = (unsigned short)(vv.y & 0xffffu); vt[3 * (AT_VST / 2)] = (unsigned short)(vv.y >> 16);
            vt[4 * (AT_VST / 2)] = (unsigned short)(vv.z & 0xffffu); vt[5 * (AT_VST / 2)] = (unsigned short)(vv.z >> 16);
            vt[6 * (AT_VST / 2)] = (unsigned short)(vv.w & 0xffffu); vt[7 * (AT_VST / 2)] = (unsigned short)(vv.w >> 16); } }
        { const int gg = tid >> 7, dist = tid & 127; biasT[gg * 128 + dist] = relb[c_bucket[dist] * 8 + kvh * 4 + gg]; }
        __syncthreads();
        const int hq = kvh * 4 + g; const float sink = sinks[hq];
#pragma unroll 1
        for (int qb = 0; qb < 2; ++qb) {
            const int q0 = half * 64 + qb * 32; const size_t tq = (size_t)(t0 + q0 + qc);
            bf16x8 qf[4];
            { const bf16* qp = proj + tq * NP + PQ + hq * 64 + 8 * hh;
#pragma unroll
              for (int ks = 0; ks < 4; ++ks) qf[ks] = *(const bf16x8*)(qp + 16 * ks); }
            f32x16 sc[5];
#pragma unroll
            for (int kb = 0; kb < 5; ++kb) {
#pragma unroll
                for (int r = 0; r < 16; ++r) sc[kb][r] = 0.f;
#pragma unroll
                for (int ks = 0; ks < 4; ++ks) { const bf16x8 kf = *(const LAS bf16x8*)(Kimg + (q0 + 32 * kb + qc) * AT_KST + (16 * ks + 8 * hh) * 2);
                    sc[kb] = __builtin_amdgcn_mfma_f32_32x32x16_bf16(kf, qf[ks], sc[kb], 0, 0, 0); } }
            float m = -INFINITY;
#pragma unroll
            for (int kb = 0; kb < 5; ++kb)
#pragma unroll
                for (int r = 0; r < 16; ++r) { const int ki = (r & 3) + 8 * (r >> 2) + 4 * hh, dist = qc + 128 - 32 * kb - ki, j = q0 + 32 * kb + ki;
                    const bool ok = dist >= 0 && dist < 128 && (blk > 0 || j >= 128);
                    const float v = ok ? sc[kb][r] * 0.125f + biasT[g * 128 + (dist & 127)] : -INFINITY; sc[kb][r] = v; m = fmaxf(m, v); }
            m = fmaxf(m, __shfl_xor(m, 32)); m = fmaxf(m, sink);
            float l = 0.f;
#pragma unroll
            for (int kb = 0; kb < 5; ++kb)
#pragma unroll
                for (int r = 0; r < 16; ++r) { const float pv = __expf(sc[kb][r] - m); sc[kb][r] = pv; l += pv; }
            l += __shfl_xor(l, 32); l += __expf(sink - m);
            f32x16 o[2];
#pragma unroll
            for (int db = 0; db < 2; ++db)
#pragma unroll
                for (int r = 0; r < 16; ++r) o[db][r] = 0.f;
#pragma unroll
            for (int kb = 0; kb < 5; ++kb)
#pragma unroll
                for (int k2 = 0; k2 < 2; ++k2) {
                    union { bf16x8 v; unsigned u[4]; } pb;
#pragma unroll
                    for (int e = 0; e < 4; ++e) pb.u[e] = cvtpk(sc[kb][8 * k2 + 2 * e], sc[kb][8 * k2 + 2 * e + 1]);
#pragma unroll
                    for (int db = 0; db < 2; ++db) { const LAS unsigned char* vp = VT + (db * 32 + qc) * AT_VST + (q0 + 32 * kb + 16 * k2 + 4 * hh) * 2;
                        union { bf16x8 v; u32x2v h2[2]; } va; va.h2[0] = *(const LAS u32x2v*)vp; va.h2[1] = *(const LAS u32x2v*)(vp + 16);
                        o[db] = __builtin_amdgcn_mfma_f32_32x32x16_bf16(va.v, pb.v, o[db], 0, 0, 0); } }
            const float inv = 1.f / l; float ss = 0.f;
#pragma unroll
            for (int db = 0; db < 2; ++db)
#pragma unroll
                for (int r = 0; r < 16; ++r) { o[db][r] *= inv; ss += o[db][r] * o[db][r]; }
            ss += __shfl_xor(ss, 32);
            if (hh == 0) ssat[tq * 8 + hq] = ss;
#pragma unroll
            for (int db = 0; db < 2; ++db)
#pragma unroll
                for (int q4 = 0; q4 < 4; ++q4) { uint2 pk; pk.x = cvtpk(o[db][4 * q4], o[db][4 * q4 + 1]); pk.y = cvtpk(o[db][4 * q4 + 2], o[db][4 * q4 + 3]);
                    *(uint2*)(ao + tq * 1024 + hq * 64 + db * 32 + 8 * q4 + 4 * hh) = pk; }
        }
    }
}
constexpr int RT_UST = 1025;
constexpr int RT_P = 0, RT_L = 32768;
constexpr int RT_HIST = TAB_OFF, RT_BASE = TAB_OFF + 128, RT_SE = TAB_OFF + 256, RT_SG = RT_SE + 512, RT_SS = RT_SG + 512;
static_assert(32 * RT_UST * 4 <= SCR_BYTES, "router LDS map");
__device__ __forceinline__ void ph_router(const Args& a, LAS unsigned char* lds, int bid, int nb) {
    const float* hh_ = a.in[0]; const bf16* dl_ = (const bf16*)(a.ws + WS_H); const float* g = a.in[13]; const float* wr = a.in[14]; const float* br = a.in[15];
    unsigned char* u2 = a.ws + WS_U2; int* toke = (int*)(a.ws + WS_TOKE); int* toks = (int*)(a.ws + WS_TOKS);
    int* ltok = (int*)(a.ws + WS_LTOK); float* lgate = (float*)(a.ws + WS_LGATE); unsigned* cnt = (unsigned*)(a.ws + WS_CTL);
    const int tid = threadIdx.x, lane = tid & 63, w = tid >> 6, qc = lane & 31, hh = lane >> 5;
    LAS float* U = (LAS float*)lds; LAS float* P = (LAS float*)(lds + RT_P); LAS float* L = (LAS float*)(lds + RT_L);
    LAS unsigned* hist = (LAS unsigned*)(lds + RT_HIST); LAS unsigned* basev = (LAS unsigned*)(lds + RT_BASE);
    LAS int* se = (LAS int*)(lds + RT_SE); LAS float* sg = (LAS float*)(lds + RT_SG); LAS unsigned* ssl = (LAS unsigned*)(lds + RT_SS);
    float breg[64];
#pragma unroll
    for (int kk = 0; kk < 64; ++kk) breg[kk] = wr[(size_t)(128 * w + 2 * kk + hh) * NE + qc];
    float4 gq[4];
#pragma unroll
    for (int j = 0; j < 4; ++j) gq[j] = ((const float4*)g)[lane + 64 * j];
    const float brv = br[tid & 31];
    float4 vv[4][4]; uint2 dd[4][4];
#define RT_LOAD(tile_) do { const int tk_ = (tile_) * 32; _Pragma("unroll") for (int rr = 0; rr < 4; ++rr) { const int row = w * 4 + rr; \
        const float4* xr = (const float4*)(hh_ + (size_t)(tk_ + row) * DM); const uint2* dr = (const uint2*)(dl_ + (size_t)(tk_ + row) * DM); \
        _Pragma("unroll") for (int j = 0; j < 4; ++j) { vv[rr][j] = xr[lane + 64 * j]; dd[rr][j] = dr[lane + 64 * j]; } } } while (0)
    if (bid < T / 32) RT_LOAD(bid);
    for (int tile = bid; tile < T / 32; tile += nb) {
        const int tk0 = tile * 32;
        __syncthreads();
        if (tid < NE) hist[tid] = 0u;
#pragma unroll
        for (int rr = 0; rr < 4; ++rr) { const int row = w * 4 + rr; float4 (&v)[4] = vv[rr]; float s = 0.f;
#pragma unroll
            for (int j = 0; j < 4; ++j) { const uint2 dw = dd[rr][j]; v[j].x += bflo(dw.x); v[j].y += bfhi(dw.x); v[j].z += bflo(dw.y); v[j].w += bfhi(dw.y);
                s += v[j].x * v[j].x + v[j].y * v[j].y + v[j].z * v[j].z + v[j].w * v[j].w; }
            const float rs = rsqrtf(wave_sum(s) * (1.f / DM) + EPS);
#pragma unroll
            for (int j = 0; j < 4; ++j) { const float4 gg = gq[j];
                const float un[4] = {v[j].x * rs * gg.x, v[j].y * rs * gg.y, v[j].z * rs * gg.z, v[j].w * rs * gg.w};
                *(unsigned*)(u2 + (size_t)(tk0 + row) * DM + 4 * lane + 256 * j) = pk4_fp8(un[0], un[1], un[2], un[3]);
                LAS float* ur = U + row * RT_UST + 4 * lane + 256 * j; ur[0] = un[0]; ur[1] = un[1]; ur[2] = un[2]; ur[3] = un[3]; } }
        if (tile + nb < T / 32) RT_LOAD(tile + nb);
        __syncthreads();
        f32x16 acc;
#pragma unroll
        for (int i = 0; i < 16; ++i) acc[i] = 0.f;
#pragma unroll
        for (int kk = 0; kk < 64; ++kk) acc = __builtin_amdgcn_mfma_f32_32x32x2f32(U[qc * RT_UST + 128 * w + 2 * kk + hh], breg[kk], acc, 0, 0, 0);
        __syncthreads();
#pragma unroll
        for (int i = 0; i < 16; ++i) P[(w * 32 + (i & 3) + 8 * (i >> 2) + 4 * hh) * 32 + qc] = acc[i];
        __syncthreads();
#pragma unroll
        for (int o2 = 0; o2 < 2; ++o2) { const int o = tid + 512 * o2; float sacc = brv;
#pragma unroll
            for (int ww = 0; ww < 8; ++ww) sacc += P[ww * 1024 + o];
            L[o] = sacc; }
        __syncthreads();
#pragma unroll 1
        for (int it = 0; it < 2; ++it) { const int tok = w * 4 + it * 2 + hh;
            float cur = L[tok * 32 + qc]; int idx[4]; float val[4];
#pragma unroll
            for (int k = 0; k < 4; ++k) { float m = cur;
#pragma unroll
                for (int of = 1; of < 32; of <<= 1) m = fmaxf(m, __shfl_xor(m, of));
                const unsigned long long bal = __ballot(cur == m); const unsigned hb = hh ? (unsigned)(bal >> 32) : (unsigned)bal; const int wi = __ffs((int)hb) - 1;
                idx[k] = wi; val[k] = m; if (qc == wi) cur = -INFINITY; }
            if (qc < 4) { const float e1 = __expf(val[1] - val[0]), e2 = __expf(val[2] - val[0]), e3 = __expf(val[3] - val[0]); const float inv = 1.f / (1.f + e1 + e2 + e3);
                const float gsel = qc == 0 ? inv : (qc == 1 ? e1 * inv : (qc == 2 ? e2 * inv : e3 * inv)); const int esel = qc == 0 ? idx[0] : (qc == 1 ? idx[1] : (qc == 2 ? idx[2] : idx[3]));
                se[tok * 4 + qc] = esel; sg[tok * 4 + qc] = gsel; ssl[tok * 4 + qc] = atomicAdd((unsigned*)&hist[esel], 1u); } }
        __syncthreads();
        if (tid < NE) basev[tid] = atomicAdd(&cnt[tid], hist[tid]);
        __syncthreads();
        if (tid < 128) { const int tok = tid >> 2, e = se[tid]; const unsigned sl = basev[e] + ssl[tid]; const int tg = tk0 + tok;
            toke[tg * 4 + (tid & 3)] = e; toks[tg * 4 + (tid & 3)] = (int)sl; ltok[(size_t)e * T + sl] = tg; lgate[(size_t)e * T + sl] = sg[tid]; }
    }
}
#undef RT_LOAD
__device__ __forceinline__ void moe_setup(const Args& a, LAS unsigned char* lds, int nct, int G, int c, bool gather, unsigned pitch, bool plain) {
    LAS int* s_cnt = (LAS int*)(lds + TB_CNT); LAS int* s_ptile = (LAS int*)(lds + TB_PTILE); LAS int* s_re = (LAS int*)(lds + TB_RE); LAS int* s_tstart = (LAS int*)(lds + TB_TSTART);
    LAS int* s_misc = (LAS int*)(lds + TB_MISC); LAS int* s_units = (LAS int*)(lds + TB_UNITS); LAS unsigned* rowtab = (LAS unsigned*)(lds + TB_ROWTAB);
    const unsigned* cnt = (const unsigned*)(a.ws + WS_CTL); const int* ltok = (const int*)(a.ws + WS_LTOK);
    const int tid = threadIdx.x;
    __syncthreads();
    if (tid < NE) s_cnt[tid] = (int)cnt[tid];
    __syncthreads();
    if (tid == 0) { int pt = 0, ts = 0;
        for (int e = 0; e < NE; ++e) { const int cn = s_cnt[e], re = (cn + 255) >> 8; s_ptile[e] = pt; s_re[e] = re; s_tstart[e] = ts; pt += re; ts += re * nct; }
        s_ptile[NE] = pt; s_tstart[NE] = ts; s_misc[0] = ts; s_misc[1] = (ts + G - 1) / G; }
    __syncthreads();
    if (tid < 16) { const int nwg = s_misc[0]; const long L = (long)tid * G + c; int pm = -1, pn = 0;
        if (L < nwg) { int wgid = (int)L; { const int q = nwg / 8, r = nwg % 8, xcd = wgid % 8, off = wgid / 8; wgid = (xcd < r ? xcd * (q + 1) : r * (q + 1) + (xcd - r) * q) + off; }
            int e = 0; while (wgid >= s_tstart[e + 1]) ++e;
            const int local = wgid - s_tstart[e], re = s_re[e]; pm = s_ptile[e] + local % re; pn = e * nct + local / re; }
        s_units[2 * tid] = pm; s_units[2 * tid + 1] = pn; }
    __syncthreads();
    if (gather) { const int nr = s_misc[1] < 9 ? s_misc[1] : 9;
        LAS float* btab = (LAS float*)(lds + 131072); LAS float* gtab = btab + 5 * 256;
        float bv_[5], gv_[5]; unsigned rv_[5];
#pragma unroll
        for (int q = 0; q < 5; ++q) { const int idx = tid + q * NT, i = idx >> 8, r = idx & 255; bv_[q] = 0.f; gv_[q] = 0.f; rv_[q] = 0u;
            if (i < nr) { const int pm = s_units[2 * i]; if (pm >= 0) { const int e = s_units[2 * i + 1] / nct, ct = s_units[2 * i + 1] % nct, sl = (pm - s_ptile[e]) * 256 + r; const bool ok = sl < s_cnt[e];
                if (plain) { bv_[q] = a.in[19][(size_t)e * 1024 + ct * 256 + r]; gv_[q] = ok ? ((const float*)(a.ws + WS_LGATE))[(size_t)e * T + sl] : 0.f; rv_[q] = (unsigned)(pm * 256 + r) * pitch; }
                else { bv_[q] = a.in[17][(size_t)e * 2048 + (r < 128 ? 0 : 1024 - 128) + ct * 128 + r]; rv_[q] = ok ? (unsigned)ltok[(size_t)e * T + sl] * pitch : 0u; } } } }
#pragma unroll
        for (int q = 0; q < 5; ++q) { const int idx = tid + q * NT, i = idx >> 8; if (i < nr) { btab[idx] = bv_[q]; rowtab[idx] = rv_[q]; if (plain) gtab[idx] = gv_[q]; } } }
    __syncthreads();
}
typedef float float2v __attribute__((ext_vector_type(2)));
__device__ __forceinline__ void ph_final(const Args& a, LAS unsigned char* lds, int bid, int nb) {
    const float* hh = a.in[0]; const bf16* dl = (const bf16*)(a.ws + WS_H); const unsigned char* ys = a.ws + WS_YS; const int* toke = (const int*)(a.ws + WS_TOKE); const int* toks = (const int*)(a.ws + WS_TOKS);
    const unsigned* cnt = (const unsigned*)(a.ws + WS_CTL); const float* g = a.in[20]; float* out = a.out;
    LAS int* s_ps = (LAS int*)(lds + TB_PTILE);
    __syncthreads();
    LAS int* s_c = (LAS int*)(lds + TB_CNT); if (threadIdx.x < NE) s_c[threadIdx.x] = (int)cnt[threadIdx.x];
    __syncthreads();
    if (threadIdx.x == 0) { int pt = 0; for (int e = 0; e < NE; ++e) { s_ps[e] = pt; pt += (s_c[e] + 255) >> 8; } }
    __syncthreads();
    const int lane = threadIdx.x & 63, gw = bid * 8 + (threadIdx.x >> 6), ngw = nb * 8;
    size_t myoff = 0; { const int j = lane >> 2, k = lane & 3, r = gw + j * ngw; if (lane < 32 && r < T) myoff = ((size_t)s_ps[toke[r * 4 + k]] * 256 + toks[r * 4 + k]) * 1024; }
    for (int j = 0; gw + j * ngw < T; ++j) { const int r = gw + j * ngw;
        float4 v[4]; int wq[4][4];
        if (j < 8) {
#pragma unroll
            for (int k = 0; k < 4; ++k) { const size_t off = __shfl(myoff, (j & 7) * 4 + k);
#pragma unroll
                for (int jj = 0; jj < 4; ++jj) wq[k][jj] = *(const int*)(ys + off + 4 * lane + 256 * jj); } }
        else {
#pragma unroll
            for (int k = 0; k < 4; ++k) { const size_t off = ((size_t)s_ps[toke[r * 4 + k]] * 256 + toks[r * 4 + k]) * 1024;
#pragma unroll
                for (int jj = 0; jj < 4; ++jj) wq[k][jj] = *(const int*)(ys + off + 4 * lane + 256 * jj); } }
#pragma unroll
        for (int jj = 0; jj < 4; ++jj) { v[jj] = *(const float4*)(hh + (size_t)r * DM + 4 * lane + 256 * jj); const uint2 dw = *(const uint2*)(dl + (size_t)r * DM + 4 * lane + 256 * jj);
            v[jj].x += bflo(dw.x); v[jj].y += bfhi(dw.x); v[jj].z += bflo(dw.y); v[jj].w += bfhi(dw.y); }
#pragma unroll
        for (int k = 0; k < 4; ++k)
#pragma unroll
            for (int jj = 0; jj < 4; ++jj) { const int w = wq[k][jj];
                const float2v lo = __builtin_amdgcn_cvt_pk_f32_fp8(w, false), hi = __builtin_amdgcn_cvt_pk_f32_fp8(w, true);
                v[jj].x += lo[0] * (1.f / YS8_SCALE); v[jj].y += lo[1] * (1.f / YS8_SCALE); v[jj].z += hi[0] * (1.f / YS8_SCALE); v[jj].w += hi[1] * (1.f / YS8_SCALE); }
        float s = 0.f;
#pragma unroll
        for (int jj = 0; jj < 4; ++jj) s += v[jj].x * v[jj].x + v[jj].y * v[jj].y + v[jj].z * v[jj].z + v[jj].w * v[jj].w;
        const float rs = rsqrtf(wave_sum(s) * (1.f / DM) + EPS);
#pragma unroll
        for (int jj = 0; jj < 4; ++jj) { const float4 gg = *(const float4*)(g + 4 * lane + 256 * jj);
            *(float4*)(out + (size_t)r * DM + 4 * lane + 256 * jj) = make_float4(v[jj].x * rs * gg.x, v[jj].y * rs * gg.y, v[jj].z * rs * gg.z, v[jj].w * rs * gg.w); }
    }
}

__global__ void __launch_bounds__(NT, 2) mk_fwd(Args args) {
    extern __shared__ __attribute__((aligned(16))) unsigned char smem[];
    LAS unsigned char* lds = (LAS unsigned char*)smem;
    const int tid = threadIdx.x, bid = blockIdx.x, G = gridDim.x;
    unsigned char* ws = args.ws;
    const int lo = args.ph_lo, hi = args.ph_hi;
#define IN(k) (lo <= (k) && (k) < hi)
#define BOTH(k) (IN(k) && IN((k) + 1))
    XcdBarrier bar; bar.bar = (unsigned*)(ws + WS_CTL) + CW_BAR + args.bar_sel * XCD_BAR_WORDS; bar.x = 0; bar.st = nullptr;
    if (MK_ONE_LAUNCH) {
        if (tid < 4) ((volatile LAS unsigned*)(lds + XBW_OFF))[tid] = 0u;
        __syncthreads();
        bar = xcd_barrier_post((unsigned*)(ws + WS_CTL) + CW_BAR + args.bar_sel * XCD_BAR_WORDS, (volatile LAS unsigned*)(lds + XBW_OFF));
    }
#define GRID_BAR() do { if (MK_ONE_LAUNCH) xcd_barrier(bar); } while (0)

    if (IN(0)) { ph_prologue(args, lds, bid, G); if (BOTH(0)) GRID_BAR(); }
    if (IN(1)) {
        const int gp = G > 192 ? 192 : G;
        if (bid < gp) {
            pg8::Gemm g{(const bf16*)(ws + WS_U), (const bf16*)(ws + WS_WIN), T, NP, DM}; pg8::StaticOrder S; S.init(T, NP, gp, bid);
            pg8::EpiStoreBf16 E{(bf16*)(ws + WS_PROJ), NP};
            pg8::gemm_phase<pg8::EpiStoreBf16, pg8::StaticOrder, true, true, false>(lds, g, S, E); }
        __syncthreads();
        moe_weight_queue(args, lds, bid);
        if (BOTH(1)) GRID_BAR();
    }
    if (IN(3)) { ph_ssd_local(args, lds, bid, G); if (BOTH(3)) GRID_BAR(); }
    if (IN(4)) { ph_scan(args, bid, G); if (BOTH(4)) GRID_BAR(); }
    if (IN(5)) { ph_ssd_out(args, lds, bid, G); ph_attn(args, lds, bid, G); if (BOTH(5)) GRID_BAR(); }
    if (IN(7)) {
        __syncthreads();
        pg8::Gemm g{(const bf16*)(ws + WS_CAT), (const bf16*)(ws + WS_WOUT), T, DM, DM}; pg8::StaticOrder S; S.init(T, DM, G, bid);
        LAS float* r1 = (LAS float*)(lds + TAB_OFF); LAS float* r2 = r1 + 256;
        { pg8::Unit u0; if (S.next(0, u0) && tid < 256) { const size_t row = (size_t)u0.pm * 256 + tid; const float* sd = (const float*)(ws + WS_SSSD) + row * 2; const float* sa = (const float*)(ws + WS_SSAT) + row * 8;
            const float s1 = sd[0] + sd[1], s2 = ((sa[0] + sa[1]) + (sa[2] + sa[3])) + ((sa[4] + sa[5]) + (sa[6] + sa[7]));
            r1[tid] = rsqrtf(s1 * (1.f / 512) + EPS); r2[tid] = rsqrtf(s2 * (1.f / 512) + EPS); } }
        __syncthreads();
        pg8::EpiResScale E{(bf16*)(ws + WS_H), DM, r1, r2};
        pg8::gemm_phase<pg8::EpiResScale, pg8::StaticOrder, false, true, false>(lds, g, S, E);
        if (BOTH(7)) GRID_BAR();
    }
    if (IN(8)) { ph_router(args, lds, bid, G); if (BOTH(8)) GRID_BAR(); }
    if (IN(9)) {
        moe_setup(args, lds, 8, G, bid, true, 1024u, false);
        pg8::Gemm g{(const bf16*)(ws + WS_U2), (const bf16*)(ws + WS_W1), MAXROWS, NE * 2048, DM / 2};
        pg8::MoeOrder S{(const LAS int*)(lds + TB_UNITS), (const LAS unsigned*)(lds + TB_ROWTAB), __builtin_amdgcn_readfirstlane(*(const LAS int*)(lds + TB_MISC + 4))};
        pg8::EpiSwiglu E{ws + WS_ACT, (const LAS float*)(lds + 131072), 1.f / W8_SCALE, ACT8_SCALE};
        pg8::gemm_phase<pg8::EpiSwiglu, pg8::MoeOrder, true, true, true, true>(lds, g, S, E);
        if (BOTH(9)) GRID_BAR();
    }
    if (IN(10)) {
        moe_setup(args, lds, 4, G, bid, true, 1024u, true);
        pg8::Gemm g{(const bf16*)(ws + WS_ACT), (const bf16*)(ws + WS_W2), MAXROWS, NE * 1024, DM / 2};
        pg8::MoeOrder S{(const LAS int*)(lds + TB_UNITS), (const LAS unsigned*)(lds + TB_ROWTAB), __builtin_amdgcn_readfirstlane(*(const LAS int*)(lds + TB_MISC + 4))};
        pg8::EpiMoe2 E{ws + WS_YS, (const LAS float*)(lds + 131072), (const LAS float*)(lds + 131072) + 5 * 256, 1.f / (W8_SCALE * ACT8_SCALE), YS8_SCALE};
        pg8::gemm_phase<pg8::EpiMoe2, pg8::MoeOrder, true, true, true, true>(lds, g, S, E);
        if (BOTH(10)) GRID_BAR();
    }
    if (IN(11)) { ph_final(args, lds, bid, G); }
#undef IN
#undef BOTH
}

extern "C" void kernel_launch(void* const* d_in, const int* in_sizes, int n_in, void* d_out, int out_size, void* d_ws, size_t ws_size, hipStream_t stream) {
    static int grid = 0;
    if (grid == 0) {
        if (n_in != 21 || out_size != T * DM || ws_size < WS_END) { fprintf(stderr, "kernel_launch: unexpected shapes (n_in %d out %d ws %zu)\n", n_in, out_size, ws_size); grid = -1; return; }
        int dev = 0, cus = 0, per_cu = 0;
        if (hipGetDevice(&dev) != hipSuccess || hipDeviceGetAttribute(&cus, hipDeviceAttributeMultiprocessorCount, dev) != hipSuccess) { grid = -1; return; }
        if (hipFuncSetAttribute((const void*)mk_fwd, hipFuncAttributeMaxDynamicSharedMemorySize, LDS_BYTES) != hipSuccess) { fprintf(stderr, "kernel_launch: hipFuncSetAttribute failed\n"); grid = -1; return; }
        if (hipOccupancyMaxActiveBlocksPerMultiprocessor(&per_cu, (const void*)mk_fwd, NT, LDS_BYTES) != hipSuccess || per_cu < 1) { fprintf(stderr, "kernel_launch: occupancy query says %d blocks per CU\n", per_cu); }
        (void)hipGetLastError();
        grid = cus;
    }
    if (grid < 0) return;
    if (hipMemsetAsync((char*)d_ws + WS_CTL, 0, 65536, stream) != hipSuccess) return;
    Args a{};
    for (int i = 0; i < 21; ++i) a.in[i] = (const float*)d_in[i];
    a.out = (float*)d_out; a.ws = (unsigned char*)d_ws;
#if MK_ONE_LAUNCH
    a.ph_lo = 0; a.ph_hi = NPH;
    hipLaunchKernelGGL(mk_fwd, dim3(grid), dim3(NT), LDS_BYTES, stream, a);
#if defined(PROBE_LO)
    a.ph_lo = PROBE_LO; a.ph_hi = PROBE_HI; a.bar_sel = 1;
    hipLaunchKernelGGL(mk_fwd, dim3(grid), dim3(NT), LDS_BYTES, stream, a);
#endif
#if defined(PROBE_LO2)
    a.ph_lo = PROBE_LO2; a.ph_hi = PROBE_HI2; a.bar_sel = 2;
    hipLaunchKernelGGL(mk_fwd, dim3(grid), dim3(NT), LDS_BYTES, stream, a);
#endif
#else
    for (int ph = 0; ph < NPH; ++ph) { a.ph_lo = ph; a.ph_hi = ph + 1; hipLaunchKernelGGL(mk_fwd, dim3(grid), dim3(NT), LDS_BYTES, stream, a); }
#endif
}
```

```cpp
#include <hip/hip_runtime.h>
#include <cstdio>
#include <cstdint>

#ifndef MK_ONE_LAUNCH
#define MK_ONE_LAUNCH 1
#endif

constexpr int BATCH = 8, SEQ = 2048, T = BATCH * SEQ, DM = 1024, DPROJ = 2312;
constexpr int NCH = SEQ / 128;
constexpr int NE = 32, TOPK = 4;
constexpr int O_DT = 1536;
constexpr int NP = 2304;
constexpr int PZ = 0, PXBC = 512, PQ = 1536, PK = 2048, PV = 2176;
constexpr float EPS = 1e-5f;
constexpr int NT = 512;
constexpr int MAXROWS = T * TOPK + NE * 256;
constexpr int NPH = 12;

__constant__ int c_bucket[129] = {0, 1, 2, 3, 4, 5, 6, 7, 8, 9, 10, 11, 12, 13, 14, 15, 16, 16, 16, 17, 17, 18, 18, 18, 19, 19, 19, 20, 20, 20, 20, 21, 21, 21, 21, 22, 22, 22, 22, 22, 23, 23, 23, 23, 23, 23, 24, 24, 24, 24, 24, 24, 25, 25, 25, 25, 25, 25, 25, 26, 26, 26, 26, 26, 26, 26, 26, 27, 27, 27, 27, 27, 27, 27, 27, 27, 27, 28, 28, 28, 28, 28, 28, 28, 28, 28, 28, 29, 29, 29, 29, 29, 29, 29, 29, 29, 29, 29, 29, 30, 30, 30, 30, 30, 30, 30, 30, 30, 30, 30, 30, 30, 30, 31, 31, 31, 31, 31, 31, 31, 31, 31, 31, 31, 31, 31, 31, 31, 31};

constexpr size_t MiB = 1ull << 20;
constexpr size_t WS_CTL = 0, CTL_ZERO_BYTES = 1 * MiB;
constexpr int CW_BAR = 4096;
static_assert((CW_BAR + 3 * 3456) * 4 <= 65536, "control words inside the per-call memset");
constexpr size_t WS_WIN = 1 * MiB;
constexpr size_t WS_WOUT = WS_WIN + (size_t)NP * DM * 2;
constexpr size_t WS_W1 = WS_WOUT + (size_t)DM * DM * 2;
constexpr size_t WS_W2 = WS_W1 + (size_t)NE * 2048 * 1024 * 2;
constexpr size_t WS_U = WS_W2 + (size_t)NE * 1024 * 1024 * 2;
constexpr size_t WS_DTRAW = WS_U + (size_t)T * DM * 2;
constexpr size_t WS_PROJ = WS_DTRAW + (size_t)T * 8 * 4;
constexpr size_t WS_XC = WS_PROJ + (size_t)T * NP * 2;
constexpr size_t WS_DT = WS_XC + (size_t)T * 1024 * 4;
constexpr size_t WS_ACUM = WS_DT + (size_t)T * 8 * 4;
constexpr size_t WS_CDEC = WS_ACUM + (size_t)T * 8 * 4;
constexpr size_t WS_STATES = WS_CDEC + 1 * MiB;
constexpr size_t WS_PREV = WS_STATES + (size_t)BATCH * NCH * 8 * 8192 * 4;
constexpr size_t WS_YG = WS_PREV + (size_t)BATCH * NCH * 8 * 8192 * 4;
constexpr size_t WS_YGB = WS_YG;
constexpr size_t WS_SSSD = WS_YG + (size_t)T * 512 * 2;
constexpr size_t WS_AO = WS_YG + (size_t)T * 512 * 4;
constexpr size_t WS_SSAT = WS_AO + (size_t)T * 512 * 2;
constexpr size_t WS_CAT = WS_SSAT + (size_t)T * 8 * 4;
constexpr size_t WS_H = WS_CAT + (size_t)T * DM * 2;
constexpr size_t WS_U2 = WS_H + (size_t)T * DM * 4;
constexpr size_t WS_TOKE = WS_U2 + (size_t)T * DM * 2;
constexpr size_t WS_TOKS = WS_TOKE + (size_t)T * 4 * 4;
constexpr size_t WS_LTOK = WS_TOKS + (size_t)T * 4 * 4;
constexpr size_t WS_LGATE = WS_LTOK + (size_t)NE * T * 4;
constexpr size_t WS_ACT = WS_LGATE + (size_t)NE * T * 4;
constexpr size_t WS_YS = WS_ACT + (size_t)MAXROWS * 1024 * 2;
constexpr size_t WS_END = WS_YS + (size_t)MAXROWS * 1024 * 2;
static_assert(WS_END <= 1024 * MiB, "workspace");

constexpr int SCR_BYTES = 143360;
constexpr int TAB_OFF = SCR_BYTES;
constexpr int TB_CNT = TAB_OFF, TB_PTILE = TAB_OFF + 128, TB_RE = TAB_OFF + 272, TB_TSTART = TAB_OFF + 400, TB_MISC = TAB_OFF + 544, TB_UNITS = TAB_OFF + 576, TB_ROWTAB = TAB_OFF + 1024;
constexpr int XBW_OFF = TB_ROWTAB + 9 * 256 * 4;
constexpr int LDS_BYTES = 163840;
static_assert(XBW_OFF + 16 <= LDS_BYTES && XBW_OFF % 16 == 0, "LDS map");

#define GAS __attribute__((address_space(1)))
#define LAS __attribute__((address_space(3)))
typedef unsigned short bf16;
typedef unsigned v4u __attribute__((ext_vector_type(4)));
#define LDS_WAIT() asm volatile("s_waitcnt lgkmcnt(0)" ::: "memory")
#define VM_WAIT() asm volatile("s_waitcnt vmcnt(0)" ::: "memory")
__device__ __forceinline__ unsigned f2bf(float f) { unsigned u = __builtin_bit_cast(unsigned, f); return (u + 0x7fffu + ((u >> 16) & 1u)) >> 16; }
__device__ __forceinline__ unsigned pk2(float lo, float hi) { return f2bf(lo) | (f2bf(hi) << 16); }
__device__ __forceinline__ float bf2f(unsigned short b) { return __uint_as_float((unsigned)b << 16); }
__device__ __forceinline__ float bflo(unsigned w) { return __uint_as_float(w << 16); }
__device__ __forceinline__ float bfhi(unsigned w) { return __uint_as_float(w & 0xffff0000u); }

namespace pg8 {
#define PG8_LAS __attribute__((address_space(3)))
typedef unsigned short bf16_t;
typedef short bf16x8 __attribute__((ext_vector_type(8)));
typedef float f32x4 __attribute__((ext_vector_type(4)));
typedef unsigned u32x4 __attribute__((ext_vector_type(4)));
typedef unsigned u32x2 __attribute__((ext_vector_type(2)));
typedef int i32x8 __attribute__((ext_vector_type(8)));
typedef int i32x4 __attribute__((ext_vector_type(4)));
constexpr int BM = 256, BK = 64, HALF = 128, HTB = HALF * BK * 2  , STAGE_BYTES = 8 * HTB, NXCD = 8, WGM = 8;

__host__ __device__ __forceinline__ int lds_byte(int r, int c) { const int st = (r >> 4) * 2 + (c >> 5), rr = r & 15, cc = c & 31, ob = rr * 64 + cc * 2; return st * 1024 + (ob ^ (((ob >> 9) & 1) << 5)); }
__host__ __device__ __forceinline__ void stage_rc(int b, int& R, int& C) { const int st = b / 1024, sb = b % 1024, swz = sb ^ (((sb >> 9) & 1) << 5); R = (st >> 1) * 16 + swz / 64; C = (st & 1) * 32 + (swz % 64) / 2; }
__host__ __device__ __forceinline__ int perm32(int rho) { const int n = rho >> 4, i = rho & 15; return 8 * (i >> 2) + 4 * n + (i & 3); }

struct Unit { int pm, pn, rid; };
struct Gemm { const bf16_t* A; const bf16_t* Bt; int M, N, K; };

struct StaticOrder {
    int nM, nN, nwg, G, c;
    __host__ __device__ __forceinline__ void init(int M, int N, int G_, int c_) { nM = M / BM; nN = N / BM; nwg = nM * nN; G = G_; c = c_; }
    __host__ __device__ __forceinline__ bool next(int i, Unit& u) const {
        const long L = (long)i * G + c; if (L >= nwg) return false;
        int wgid = (int)L; { const int q = nwg / NXCD, r = nwg % NXCD, xcd = wgid % NXCD, off = wgid / NXCD; wgid = (xcd < r ? xcd * (q + 1) : r * (q + 1) + (xcd - r) * q) + off; }
        const int nig = WGM * nN, gid = wgid / nig, fm = gid * WGM, gsz = (nM - fm) < WGM ? (nM - fm) : WGM;
        u.pm = fm + ((wgid % nig) % gsz); u.pn = (wgid % nig) / gsz; u.rid = 0; return true;
    }
    __device__ __forceinline__ void a_ready(const Unit&) const {}
    __device__ __forceinline__ void done(const Unit&) const {}
};


typedef float f32x2 __attribute__((ext_vector_type(2)));
__device__ __forceinline__ unsigned cvt_pk_bf16(float lo, float hi) { unsigned r; asm volatile("v_cvt_pk_bf16_f32 %0, %1, %2" : "=v"(r) : "v"(lo), "v"(hi)); return r; }

struct EpiStoreBf16 {
    static constexpr bool PERM = true, AFTER_DRAIN = false, HAS_MID = false;
    bf16_t* O; int ldc;
    __device__ __forceinline__ void operator()(const f32x4 (&acc)[2][2][4][2], const Unit& u, int wr, int wc, int fr, int fq) const {
        const int row0 = u.pm * BM + wr * 64 + fr, col0 = u.pn * BM + wc * 32 + 8 * fq;
#pragma unroll
        for (int ai = 0; ai < 2; ++ai)
#pragma unroll
            for (int m = 0; m < 4; ++m) { bf16_t* rowp = O + (size_t)(row0 + ai * HALF + m * 16) * ldc + col0;
#pragma unroll
                for (int bj = 0; bj < 2; ++bj) { const f32x4 v0 = acc[ai][bj][m][0], v1 = acc[ai][bj][m][1];
                    u32x4 w; w.x = cvt_pk_bf16(v0[0], v0[1]); w.y = cvt_pk_bf16(v0[2], v0[3]); w.z = cvt_pk_bf16(v1[0], v1[1]); w.w = cvt_pk_bf16(v1[2], v1[3]);
                    *(u32x4*)(rowp + bj * HALF) = w; } }
    }
};
struct EpiResF32 {
    static constexpr bool PERM = false, AFTER_DRAIN = false, HAS_MID = false;
    const float* __restrict__ base; float* __restrict__ C; int ldc;
    __device__ __forceinline__ void operator()(const f32x4 (&acc)[2][2][4][2], const Unit& u, int wr, int wc, int fr, int fq) const {
        const int row0 = u.pm * BM + wr * 64 + fr, col0 = u.pn * BM + wc * 32 + 4 * fq;
#pragma unroll
        for (int ai = 0; ai < 2; ++ai)
#pragma unroll
            for (int m = 0; m < 4; ++m) { const size_t off = (size_t)(row0 + ai * HALF + m * 16) * ldc + col0; f32x4 bs[2][2];
#pragma unroll
                for (int bj = 0; bj < 2; ++bj)
#pragma unroll
                    for (int n = 0; n < 2; ++n) bs[bj][n] = __builtin_nontemporal_load((const f32x4*)(base + off + bj * HALF + n * 16));
#pragma unroll
                for (int bj = 0; bj < 2; ++bj)
#pragma unroll
                    for (int n = 0; n < 2; ++n) *(f32x4*)(C + off + bj * HALF + n * 16) = bs[bj][n] + acc[ai][bj][m][n]; }
    }
};
struct EpiResScale {
    static constexpr bool PERM = true, AFTER_DRAIN = false, HAS_MID = true;
    bf16_t* D; int ldc; const PG8_LAS float* r1; const PG8_LAS float* r2;
    __device__ __forceinline__ void mid(f32x4 (&acc)[2][2][4][2], const Unit&, int wr, int, int fr, int) const {
#pragma unroll
        for (int ai = 0; ai < 2; ++ai)
#pragma unroll
            for (int m = 0; m < 4; ++m) { const int rl = ai * HALF + wr * 64 + m * 16 + fr; const float f = r1[rl] / r2[rl];
#pragma unroll
                for (int bj = 0; bj < 2; ++bj)
#pragma unroll
                    for (int n = 0; n < 2; ++n) acc[ai][bj][m][n] *= f; }
    }
    __device__ __forceinline__ void operator()(const f32x4 (&acc)[2][2][4][2], const Unit& u, int wr, int wc, int fr, int fq) const {
        const int row0 = u.pm * BM + wr * 64 + fr, col0 = u.pn * BM + wc * 32 + 8 * fq;
#pragma unroll
        for (int ai = 0; ai < 2; ++ai)
#pragma unroll
            for (int m = 0; m < 4; ++m) { bf16_t* rowp = D + (size_t)(row0 + ai * HALF + m * 16) * ldc + col0; const float f = r2[ai * HALF + wr * 64 + m * 16 + fr];
#pragma unroll
                for (int bj = 0; bj < 2; ++bj) { const f32x4 v0 = acc[ai][bj][m][0] * f, v1 = acc[ai][bj][m][1] * f;
                    u32x4 w; w.x = cvt_pk_bf16(v0[0], v0[1]); w.y = cvt_pk_bf16(v0[2], v0[3]); w.z = cvt_pk_bf16(v1[0], v1[1]); w.w = cvt_pk_bf16(v1[2], v1[3]);
                    *(u32x4*)(rowp + bj * HALF) = w; } }
    }
};
struct EpiSwiglu {
    static constexpr bool PERM = true, AFTER_DRAIN = false, HAS_MID = false;
    unsigned char* act; const PG8_LAS float* btab; float dq, asc;
    __device__ __forceinline__ void operator()(const f32x4 (&acc)[2][2][4][2], const Unit& u, int wr, int wc, int fr, int fq) const {
        const int e = u.pn >> 3, ct = u.pn & 7, colo = ct * 128 + wc * 32 + 8 * fq;
        const PG8_LAS float* bg = btab + u.rid * 256 + wc * 32 + 8 * fq; (void)e;
        const f32x4 g0 = *(const PG8_LAS f32x4*)bg, g1 = *(const PG8_LAS f32x4*)(bg + 4), l0 = *(const PG8_LAS f32x4*)(bg + 128), l1 = *(const PG8_LAS f32x4*)(bg + 132);
        const int row0 = u.pm * BM + wr * 64 + fr;
#pragma unroll
        for (int ai = 0; ai < 2; ++ai)
#pragma unroll
            for (int m = 0; m < 4; ++m) {
                const f32x4 xg[2] = {acc[ai][0][m][0] * dq + g0, acc[ai][0][m][1] * dq + g1}; const f32x4 xl[2] = {acc[ai][1][m][0] * dq + l0, acc[ai][1][m][1] * dq + l1};
                float o[8];
#pragma unroll
                for (int q = 0; q < 4; ++q) {
                    f32x2 a2 = {xg[q >> 1][2 * (q & 1)], xg[q >> 1][2 * (q & 1) + 1]}, b2 = {xl[q >> 1][2 * (q & 1)], xl[q >> 1][2 * (q & 1) + 1]};
                    a2 = __builtin_elementwise_min(a2, (f32x2){7.f, 7.f}); b2 = __builtin_elementwise_min(__builtin_elementwise_max(b2, (f32x2){-7.f, -7.f}), (f32x2){7.f, 7.f});
                    const f32x2 t2 = a2 * (-1.702f * 1.4426950408889634f); f32x2 e2; e2.x = __builtin_amdgcn_exp2f(t2.x); e2.y = __builtin_amdgcn_exp2f(t2.y);
                    const f32x2 d2 = e2 + 1.f; f32x2 r2; r2.x = __builtin_amdgcn_rcpf(d2.x); r2.y = __builtin_amdgcn_rcpf(d2.y);
                    const f32x2 o2 = (a2 * r2) * (b2 * asc + asc); o[2 * q] = o2.x; o[2 * q + 1] = o2.y; }
                int w0 = 0, w1 = 0; w0 = __builtin_amdgcn_cvt_pk_fp8_f32(o[0], o[1], w0, false); w0 = __builtin_amdgcn_cvt_pk_fp8_f32(o[2], o[3], w0, true);
                w1 = __builtin_amdgcn_cvt_pk_fp8_f32(o[4], o[5], w1, false); w1 = __builtin_amdgcn_cvt_pk_fp8_f32(o[6], o[7], w1, true);
                u32x2 w; w.x = (unsigned)w0; w.y = (unsigned)w1;
                *(u32x2*)(act + (size_t)(row0 + ai * HALF + m * 16) * 1024 + colo) = w; }
    }
};
struct EpiMoe2 {
    static constexpr bool PERM = true, AFTER_DRAIN = false, HAS_MID = false;
    unsigned char* ys; const PG8_LAS float* btab; const PG8_LAS float* gtab; float dq, ysc;
    __device__ __forceinline__ void operator()(const f32x4 (&acc)[2][2][4][2], const Unit& u, int wr, int wc, int fr, int fq) const {
        const int e = u.pn >> 2, ct = u.pn & 3, colb = ct * 256 + wc * 32 + 8 * fq;
        (void)e;
        f32x4 bv[2][2];
#pragma unroll
        for (int bj = 0; bj < 2; ++bj)
#pragma unroll
            for (int n = 0; n < 2; ++n) bv[bj][n] = *(const PG8_LAS f32x4*)(btab + u.rid * 256 + bj * HALF + wc * 32 + 8 * fq + 4 * n);
        const int row0 = u.pm * BM + wr * 64 + fr;
#pragma unroll
        for (int ai = 0; ai < 2; ++ai)
#pragma unroll
            for (int m = 0; m < 4; ++m) { const float gt = gtab[u.rid * 256 + ai * HALF + wr * 64 + m * 16 + fr] * ysc;
                unsigned char* rowp = ys + (size_t)(row0 + ai * HALF + m * 16) * 1024 + colb;
#pragma unroll
                for (int bj = 0; bj < 2; ++bj) { f32x4 v0 = (acc[ai][bj][m][0] * dq + bv[bj][0]) * gt, v1 = (acc[ai][bj][m][1] * dq + bv[bj][1]) * gt;
                    v0 = __builtin_elementwise_min(__builtin_elementwise_max(v0, (f32x4){-440.f, -440.f, -440.f, -440.f}), (f32x4){440.f, 440.f, 440.f, 440.f});
                    v1 = __builtin_elementwise_min(__builtin_elementwise_max(v1, (f32x4){-440.f, -440.f, -440.f, -440.f}), (f32x4){440.f, 440.f, 440.f, 440.f});
                    int w0 = 0, w1 = 0; w0 = __builtin_amdgcn_cvt_pk_fp8_f32(v0[0], v0[1], w0, false); w0 = __builtin_amdgcn_cvt_pk_fp8_f32(v0[2], v0[3], w0, true);
                    w1 = __builtin_amdgcn_cvt_pk_fp8_f32(v1[0], v1[1], w1, false); w1 = __builtin_amdgcn_cvt_pk_fp8_f32(v1[2], v1[3], w1, true);
                    u32x2 w; w.x = (unsigned)w0; w.y = (unsigned)w1; *(u32x2*)(rowp + bj * HALF) = w; } }
    }
};
struct MoeOrder {
    const PG8_LAS int* units; const PG8_LAS unsigned* rowtab; int nr;
    __device__ __forceinline__ bool next(int i, Unit& u) const {
        if (i >= nr) return false;
        const int pm = __builtin_amdgcn_readfirstlane(units[2 * i]); if (pm < 0) return false;
        u.pm = pm; u.pn = __builtin_amdgcn_readfirstlane(units[2 * i + 1]); u.rid = i; return true;
    }
    __device__ __forceinline__ unsigned arow(const Unit& u, int r) const { return rowtab[u.rid * 256 + r]; }
    __device__ __forceinline__ void a_ready(const Unit&) const {}
    __device__ __forceinline__ void done(const Unit&) const {}
};

template <class Epi, class Sched, bool ALIGN_EPI = false, bool SP2 = false, bool GATHER = false, bool FP8 = false>
__device__ __forceinline__ void gemm_phase(PG8_LAS unsigned char* lds, const Gemm g, const Sched& S, const Epi& E) {
    const int tid = threadIdx.x, wid = __builtin_amdgcn_readfirstlane(tid >> 6), lane = tid & 63, wr = wid >> 2, wc = wid & 3, fr = lane & 15, fq = lane >> 4;
    const int K = g.K, nt = K / BK;
    unsigned voffA[2], voffB[2];
#pragma unroll
    for (int i = 0; i < 2; ++i) { int R, C; stage_rc(tid * 16 + i * 8192, R, C); const int Rb = Epi::PERM ? ((R & ~31) + perm32(R & 31)) : R;
        voffA[i] = (unsigned)(R * K + C) * 2u; voffB[i] = (unsigned)(Rb * K + C) * 2u; }
    const size_t kstep = (size_t)(BK * 2);
    const size_t hstep = (size_t)HALF * K * 2;
    const size_t tstep = 2 * hstep;
    const unsigned ldsw = (unsigned)wid * 1024u;
    const int aoff = lds_byte(wr * 64 + fr, fq * 8), boff = lds_byte(wc * 32 + fr, fq * 8);
#define PG8_SA(b, h) (((b) * 2 + (h)) * HTB)
#define PG8_SB(b, h) ((4 + (b) * 2 + (h)) * HTB)
#define PG8_STAGE(bufoff, gbase, voff) do { _Pragma("unroll") for (int _i = 0; _i < 2; ++_i) \
        __builtin_amdgcn_global_load_lds((const unsigned*)((const char*)(gbase) + (voff)[_i]), (PG8_LAS unsigned*)(lds + (bufoff) + ldsw + _i * 8192), 16, 0, 0); } while (0)
#define PG8_STAGE_A(b, h, U, koff) do { if constexpr (GATHER) { PG8_STAGE(PG8_SA(b, h), Ab + (koff), c_ao[h]); } else { PG8_STAGE(PG8_SA(b, h), U##_A + (size_t)(h) * hstep + (koff), voffA); } } while (0)
#define PG8_LDA(dst, b, h) do { _Pragma("unroll") for (int m = 0; m < 4; ++m) _Pragma("unroll") for (int k = 0; k < 2; ++k) dst[m][k] = *(const PG8_LAS bf16x8*)(lds + PG8_SA(b, h) + aoff + m * 2048 + k * 1024); } while (0)
#define PG8_LDB(dst, b, h) do { _Pragma("unroll") for (int n = 0; n < 2; ++n) _Pragma("unroll") for (int k = 0; k < 2; ++k) dst[n][k] = *(const PG8_LAS bf16x8*)(lds + PG8_SB(b, h) + boff + n * 2048 + k * 1024); } while (0)
#define PG8_MMA(ai, bj, At, Bt) do { __builtin_amdgcn_s_setprio(1); _Pragma("unroll") for (int m = 0; m < 4; ++m) _Pragma("unroll") for (int n = 0; n < 2; ++n) { \
        if constexpr (FP8) { const i32x8 ub_ = __builtin_shufflevector(__builtin_bit_cast(i32x4, Bt[n][0]), __builtin_bit_cast(i32x4, Bt[n][1]), 0, 1, 2, 3, 4, 5, 6, 7); \
            const i32x8 ua_ = __builtin_shufflevector(__builtin_bit_cast(i32x4, At[m][0]), __builtin_bit_cast(i32x4, At[m][1]), 0, 1, 2, 3, 4, 5, 6, 7); \
            acc[ai][bj][m][n] = __builtin_amdgcn_mfma_scale_f32_16x16x128_f8f6f4(ub_, ua_, acc[ai][bj][m][n], 0, 0, 0, 0x7f7f7f7f, 0, 0x7f7f7f7f); } \
        else { _Pragma("unroll") for (int k = 0; k < 2; ++k) acc[ai][bj][m][n] = __builtin_amdgcn_mfma_f32_16x16x32_bf16(Bt[n][k], At[m][k], acc[ai][bj][m][n], 0, 0, 0); } } \
        __builtin_amdgcn_s_setprio(0); } while (0)
#define PG8_WAIT_V(n) asm volatile("s_waitcnt vmcnt(" #n ")" ::: "memory")
#define PG8_WAIT_L(n) asm volatile("s_waitcnt lgkmcnt(" #n ")" ::: "memory")
#define PG8_BAR __builtin_amdgcn_s_barrier()
#define PG8_SCHED __builtin_amdgcn_sched_barrier(0)
    Unit cur, nxt; int ui = 0;
    if (!S.next(0, cur)) return;
    f32x4 acc[2][2][4][2];
#pragma unroll
    for (int a = 0; a < 2; ++a)
#pragma unroll
        for (int b = 0; b < 2; ++b)
#pragma unroll
            for (int m = 0; m < 4; ++m)
#pragma unroll
                for (int n = 0; n < 2; ++n) acc[a][b][m][n] = (f32x4){0.f, 0.f, 0.f, 0.f};
    bf16x8 At[4][2], B0[2][2], B1[2][2];
    const char* const Ab = (const char*)g.A; (void)Ab;
    unsigned c_ao[2][2] = {{0u, 0u}, {0u, 0u}}; (void)c_ao;
    int RA0, CA0; stage_rc(tid * 16, RA0, CA0);
    const char* c_A = (const char*)g.A + (size_t)cur.pm * tstep; const char* cB = (const char*)g.Bt + (size_t)cur.pn * tstep;
    if constexpr (GATHER) { _Pragma("unroll") for (int h_ = 0; h_ < 2; ++h_) _Pragma("unroll") for (int i_ = 0; i_ < 2; ++i_) c_ao[h_][i_] = S.arow(cur, h_ * HALF + RA0 + i_ * 64) + (unsigned)CA0 * 2u; }
    S.a_ready(cur);
    if constexpr (SP2) {
        PG8_STAGE(PG8_SB(0, 0), cB, voffB); PG8_STAGE(PG8_SB(0, 1), cB + hstep, voffB); PG8_STAGE_A(0, 0, c, (size_t)0); PG8_STAGE_A(0, 1, c, (size_t)0);
        if (wr == 1) PG8_BAR;
        PG8_WAIT_V(2); PG8_BAR;
        PG8_STAGE(PG8_SB(1, 0), cB + kstep, voffB); PG8_STAGE_A(1, 0, c, kstep); PG8_STAGE(PG8_SB(1, 1), cB + hstep + kstep, voffB);
        PG8_WAIT_V(6); PG8_BAR;
    } else {
        PG8_STAGE(PG8_SB(0, 0), cB, voffB); PG8_STAGE_A(0, 0, c, (size_t)0); PG8_STAGE(PG8_SB(0, 1), cB + hstep, voffB); PG8_STAGE_A(0, 1, c, (size_t)0);
        if (wr == 1) PG8_BAR;
        PG8_WAIT_V(4); PG8_BAR;
        PG8_STAGE(PG8_SB(1, 0), cB + kstep, voffB); PG8_STAGE_A(1, 0, c, kstep); PG8_STAGE(PG8_SB(1, 1), cB + hstep + kstep, voffB);
        PG8_WAIT_V(6); PG8_BAR;
    }
    for (;;) {
        const bool has_next = S.next(ui + 1, nxt);
        const char* n_A = has_next ? (const char*)g.A + (size_t)nxt.pm * tstep : c_A; const char* nB = has_next ? (const char*)g.Bt + (size_t)nxt.pn * tstep : cB;
#pragma unroll 1
        for (int t = 0; t < nt; t += 2) {
            const bool last = (t == nt - 2);
            if constexpr (Epi::HAS_MID) { if (t == (nt >> 1)) E.mid(acc, cur, wr, wc, fr, fq); }
            const char* s_A = last ? n_A : c_A; const size_t k2 = last ? (size_t)0 : (size_t)(t + 2) * kstep; const char* b2 = last ? nB : cB + (size_t)(t + 2) * kstep;
            const char* b3 = b2 + kstep; (void)s_A;
            if (last && has_next) S.a_ready(nxt);
            if constexpr (SP2) {
            PG8_LDB(B0, 0, 0); PG8_LDB(B1, 0, 1); PG8_SCHED; PG8_LDA(At, 0, 0); PG8_STAGE_A(1, 1, c, (size_t)(t + 1) * kstep); if constexpr (GATHER) { if (last && has_next) { _Pragma("unroll") for (int h_ = 0; h_ < 2; ++h_) _Pragma("unroll") for (int i_ = 0; i_ < 2; ++i_) c_ao[h_][i_] = S.arow(nxt, h_ * HALF + RA0 + i_ * 64) + (unsigned)CA0 * 2u; } }
            PG8_WAIT_V(8); PG8_WAIT_L(0); PG8_BAR; PG8_MMA(0, 0, At, B0); PG8_MMA(0, 1, At, B1); PG8_BAR; PG8_SCHED;
            PG8_LDA(At, 0, 1); PG8_STAGE(PG8_SB(0, 0), b2, voffB); PG8_STAGE(PG8_SB(0, 1), b2 + hstep, voffB); PG8_STAGE_A(0, 0, s, k2);
            PG8_WAIT_V(8); PG8_WAIT_L(0); PG8_BAR; PG8_MMA(1, 0, At, B0); PG8_MMA(1, 1, At, B1); PG8_BAR; PG8_SCHED;
            PG8_LDB(B0, 1, 0); PG8_LDB(B1, 1, 1); PG8_SCHED; PG8_LDA(At, 1, 0); PG8_STAGE_A(0, 1, s, k2);
            PG8_WAIT_V(8); PG8_WAIT_L(0); PG8_BAR; PG8_MMA(0, 0, At, B0); PG8_MMA(0, 1, At, B1); PG8_BAR; PG8_SCHED;
            PG8_LDA(At, 1, 1); PG8_STAGE(PG8_SB(1, 0), b3, voffB); PG8_STAGE(PG8_SB(1, 1), b3 + hstep, voffB); PG8_STAGE_A(1, 0, s, k2 + kstep);
            PG8_WAIT_V(8); PG8_WAIT_L(0); PG8_BAR; PG8_MMA(1, 0, At, B0); PG8_MMA(1, 1, At, B1); PG8_BAR; PG8_SCHED;
            } else {
            PG8_LDB(B0, 0, 0); PG8_SCHED; PG8_LDA(At, 0, 0); PG8_STAGE_A(1, 1, c, (size_t)(t + 1) * kstep); if constexpr (GATHER) { if (last && has_next) { _Pragma("unroll") for (int h_ = 0; h_ < 2; ++h_) _Pragma("unroll") for (int i_ = 0; i_ < 2; ++i_) c_ao[h_][i_] = S.arow(nxt, h_ * HALF + RA0 + i_ * 64) + (unsigned)CA0 * 2u; } }
            PG8_WAIT_L(8); PG8_BAR; PG8_WAIT_L(0); PG8_MMA(0, 0, At, B0); PG8_BAR; PG8_SCHED;
            PG8_LDB(B1, 0, 1); PG8_STAGE(PG8_SB(0, 0), b2, voffB);
            PG8_BAR; PG8_WAIT_L(0); PG8_MMA(0, 1, At, B1); PG8_BAR;
            PG8_LDA(At, 0, 1); PG8_STAGE_A(0, 0, s, k2);
            PG8_BAR; PG8_WAIT_L(0); PG8_MMA(1, 0, At, B0); PG8_BAR; PG8_SCHED;
            PG8_STAGE(PG8_SB(0, 1), b2 + hstep, voffB);
            PG8_WAIT_V(6); PG8_BAR; PG8_MMA(1, 1, At, B1); PG8_BAR;
            PG8_LDB(B0, 1, 0); PG8_SCHED; PG8_LDA(At, 1, 0); PG8_STAGE_A(0, 1, s, k2);
            PG8_WAIT_L(8); PG8_BAR; PG8_WAIT_L(0); PG8_MMA(0, 0, At, B0); PG8_BAR; PG8_SCHED;
            PG8_LDB(B1, 1, 1); PG8_STAGE(PG8_SB(1, 0), b3, voffB);
            PG8_BAR; PG8_WAIT_L(0); PG8_MMA(0, 1, At, B1); PG8_BAR;
            PG8_LDA(At, 1, 1); PG8_STAGE_A(1, 0, s, k2 + kstep);
            PG8_BAR; PG8_WAIT_L(0); PG8_MMA(1, 0, At, B0); PG8_BAR; PG8_SCHED;
            PG8_STAGE(PG8_SB(1, 1), b3 + hstep, voffB);
            PG8_WAIT_V(6); PG8_BAR; PG8_MMA(1, 1, At, B1); PG8_BAR;
            }
        }
        if constexpr (ALIGN_EPI) { if (wr == 0) PG8_BAR; }
        if constexpr (!Epi::AFTER_DRAIN) { E(acc, cur, wr, wc, fr, fq); S.done(cur); }
        if (!has_next) break;
#pragma unroll
        for (int a = 0; a < 2; ++a)
#pragma unroll
            for (int b = 0; b < 2; ++b)
#pragma unroll
                for (int m = 0; m < 4; ++m)
#pragma unroll
                    for (int n = 0; n < 2; ++n) acc[a][b][m][n] = (f32x4){0.f, 0.f, 0.f, 0.f};
        cur = nxt; c_A = n_A; cB = nB; ++ui;
        if constexpr (ALIGN_EPI) { if (wr == 1) PG8_BAR; }
    }
    PG8_WAIT_V(0);
    if constexpr (!ALIGN_EPI) { if (wr == 0) PG8_BAR; }
    PG8_BAR;
    if constexpr (Epi::AFTER_DRAIN) { E.fused(acc, cur, wr, wc, fr, fq, lds, wid, lane); S.done(cur); }
#undef PG8_SA
#undef PG8_SB
#undef PG8_STAGE
#undef PG8_STAGE_A
#undef PG8_LDA
#undef PG8_LDB
#undef PG8_MMA
#undef PG8_WAIT_V
#undef PG8_WAIT_L
#undef PG8_BAR
#undef PG8_SCHED
}
}

#define XB_TMO      128
#define XB_XCNT(j)  (256  + 64 * (j))
#define XB_XSUB(j)  (1280 + 64 * (j))
#define XB_XGEN(j)  (2304 + 64 * (j))
#define XB_TOP      3328
#define XB_TOPGEN   3392
#define XCD_BAR_WORDS 3456
#define XB_SPIN_CAP (1u << 18)

__device__ __forceinline__ unsigned xb_ld(unsigned* p)              { return __hip_atomic_load(p, __ATOMIC_RELAXED, __HIP_MEMORY_SCOPE_AGENT); }
__device__ __forceinline__ unsigned xb_add(unsigned* p, unsigned v) { return __hip_atomic_fetch_add(p, v, __ATOMIC_RELAXED, __HIP_MEMORY_SCOPE_AGENT); }
__device__ __forceinline__ unsigned xb_xcc_id() { return (unsigned)__builtin_amdgcn_s_getreg((3 << 11) | 20) & 0xFu; }
#define XB_SPIN(cond, bar) do { unsigned _sp = 0; while (cond) { __builtin_amdgcn_s_sleep(1); \
    if ((++_sp & 255u) == 0u) { if (xb_ld(&(bar)[XB_TMO])) break; if (_sp > XB_SPIN_CAP) { atomicAdd(&(bar)[XB_TMO], 1u); break; } } } } while (0)

struct XcdBarrier {
    unsigned* bar; unsigned x;
    volatile LAS unsigned* st;
};

__device__ __forceinline__ XcdBarrier xcd_barrier_post(unsigned* bar, volatile LAS unsigned* st) {
    XcdBarrier b; b.bar = bar; b.x = xb_xcc_id(); b.st = st;
    if (threadIdx.x == 0) (void)xb_add(&bar[XB_XCNT(b.x)], 1u);
    return b;
}
__device__ __forceinline__ void xcd_barrier_complete(unsigned* bar, unsigned x, unsigned& nloc, unsigned& nx) {
    const unsigned G = gridDim.x * gridDim.y * gridDim.z;
    unsigned sum, cnt, mine, sp = 0u;
    for (;;) {
        sum = 0u; cnt = 0u; mine = 0u;
#pragma unroll
        for (unsigned j = 0; j < 16; ++j) { const unsigned c = xb_ld(&bar[XB_XCNT(j)]); sum += c; cnt += (c > 0u) ? 1u : 0u; mine = (j == x) ? c : mine; }
        if (sum == G) break;
        __builtin_amdgcn_s_sleep(1);
        if ((++sp & 255u) == 0u) { if (xb_ld(&bar[XB_TMO])) break; if (sp > XB_SPIN_CAP) { atomicAdd(&bar[XB_TMO], 1u); break; } }
    }
    nloc = mine > 0u ? mine : 1u; nx = cnt > 0u ? cnt : 1u;
}

__device__ __forceinline__ void xcd_barrier(const XcdBarrier& b) {
    asm volatile("s_waitcnt vmcnt(0)" ::: "memory");
    __syncthreads();
    if (threadIdx.x == 0) {
        unsigned* bar = b.bar;
        __builtin_amdgcn_s_waitcnt(0);
        unsigned nloc = b.st[0], nx = b.st[1];
        if (nloc == 0u) { xcd_barrier_complete(bar, b.x, nloc, nx); b.st[0] = nloc; b.st[1] = nx; }
        const unsigned old = xb_add(&bar[XB_XSUB(b.x)], 1u);
        const unsigned gen = old / nloc;
        if (old + 1u == (gen + 1u) * nloc) {
            __builtin_amdgcn_fence(__ATOMIC_RELEASE, "agent");
            asm volatile("s_waitcnt vmcnt(0)" ::: "memory");
            const unsigned og = xb_add(&bar[XB_TOP], 1u);
            const unsigned tg = og / nx;
            if (og + 1u == (tg + 1u) * nx) xb_add(&bar[XB_TOPGEN], 1u);
            else XB_SPIN(xb_ld(&bar[XB_TOPGEN]) == tg, bar);
            __builtin_amdgcn_fence(__ATOMIC_ACQUIRE, "agent");
            xb_add(&bar[XB_XGEN(b.x)], 1u);
            asm volatile("s_waitcnt vmcnt(0)" ::: "memory");
        } else {
            XB_SPIN(xb_ld(&bar[XB_XGEN(b.x)]) == gen, bar);
            __builtin_amdgcn_fence(__ATOMIC_ACQUIRE, "agent");
            asm volatile("s_waitcnt vmcnt(0)" ::: "memory");
        }
    }
    __syncthreads();
}

typedef short bf16x8 __attribute__((ext_vector_type(8)));
typedef float f32x16 __attribute__((ext_vector_type(16)));
typedef float f32x4v __attribute__((ext_vector_type(4)));
typedef unsigned u32x2v __attribute__((ext_vector_type(2)));
struct Args { const float* in[21]; float* out; unsigned char* ws; int ph_lo, ph_hi, bar_sel, pad; };

template <int CTRL> __device__ __forceinline__ float dppf(float v) { return __builtin_bit_cast(float, __builtin_amdgcn_update_dpp(0, __builtin_bit_cast(int, v), CTRL, 0xf, 0xf, false)); }
__device__ __forceinline__ float rdlane(float v, int l) { return __builtin_bit_cast(float, __builtin_amdgcn_readlane(__builtin_bit_cast(int, v), l)); }
__device__ __forceinline__ float row16_sum(float v) { v += dppf<0xB1>(v); v += dppf<0x4E>(v); v += dppf<0x141>(v); v += dppf<0x140>(v); return v; }
__device__ __forceinline__ float row16_max(float v) { v = fmaxf(v, dppf<0xB1>(v)); v = fmaxf(v, dppf<0x4E>(v)); v = fmaxf(v, dppf<0x141>(v)); v = fmaxf(v, dppf<0x140>(v)); return v; }
__device__ __forceinline__ float wave_sum(float v) { v = row16_sum(v); return (rdlane(v, 0) + rdlane(v, 16)) + (rdlane(v, 32) + rdlane(v, 48)); }
__device__ __forceinline__ float wave_max(float v) { v = row16_max(v); return fmaxf(fmaxf(rdlane(v, 0), rdlane(v, 16)), fmaxf(rdlane(v, 32), rdlane(v, 48))); }
typedef unsigned xl_u2 __attribute__((ext_vector_type(2)));
#define XL_SWAP(WHICH, v, X, Y) const auto xl_r_ = __builtin_amdgcn_permlane##WHICH##_swap(__builtin_bit_cast(unsigned, v), __builtin_bit_cast(unsigned, v), false, false); \
    const unsigned xl_x_ = xl_r_[0], xl_y_ = xl_r_[1]; const float X = __uint_as_float(xl_x_), Y = __uint_as_float(xl_y_)
__device__ __forceinline__ float half32_sum(float v) { v = row16_sum(v); XL_SWAP(16, v, x, y); return x + y; }
__device__ __forceinline__ float half32_max(float v) { v = row16_max(v); XL_SWAP(16, v, x, y); return fmaxf(x, y); }
__device__ __forceinline__ float pair32_sum(float v) { XL_SWAP(32, v, x, y); return x + y; }
__device__ __forceinline__ float pair32_max(float v) { XL_SWAP(32, v, x, y); return fmaxf(x, y); }
#undef XL_SWAP
__device__ __forceinline__ float wave_scan_incl(float x, int lane) {
    x += dppf<0x111>(x); x += dppf<0x112>(x); x += dppf<0x114>(x); x += dppf<0x118>(x);
    const float s0 = rdlane(x, 15), s1 = rdlane(x, 31), s2 = rdlane(x, 47); const int r = lane >> 4;
    return x + (r == 0 ? 0.f : (r == 1 ? s0 : (r == 2 ? s0 + s1 : (s0 + s1) + s2)));
}
__device__ __forceinline__ float silu_f(float x) { return x / (1.f + __expf(-x)); }

template <bool GAIN>
__device__ __forceinline__ void cvt_item(const float* W, int ldw, int n0src, bf16* WT, int K, int drow0, int k0, LAS float* scr, int lane, const float* gk = nullptr) {
#pragma unroll 16
    for (int i = 0; i < 32; ++i) { const int kk = 2 * i + (lane >> 5); float v = W[(size_t)(k0 + kk) * ldw + n0src + (lane & 31)]; if (GAIN) v *= gk[kk]; scr[kk * 33 + (lane & 31)] = v; }
    LDS_WAIT(); asm volatile("" ::: "memory");
    const int c = lane & 7;
#pragma unroll
    for (int j = 0; j < 4; ++j) { const int n = (lane >> 3) + 8 * j; const LAS float* s = scr + (8 * c) * 33 + n;
        v4u o; o.x = pk2(s[0 * 33], s[1 * 33]); o.y = pk2(s[2 * 33], s[3 * 33]); o.z = pk2(s[4 * 33], s[5 * 33]); o.w = pk2(s[6 * 33], s[7 * 33]);
        *(GAS v4u*)(WT + (size_t)(drow0 + n) * K + k0 + 8 * c) = o; }
    LDS_WAIT(); asm volatile("" ::: "memory");
}
constexpr float W8_SCALE = 64.f, ACT8_SCALE = 4.f, YS8_SCALE = 16.f;
__device__ __forceinline__ unsigned pk4_fp8(float a, float b, float c, float d) { int w = 0; w = __builtin_amdgcn_cvt_pk_fp8_f32(a, b, w, false); w = __builtin_amdgcn_cvt_pk_fp8_f32(c, d, w, true); return (unsigned)w; }
__device__ __forceinline__ void cvt_item_fp8(const float* W, int ldw, int n0src, unsigned char* WT, int K, int drow0, int k0, LAS float* scr, int lane) {
#pragma unroll 16
    for (int i = 0; i < 32; ++i) { const int kk = 2 * i + (lane >> 5); scr[kk * 33 + (lane & 31)] = W[(size_t)(k0 + kk) * ldw + n0src + (lane & 31)] * W8_SCALE; }
    LDS_WAIT(); asm volatile("" ::: "memory");
    const int c = lane & 3;
#pragma unroll
    for (int j = 0; j < 2; ++j) { const int n = (lane >> 2) + 16 * j; const LAS float* s = scr + (16 * c) * 33 + n;
        v4u o; o.x = pk4_fp8(s[0 * 33], s[1 * 33], s[2 * 33], s[3 * 33]); o.y = pk4_fp8(s[4 * 33], s[5 * 33], s[6 * 33], s[7 * 33]);
        o.z = pk4_fp8(s[8 * 33], s[9 * 33], s[10 * 33], s[11 * 33]); o.w = pk4_fp8(s[12 * 33], s[13 * 33], s[14 * 33], s[15 * 33]);
        *(GAS v4u*)(WT + (size_t)(drow0 + n) * K + k0 + 16 * c) = o; }
    LDS_WAIT(); asm volatile("" ::: "memory");
}
__device__ __forceinline__ void ph_prologue(const Args& a, LAS unsigned char* lds, int bid, int nb) {
    const int tid = threadIdx.x, lane = tid & 63, wave = tid >> 6;
    unsigned char* ws = a.ws;
    LAS float* scr = (LAS float*)(lds + wave * 16384);
    const int gw = bid * 8 + wave, ngw = nb * 8;
    constexpr int I_IN = 16 * 72, I_OUT = 16 * 32;
    for (int it0 = gw; it0 < I_IN + I_OUT; it0 += ngw) {
        int it = it0;
        if (it < I_IN) { const int kb = it / 72, d0 = 32 * (it % 72); cvt_item<false>(a.in[2], DPROJ, d0 < 1536 ? d0 : d0 + 8, (bf16*)(ws + WS_WIN), DM, d0, 64 * kb, scr, lane); continue; }
        it -= I_IN;
        { const int kb = it / 32, d0 = 32 * (it % 32); cvt_item<true>(a.in[12], DM, d0, (bf16*)(ws + WS_WOUT), DM, d0, 64 * kb, scr, lane, (kb < 8 ? a.in[8] : a.in[11] - 512) + 64 * kb); }
    }
    __syncthreads();
    LAS float* wdt = (LAS float*)lds;
    for (int i = tid; i < 1024 * 8; i += NT) wdt[i] = a.in[2][(size_t)(i >> 3) * DPROJ + O_DT + (i & 7)];
    __syncthreads();
    const float* x = a.in[0]; const float* g = a.in[1]; bf16* u = (bf16*)(ws + WS_U); float* dtraw = (float*)(ws + WS_DTRAW);
    float wreg[16][8];
#pragma unroll
    for (int jc = 0; jc < 16; ++jc) { const LAS float* wd = wdt + (size_t)(4 * lane + 256 * (jc >> 2) + (jc & 3)) * 8; const f32x4v w0 = *(const LAS f32x4v*)wd, w1 = *(const LAS f32x4v*)(wd + 4);
        wreg[jc][0] = w0[0]; wreg[jc][1] = w0[1]; wreg[jc][2] = w0[2]; wreg[jc][3] = w0[3]; wreg[jc][4] = w1[0]; wreg[jc][5] = w1[1]; wreg[jc][6] = w1[2]; wreg[jc][7] = w1[3]; }
    for (int r0 = gw; r0 < T; r0 += 2 * ngw) {
        float4 vv[2][4];
#pragma unroll
        for (int q = 0; q < 2; ++q) { const int r = r0 + q * ngw; if (r < T) { const float4* xr = (const float4*)(x + (size_t)r * DM);
#pragma unroll
            for (int j = 0; j < 4; ++j) vv[q][j] = xr[lane + 64 * j]; } }
#pragma unroll
        for (int q = 0; q < 2; ++q) { const int r = r0 + q * ngw; if (r < T) {
        float4 (&v)[4] = vv[q]; float s = 0.f;
#pragma unroll
        for (int j = 0; j < 4; ++j) s += v[j].x * v[j].x + v[j].y * v[j].y + v[j].z * v[j].z + v[j].w * v[j].w;
        const float rs = rsqrtf(wave_sum(s) * (1.f / DM) + EPS);
        float dacc[8];
#pragma unroll
        for (int h = 0; h < 8; ++h) dacc[h] = 0.f;
#pragma unroll
        for (int j = 0; j < 4; ++j) { const float4 gg = ((const float4*)g)[lane + 64 * j];
            const float un[4] = {v[j].x * rs * gg.x, v[j].y * rs * gg.y, v[j].z * rs * gg.z, v[j].w * rs * gg.w};
            uint2 o; o.x = pk2(un[0], un[1]); o.y = pk2(un[2], un[3]);
            *(uint2*)(u + (size_t)r * DM + 4 * lane + 256 * j) = o;
#pragma unroll
            for (int c = 0; c < 4; ++c)
#pragma unroll
                for (int h = 0; h < 8; ++h) dacc[h] += un[c] * wreg[j * 4 + c][h]; }
#pragma unroll
        for (int h = 0; h < 8; ++h) dacc[h] = wave_sum(dacc[h]);
        if (lane == 0) {
#pragma unroll
            for (int h = 0; h < 8; ++h) dtraw[(size_t)r * 8 + h] = dacc[h]; }
        } }
    }
}

constexpr int CW_QHEAD = 1024;
constexpr int I_W1 = NE * 8 * 64, I_W2 = NE * 8 * 32;
struct CvtItem { const float* W; unsigned char* WT; int ldw, n0src, drow0, k0; };
__device__ __forceinline__ CvtItem moe_item(const Args& a, int it) {
    CvtItem c; unsigned char* ws = a.ws;
    if (it < I_W1) { const int e = it >> 9, r = it & 511, kb = r >> 6, d0 = 32 * (r & 63), pn = d0 >> 8, j0 = d0 & 255;
        c.W = a.in[16] + (size_t)e * 1024 * 2048; c.ldw = 2048; c.n0src = j0 < 128 ? pn * 128 + j0 : 1024 + pn * 128 + (j0 - 128); c.WT = ws + WS_W1 + (size_t)e * 2048 * 1024; c.drow0 = d0; c.k0 = 128 * kb; }
    else { it -= I_W1; const int e = it >> 8, r = it & 255, kb = r >> 5, d0 = 32 * (r & 31);
        c.W = a.in[18] + (size_t)e * 1024 * 1024; c.ldw = 1024; c.n0src = d0; c.WT = ws + WS_W2 + (size_t)e * 1024 * 1024; c.drow0 = d0; c.k0 = 128 * kb; }
    return c;
}
__device__ __forceinline__ void cvt8_load(const CvtItem& c, int lane, f32x4v (&v)[16]) {
    const float* p = c.W + (size_t)(c.k0 + 16 * (lane >> 3)) * c.ldw + c.n0src + (lane & 7) * 4;
#pragma unroll
    for (int i = 0; i < 16; ++i) v[i] = __builtin_nontemporal_load((const f32x4v*)(p + (size_t)i * c.ldw));
}
__device__ __forceinline__ void cvt8_finish(const CvtItem& c, int lane, const f32x4v (&v)[16]) {
    unsigned char* q = c.WT + (size_t)(c.drow0 + 4 * (lane & 7)) * DM + c.k0 + 16 * (lane >> 3);
#pragma unroll
    for (int cc = 0; cc < 4; ++cc) { v4u o;
        o.x = pk4_fp8(v[0][cc] * W8_SCALE, v[1][cc] * W8_SCALE, v[2][cc] * W8_SCALE, v[3][cc] * W8_SCALE); o.y = pk4_fp8(v[4][cc] * W8_SCALE, v[5][cc] * W8_SCALE, v[6][cc] * W8_SCALE, v[7][cc] * W8_SCALE);
        o.z = pk4_fp8(v[8][cc] * W8_SCALE, v[9][cc] * W8_SCALE, v[10][cc] * W8_SCALE, v[11][cc] * W8_SCALE); o.w = pk4_fp8(v[12][cc] * W8_SCALE, v[13][cc] * W8_SCALE, v[14][cc] * W8_SCALE, v[15][cc] * W8_SCALE);
        *(GAS v4u*)(q + (size_t)cc * DM) = o; }
}
constexpr int I_MOE = I_W1 + I_W2, QB8 = 4, QPART = I_MOE / 8;
static_assert(QPART % QB8 == 0, "queue partition");
__device__ __forceinline__ void moe_weight_queue(const Args& a, LAS unsigned char* lds, int bid) {
    const int tid = threadIdx.x, lane = tid & 63; (void)lds;
    unsigned* heads = (unsigned*)(a.ws + WS_CTL) + CW_QHEAD;
    for (int k = 0; k < 8; ++k) { const int part = (bid + k) & 7;
        for (;;) { unsigned b0 = 0u; if (lane == 0) b0 = atomicAdd(&heads[64 * part], (unsigned)QB8); b0 = (unsigned)__builtin_amdgcn_readfirstlane((int)b0);
            if (b0 >= (unsigned)QPART) break;
            const int base = part * QPART + (int)b0;
            f32x4v A[16], B[16];
#define QL(j, R) cvt8_load(moe_item(a, base + (j)), lane, R)
#define QF(j, R) cvt8_finish(moe_item(a, base + (j)), lane, R)
            QL(0, A); QL(1, B);
            QF(0, A); QL(2, A); QF(1, B); QL(3, B);
            QF(2, A); QF(3, B); } }
#undef QL
#undef QF
}
__device__ __forceinline__ void ph_conv(const Args& a, int bid, int nb) {
    const bf16* proj = (const bf16*)(a.ws + WS_PROJ); const float* cw = a.in[3]; const float* cb = a.in[4]; const float* dtb = a.in[5]; const float* dtraw = (const float*)(a.ws + WS_DTRAW);
    float* xc = (float*)(a.ws + WS_XC); float* dt = (float*)(a.ws + WS_DT);
    const size_t n = (size_t)T * 1024;
    for (size_t i = (size_t)bid * NT + threadIdx.x; i < n; i += (size_t)nb * NT) {
        const int t = (int)(i >> 10), c = (int)(i & 1023), s = t % SEQ;
        float v = cb[c];
#pragma unroll
        for (int k = 0; k < 4; ++k) { const int ss = s - 3 + k; if (ss >= 0) v += cw[k * 1024 + c] * bf2f(proj[(size_t)(t - 3 + k) * NP + PXBC + c]); }
        xc[i] = silu_f(v);
    }
    for (int i = bid * NT + threadIdx.x; i < T * 8; i += nb * NT) {
        const float v = dtraw[i] + dtb[i & 7];
        dt[i] = v > 20.f ? v : log1pf(__expf(v));
    }
}
__device__ __forceinline__ unsigned cvtpk(float lo, float hi) { unsigned r; asm volatile("v_cvt_pk_bf16_f32 %0, %1, %2" : "=v"(r) : "v"(lo), "v"(hi)); return r; }
__device__ __forceinline__ float silu_fast(float x) { return x * __builtin_amdgcn_rcpf(1.f + __expf(-x)); }
__device__ __forceinline__ void conv_load(const bf16* proj, int t0, int s0, int l0, int ch, unsigned (&raw)[11]) {
#pragma unroll
    for (int i = 0; i < 11; ++i) { const int l = l0 - 3 + i; unsigned wv = 0u; if (s0 + l >= 0) wv = *(const unsigned*)(proj + (size_t)(t0 + l) * NP + PXBC + ch); raw[i] = wv; }
}
__device__ __forceinline__ void conv_compute(const unsigned (&raw)[11], const float* cw, const float* cb, int ch, float (&o0)[8], float (&o1)[8]) {
    float w0[4], w1[4];
#pragma unroll
    for (int k = 0; k < 4; ++k) { const float2 wv = *(const float2*)(cw + k * 1024 + ch); w0[k] = wv.x; w1[k] = wv.y; }
    const float2 bb = *(const float2*)(cb + ch);
#pragma unroll
    for (int j = 0; j < 8; ++j) { float v0 = bb.x, v1 = bb.y;
#pragma unroll
        for (int k = 0; k < 4; ++k) { v0 += w0[k] * bflo(raw[j + k]); v1 += w1[k] * bfhi(raw[j + k]); }
        o0[j] = silu_fast(v0); o1[j] = silu_fast(v1); }
}
constexpr int SL_ST = 272, SL_XW = 0, SL_BMT = 256 * SL_ST, SL_WL = SL_BMT + 128 * SL_ST, SL_TMP = SL_WL + 2048;
__device__ __forceinline__ void ph_ssd_local(const Args& a, LAS unsigned char* lds, int bid, int nb) {
    const bf16* proj = (const bf16*)(a.ws + WS_PROJ); const float* dtraw = (const float*)(a.ws + WS_DTRAW); const float* dtb = a.in[5]; const float* alog = a.in[6];
    float* dtg = (float*)(a.ws + WS_DT); float* acum = (float*)(a.ws + WS_ACUM); float* cdec = (float*)(a.ws + WS_CDEC); float* states = (float*)(a.ws + WS_STATES);
    const int tid = threadIdx.x, lane = tid & 63, w = tid >> 6;
    LAS unsigned char* XW = lds + SL_XW; LAS unsigned char* BMT = lds + SL_BMT; LAS float* wl = (LAS float*)(lds + SL_WL); LAS float* tmp = (LAS float*)(lds + SL_TMP);
    for (int unit = bid; unit < BATCH * NCH * 2; unit += nb) {
        const int g = unit & 1, c = (unit >> 1) % NCH, b = unit / (2 * NCH); const int t0 = b * SEQ + c * 128;
        __syncthreads();
        { const int r = tid >> 7, l = tid & 127, h = g * 4 + r;
          const float v = dtraw[(size_t)(t0 + l) * 8 + h] + dtb[h]; const float dtv = fmaxf(v, 0.f) + log1pf(__expf(-fabsf(v))); const float av = -__expf(alog[h]);
          float x = dtv * av;
          x = wave_scan_incl(x, lane);
          if (lane == 63) tmp[w] = x;
          __syncthreads();
          if (w & 1) x += tmp[w - 1];
          const float last = tmp[2 * r] + tmp[2 * r + 1];
          dtg[(size_t)(t0 + l) * 8 + h] = dtv; acum[(size_t)(t0 + l) * 8 + h] = x; wl[r * 128 + l] = dtv * __expf(last - x);
          if (l == 127) cdec[(b * NCH + c) * 8 + h] = __expf(x); }
        __syncthreads();
        { unsigned raw[6][11];
#pragma unroll
          for (int it = 0; it < 6; ++it) { const int task = tid + it * NT, pi = task % 192, l0 = (task / 192) * 8;
              const int ch = pi < 128 ? g * 256 + 2 * pi : 512 + g * 128 + 2 * (pi - 128); conv_load(proj, t0, c * 128, l0, ch, raw[it]); }
#pragma unroll
          for (int it = 0; it < 6; ++it) { const int task = tid + it * NT, pi = task % 192, l0 = (task / 192) * 8;
            const int ch = pi < 128 ? g * 256 + 2 * pi : 512 + g * 128 + 2 * (pi - 128);
            float o0[8], o1[8]; conv_compute(raw[it], a.in[3], a.in[4], ch, o0, o1);
            if (pi < 128) { const int row = 2 * pi; const LAS float* ws_ = wl + (row >> 6) * 128 + l0;
#pragma unroll
                for (int j = 0; j < 8; ++j) { o0[j] *= ws_[j]; o1[j] *= ws_[j]; }
                v4u p0, p1; p0.x = cvtpk(o0[0], o0[1]); p0.y = cvtpk(o0[2], o0[3]); p0.z = cvtpk(o0[4], o0[5]); p0.w = cvtpk(o0[6], o0[7]);
                p1.x = cvtpk(o1[0], o1[1]); p1.y = cvtpk(o1[2], o1[3]); p1.z = cvtpk(o1[4], o1[5]); p1.w = cvtpk(o1[6], o1[7]);
                *(LAS v4u*)(XW + row * SL_ST + l0 * 2) = p0; *(LAS v4u*)(XW + (row + 1) * SL_ST + l0 * 2) = p1; }
            else { const int row = 2 * (pi - 128);
                v4u p0, p1; p0.x = cvtpk(o0[0], o0[1]); p0.y = cvtpk(o0[2], o0[3]); p0.z = cvtpk(o0[4], o0[5]); p0.w = cvtpk(o0[6], o0[7]);
                p1.x = cvtpk(o1[0], o1[1]); p1.y = cvtpk(o1[2], o1[3]); p1.z = cvtpk(o1[4], o1[5]); p1.w = cvtpk(o1[6], o1[7]);
                *(LAS v4u*)(BMT + row * SL_ST + l0 * 2) = p0; *(LAS v4u*)(BMT + (row + 1) * SL_ST + l0 * 2) = p1; } } }
        __syncthreads();
        { const int r = w >> 1, ph = w & 1, qc = lane & 31, hh = lane >> 5, h = g * 4 + r;
          f32x16 acc[4];
#pragma unroll
          for (int n4 = 0; n4 < 4; ++n4)
#pragma unroll
              for (int i = 0; i < 16; ++i) acc[n4][i] = 0.f;
#pragma unroll
          for (int ks = 0; ks < 8; ++ks) { const bf16x8 af = *(const LAS bf16x8*)(XW + (r * 64 + ph * 32 + qc) * SL_ST + (16 * ks + 8 * hh) * 2);
#pragma unroll
              for (int n4 = 0; n4 < 4; ++n4) { const bf16x8 bfr = *(const LAS bf16x8*)(BMT + (n4 * 32 + qc) * SL_ST + (16 * ks + 8 * hh) * 2);
                  acc[n4] = __builtin_amdgcn_mfma_f32_32x32x16_bf16(af, bfr, acc[n4], 0, 0, 0); } }
          float* st = states + ((size_t)((b * NCH + c) * 8 + h)) * 8192;
#pragma unroll
          for (int n4 = 0; n4 < 4; ++n4)
#pragma unroll
              for (int i = 0; i < 16; ++i) { const int pp = ph * 32 + (i & 3) + 8 * (i >> 2) + 4 * hh; st[pp * 128 + n4 * 32 + qc] = acc[n4][i]; } }
    }
}
__device__ __forceinline__ void ph_scan(const Args& a, int bid, int nb) {
    const float* states = (const float*)(a.ws + WS_STATES); const float* cdec = (const float*)(a.ws + WS_CDEC); bf16* prev = (bf16*)(a.ws + WS_PREV);
    const int n4 = BATCH * 8 * 2048;
    for (int i = bid * NT + threadIdx.x; i < n4; i += nb * NT) {
        const int e4 = i & 2047, h = (i >> 11) & 7, b = i >> 14;
        f32x4v st[NCH]; float dc[NCH];
#pragma unroll
        for (int c = 0; c < NCH; ++c) { st[c] = *(const f32x4v*)(states + ((size_t)((b * NCH + c) * 8 + h)) * 8192 + e4 * 4); dc[c] = cdec[(b * NCH + c) * 8 + h]; }
        f32x4v hc = {0.f, 0.f, 0.f, 0.f};
#pragma unroll
        for (int c = 0; c < NCH; ++c) { u32x2v pk; pk.x = cvtpk(hc[0], hc[1]); pk.y = cvtpk(hc[2], hc[3]); *(u32x2v*)(prev + ((size_t)((b * NCH + c) * 8 + h)) * 8192 + e4 * 4) = pk; hc = hc * dc[c] + st[c]; }
    }
}
constexpr int SO_XST = 264, SO_NST = 272, SO_XS = 0, SO_BM = 256 * SO_XST, SO_CM = SO_BM + 128 * SO_NST, SO_AC = SO_CM + 128 * SO_NST, SO_DT = SO_AC + 2048, SO_EA = SO_DT + 2048, SO_END = SO_EA + 2048;
constexpr int SO_YST = 260;
static_assert(128 * SO_YST * 4 <= SO_AC && SO_END <= SCR_BYTES, "ssd_out LDS map");
__device__ __forceinline__ void ph_ssd_out(const Args& a, LAS unsigned char* lds, int bid, int nb) {
    const bf16* proj = (const bf16*)(a.ws + WS_PROJ); const float* dtg = (const float*)(a.ws + WS_DT); const float* acum = (const float*)(a.ws + WS_ACUM);
    const bf16* prev = (const bf16*)(a.ws + WS_PREV); const float* dsk = a.in[7];
    bf16* ygb = (bf16*)(a.ws + WS_CAT); float* ssd = (float*)(a.ws + WS_SSSD);
    const int tid = threadIdx.x, lane = tid & 63, w = tid >> 6, r = w >> 1, lsel = w & 1, qc = lane & 31, hh = lane >> 5;
    LAS unsigned char* XS = lds + SO_XS; LAS unsigned char* BM = lds + SO_BM; LAS unsigned char* CM = lds + SO_CM;
    LAS float* AC = (LAS float*)(lds + SO_AC); LAS float* DT = (LAS float*)(lds + SO_DT); LAS float* EA = (LAS float*)(lds + SO_EA); LAS float* YS = (LAS float*)lds;
    for (int unit = bid; unit < BATCH * NCH * 2; unit += nb) {
        const int g = unit & 1, c = (unit >> 1) % NCH, b = unit / (2 * NCH); const int t0 = b * SEQ + c * 128;
        __syncthreads();
        bf16x8 pf[2][8];
        { const bf16* pvb = prev + ((size_t)((b * NCH + c) * 8 + g * 4 + r)) * 8192 + qc * 128 + 8 * hh;
#pragma unroll
          for (int pb = 0; pb < 2; ++pb)
#pragma unroll
              for (int ks = 0; ks < 8; ++ks) pf[pb][ks] = *(const bf16x8*)(pvb + pb * 32 * 128 + 16 * ks); }
        { const int rr = tid >> 7, l = tid & 127, h = g * 4 + rr; const float ac = acum[(size_t)(t0 + l) * 8 + h];
          AC[rr * 128 + l] = ac; DT[rr * 128 + l] = dtg[(size_t)(t0 + l) * 8 + h]; EA[rr * 128 + l] = __expf(ac); }
#pragma unroll 1
        for (int bt = 0; bt < 2; ++bt) { unsigned raw[4][11];
#pragma unroll
          for (int it = 0; it < 4; ++it) { const int task = tid + (bt * 4 + it) * NT, pi = task & 255, l0 = (task >> 8) * 8;
              const int ch = pi < 128 ? g * 256 + 2 * pi : (pi < 192 ? 512 + g * 128 + 2 * (pi - 128) : 768 + g * 128 + 2 * (pi - 192)); conv_load(proj, t0, c * 128, l0, ch, raw[it]); }
#pragma unroll
          for (int it = 0; it < 4; ++it) { const int task = tid + (bt * 4 + it) * NT, pi = task & 255, l0 = (task >> 8) * 8;
            const int ch = pi < 128 ? g * 256 + 2 * pi : (pi < 192 ? 512 + g * 128 + 2 * (pi - 128) : 768 + g * 128 + 2 * (pi - 192));
            float o0[8], o1[8]; conv_compute(raw[it], a.in[3], a.in[4], ch, o0, o1);
            if (pi < 128) { const int row = 2 * pi; u32x2v q0, q1;
                q0.x = cvtpk(o0[0], o0[1]); q0.y = cvtpk(o0[2], o0[3]); q1.x = cvtpk(o0[4], o0[5]); q1.y = cvtpk(o0[6], o0[7]);
                *(LAS u32x2v*)(XS + row * SO_XST + l0 * 2) = q0; *(LAS u32x2v*)(XS + row * SO_XST + l0 * 2 + 8) = q1;
                q0.x = cvtpk(o1[0], o1[1]); q0.y = cvtpk(o1[2], o1[3]); q1.x = cvtpk(o1[4], o1[5]); q1.y = cvtpk(o1[6], o1[7]);
                *(LAS u32x2v*)(XS + (row + 1) * SO_XST + l0 * 2) = q0; *(LAS u32x2v*)(XS + (row + 1) * SO_XST + l0 * 2 + 8) = q1; }
            else { LAS unsigned char* img = pi < 192 ? BM : CM; const int n = 2 * ((pi - 128) & 63);
#pragma unroll
                for (int j = 0; j < 8; ++j) *(LAS unsigned*)(img + (l0 + j) * SO_NST + n * 2) = cvtpk(o0[j], o1[j]); } } }
        __syncthreads();
        const int h = g * 4 + r; const float dskip = dsk[h];
        f32x16 Y[2][2];
#pragma unroll
        for (int li = 0; li < 2; ++li) {
            const int lb = lsel ? (1 + li) : (li ? 3 : 0);
#pragma unroll
            for (int pb = 0; pb < 2; ++pb)
#pragma unroll
                for (int i = 0; i < 16; ++i) Y[li][pb][i] = 0.f;
#pragma unroll
            for (int ks = 0; ks < 8; ++ks) { const bf16x8 bfr = *(const LAS bf16x8*)(CM + (lb * 32 + qc) * SO_NST + (16 * ks + 8 * hh) * 2);
#pragma unroll
                for (int pb = 0; pb < 2; ++pb) Y[li][pb] = __builtin_amdgcn_mfma_f32_32x32x16_bf16(pf[pb][ks], bfr, Y[li][pb], 0, 0, 0); }
            const float ea = EA[r * 128 + lb * 32 + qc], acl = AC[r * 128 + lb * 32 + qc];
#pragma unroll
            for (int pb = 0; pb < 2; ++pb)
#pragma unroll
                for (int i = 0; i < 16; ++i) Y[li][pb][i] *= ea;
            for (int sb = 0; sb <= lb; ++sb) {
                f32x16 X;
#pragma unroll
                for (int i = 0; i < 16; ++i) X[i] = 0.f;
#pragma unroll
                for (int ks = 0; ks < 8; ++ks) { const bf16x8 af = *(const LAS bf16x8*)(BM + (sb * 32 + qc) * SO_NST + (16 * ks + 8 * hh) * 2);
                    const bf16x8 bfr = *(const LAS bf16x8*)(CM + (lb * 32 + qc) * SO_NST + (16 * ks + 8 * hh) * 2);
                    X = __builtin_amdgcn_mfma_f32_32x32x16_bf16(af, bfr, X, 0, 0, 0); }
                const bool dg = (sb == lb);
#pragma unroll
                for (int q = 0; q < 4; ++q) { const f32x4v as4 = *(const LAS f32x4v*)(AC + r * 128 + sb * 32 + 8 * q + 4 * hh), ds4 = *(const LAS f32x4v*)(DT + r * 128 + sb * 32 + 8 * q + 4 * hh);
#pragma unroll
                    for (int i = 0; i < 4; ++i) { const int sl = 8 * q + 4 * hh + i;
                        const float e = __expf(acl - as4[i]) * ds4[i]; const bool ok = !dg || sl <= qc; float f = ok ? e : 0.f;
                        float xv = X[4 * q + i] * f; if (dg && sl == qc) xv += dskip; X[4 * q + i] = xv; } }
#pragma unroll
                for (int k2 = 0; k2 < 2; ++k2) { union { bf16x8 v; unsigned u[4]; } gb;
#pragma unroll
                    for (int e = 0; e < 4; ++e) gb.u[e] = cvtpk(X[8 * k2 + 2 * e], X[8 * k2 + 2 * e + 1]);
#pragma unroll
                    for (int pb = 0; pb < 2; ++pb) { const LAS unsigned char* xp = XS + (r * 64 + pb * 32 + qc) * SO_XST + (sb * 32 + 16 * k2 + 4 * hh) * 2;
                        union { bf16x8 v; u32x2v h2[2]; } af; af.h2[0] = *(const LAS u32x2v*)xp; af.h2[1] = *(const LAS u32x2v*)(xp + 16);
                        Y[li][pb] = __builtin_amdgcn_mfma_f32_32x32x16_bf16(af.v, gb.v, Y[li][pb], 0, 0, 0); } }
            }
        }
        __syncthreads();
#pragma unroll
        for (int li = 0; li < 2; ++li) { const int lb = lsel ? (1 + li) : (li ? 3 : 0);
#pragma unroll
            for (int pb = 0; pb < 2; ++pb)
#pragma unroll
                for (int q = 0; q < 4; ++q) { f32x4v v4; v4[0] = Y[li][pb][4 * q]; v4[1] = Y[li][pb][4 * q + 1]; v4[2] = Y[li][pb][4 * q + 2]; v4[3] = Y[li][pb][4 * q + 3];
                    *(LAS f32x4v*)(YS + (lb * 32 + qc) * SO_YST + r * 64 + pb * 32 + 8 * q + 4 * hh) = v4; } }
        __syncthreads();
        { v4u zz8[8];
#pragma unroll
          for (int it = 0; it < 8; ++it) { const int task = tid + it * NT, row = task >> 5, ck = task & 31; zz8[it] = *(const v4u*)(proj + (size_t)(t0 + row) * NP + PZ + g * 256 + ck * 8); }
#pragma unroll
          for (int it = 0; it < 8; ++it) { const int task = tid + it * NT, row = task >> 5, ck = task & 31; const v4u zz = zz8[it];
            const f32x4v y0 = *(const LAS f32x4v*)(YS + row * SO_YST + ck * 8), y1 = *(const LAS f32x4v*)(YS + row * SO_YST + ck * 8 + 4);
            float o[8]; o[0] = y0[0] * silu_fast(bflo(zz.x)); o[1] = y0[1] * silu_fast(bfhi(zz.x)); o[2] = y0[2] * silu_fast(bflo(zz.y)); o[3] = y0[3] * silu_fast(bfhi(zz.y));
            o[4] = y1[0] * silu_fast(bflo(zz.z)); o[5] = y1[1] * silu_fast(bfhi(zz.z)); o[6] = y1[2] * silu_fast(bflo(zz.w)); o[7] = y1[3] * silu_fast(bfhi(zz.w));
            float ss = 0.f;
#pragma unroll
            for (int e = 0; e < 8; ++e) ss += o[e] * o[e];
            ss = half32_sum(ss);
            if (ck == 0) ssd[(size_t)(t0 + row) * 2 + g] = ss;
            v4u ov; ov.x = cvtpk(o[0], o[1]); ov.y = cvtpk(o[2], o[3]); ov.z = cvtpk(o[4], o[5]); ov.w = cvtpk(o[6], o[7]);
            *(v4u*)(ygb + (size_t)(t0 + row) * 1024 + g * 256 + ck * 8) = ov; } }
    }
}
constexpr int AT_KST = 144, AT_VST = 520, AT_K = 0, AT_V = 256 * AT_KST, AT_B = AT_V + 64 * AT_VST;
__device__ __forceinline__ void ph_attn(const Args& a, LAS unsigned char* lds, int bid, int nb) {
    const bf16* proj = (const bf16*)(a.ws + WS_PROJ); const float* sinks = a.in[9]; const float* relb = a.in[10];
    bf16* ao = (bf16*)(a.ws + WS_CAT) + 512; float* ssat = (float*)(a.ws + WS_SSAT);
    const int tid = threadIdx.x, lane = tid & 63, w = tid >> 6, g = w >> 1, half = w & 1, qc = lane & 31, hh = lane >> 5;
    LAS unsigned char* Kimg = lds + AT_K; LAS unsigned char* VT = lds + AT_V; LAS float* biasT = (LAS float*)(lds + AT_B);
    for (int unit = bid; unit < BATCH * NCH * 2; unit += nb) {
        const int kvh = unit & 1, blk = (unit >> 1) % NCH, b = unit / (2 * NCH); const int t0 = b * SEQ + blk * 128;
        __syncthreads();
        { v4u kv4[4], vv4[4];
#pragma unroll
          for (int it = 0; it < 4; ++it) { const int c = tid + it * NT, row = c >> 3, part = c & 7; kv4[it] = (v4u){0u, 0u, 0u, 0u}; vv4[it] = (v4u){0u, 0u, 0u, 0u};
            if (blk > 0 || row >= 128) { const bf16* src = proj + (size_t)(t0 - 128 + row) * NP + kvh * 64 + part * 8; kv4[it] = *(const v4u*)(src + PK); vv4[it] = *(const v4u*)(src + PV); } }
#pragma unroll
          for (int it = 0; it < 4; ++it) { const int c = tid + it * NT, row = c >> 3, part = c & 7; const v4u kv = kv4[it], vv = vv4[it];
            *(LAS v4u*)(Kimg + row * AT_KST + part * 16) = kv;
            LAS unsigned short* vt = (LAS unsigned short*)(VT + (part * 8) * AT_VST + row * 2);
            vt[0 * (AT_VST / 2)] = (unsigned short)(vv.x & 0xffffu); vt[1 * (AT_VST / 2)] = (unsigned short)(vv.x >> 16);
            vt[2 * (AT_VST / 2)] = (unsigned short)(vv.y & 0xffffu); vt[3 * (AT_VST / 2)] = (unsigned short)(vv.y >> 16);
            vt[4 * (AT_VST / 2)] = (unsigned short)(vv.z & 0xffffu); vt[5 * (AT_VST / 2)] = (unsigned short)(vv.z >> 16);
            vt[6 * (AT_VST / 2)] = (unsigned short)(vv.w & 0xffffu); vt[7 * (AT_VST / 2)] = (unsigned short)(vv.w >> 16); } }
        { const int gg = tid >> 7, dist = tid & 127; biasT[gg * 128 + dist] = relb[c_bucket[dist] * 8 + kvh * 4 + gg]; }
        __syncthreads();
        const int hq = kvh * 4 + g; const float sink = sinks[hq];
#pragma unroll 1
        for (int qb = 0; qb < 2; ++qb) {
            const int q0 = half * 64 + qb * 32; const size_t tq = (size_t)(t0 + q0 + qc);
            bf16x8 qf[4];
            { const bf16* qp = proj + tq * NP + PQ + hq * 64 + 8 * hh;
#pragma unroll
              for (int ks = 0; ks < 4; ++ks) qf[ks] = *(const bf16x8*)(qp + 16 * ks); }
            f32x16 sc[5];
#pragma unroll
            for (int kb = 0; kb < 5; ++kb) {
#pragma unroll
                for (int r = 0; r < 16; ++r) sc[kb][r] = 0.f;
#pragma unroll
                for (int ks = 0; ks < 4; ++ks) { const bf16x8 kf = *(const LAS bf16x8*)(Kimg + (q0 + 32 * kb + qc) * AT_KST + (16 * ks + 8 * hh) * 2);
                    sc[kb] = __builtin_amdgcn_mfma_f32_32x32x16_bf16(kf, qf[ks], sc[kb], 0, 0, 0); } }
            float m = -INFINITY;
#pragma unroll
            for (int kb = 0; kb < 5; ++kb)
#pragma unroll
                for (int r = 0; r < 16; ++r) { const int ki = (r & 3) + 8 * (r >> 2) + 4 * hh, dist = qc + 128 - 32 * kb - ki, j = q0 + 32 * kb + ki;
                    const bool ok = dist >= 0 && dist < 128 && (blk > 0 || j >= 128);
                    const float v = ok ? sc[kb][r] * 0.125f + biasT[g * 128 + (dist & 127)] : -INFINITY; sc[kb][r] = v; m = fmaxf(m, v); }
            m = pair32_max(m); m = fmaxf(m, sink);
            float l = 0.f;
#pragma unroll
            for (int kb = 0; kb < 5; ++kb)
#pragma unroll
                for (int r = 0; r < 16; ++r) { const float pv = __expf(sc[kb][r] - m); sc[kb][r] = pv; l += pv; }
            l = pair32_sum(l); l += __expf(sink - m);
            f32x16 o[2];
#pragma unroll
            for (int db = 0; db < 2; ++db)
#pragma unroll
                for (int r = 0; r < 16; ++r) o[db][r] = 0.f;
#pragma unroll
            for (int kb = 0; kb < 5; ++kb)
#pragma unroll
                for (int k2 = 0; k2 < 2; ++k2) {
                    union { bf16x8 v; unsigned u[4]; } pb;
#pragma unroll
                    for (int e = 0; e < 4; ++e) pb.u[e] = cvtpk(sc[kb][8 * k2 + 2 * e], sc[kb][8 * k2 + 2 * e + 1]);
#pragma unroll
                    for (int db = 0; db < 2; ++db) { const LAS unsigned char* vp = VT + (db * 32 + qc) * AT_VST + (q0 + 32 * kb + 16 * k2 + 4 * hh) * 2;
                        union { bf16x8 v; u32x2v h2[2]; } va; va.h2[0] = *(const LAS u32x2v*)vp; va.h2[1] = *(const LAS u32x2v*)(vp + 16);
                        o[db] = __builtin_amdgcn_mfma_f32_32x32x16_bf16(va.v, pb.v, o[db], 0, 0, 0); } }
            const float inv = 1.f / l; float ss = 0.f;
#pragma unroll
            for (int db = 0; db < 2; ++db)
#pragma unroll
                for (int r = 0; r < 16; ++r) { o[db][r] *= inv; ss += o[db][r] * o[db][r]; }
            ss = pair32_sum(ss);
            if (hh == 0) ssat[tq * 8 + hq] = ss;
#pragma unroll
            for (int db = 0; db < 2; ++db)
#pragma unroll
                for (int q4 = 0; q4 < 4; ++q4) { uint2 pk; pk.x = cvtpk(o[db][4 * q4], o[db][4 * q4 + 1]); pk.y = cvtpk(o[db][4 * q4 + 2], o[db][4 * q4 + 3]);
                    *(uint2*)(ao + tq * 1024 + hq * 64 + db * 32 + 8 * q4 + 4 * hh) = pk; }
        }
    }
}
constexpr int RT_UST = 1025;
constexpr int RT_P = 0, RT_L = 32768;
constexpr int RT_HIST = TAB_OFF, RT_BASE = TAB_OFF + 128, RT_SE = TAB_OFF + 256, RT_SG = RT_SE + 512, RT_SS = RT_SG + 512;
static_assert(32 * RT_UST * 4 <= SCR_BYTES, "router LDS map");
__device__ __forceinline__ void ph_router(const Args& a, LAS unsigned char* lds, int bid, int nb) {
    const float* hh_ = a.in[0]; const bf16* dl_ = (const bf16*)(a.ws + WS_H); const float* g = a.in[13]; const float* wr = a.in[14]; const float* br = a.in[15];
    unsigned char* u2 = a.ws + WS_U2; int* toke = (int*)(a.ws + WS_TOKE); int* toks = (int*)(a.ws + WS_TOKS);
    int* ltok = (int*)(a.ws + WS_LTOK); float* lgate = (float*)(a.ws + WS_LGATE); unsigned* cnt = (unsigned*)(a.ws + WS_CTL);
    const int tid = threadIdx.x, lane = tid & 63, w = tid >> 6, qc = lane & 31, hh = lane >> 5;
    LAS float* U = (LAS float*)lds; LAS float* P = (LAS float*)(lds + RT_P); LAS float* L = (LAS float*)(lds + RT_L);
    LAS unsigned* hist = (LAS unsigned*)(lds + RT_HIST); LAS unsigned* basev = (LAS unsigned*)(lds + RT_BASE);
    LAS int* se = (LAS int*)(lds + RT_SE); LAS float* sg = (LAS float*)(lds + RT_SG); LAS unsigned* ssl = (LAS unsigned*)(lds + RT_SS);
    float breg[64];
#pragma unroll
    for (int kk = 0; kk < 64; ++kk) breg[kk] = wr[(size_t)(128 * w + 2 * kk + hh) * NE + qc];
    float4 gq[4];
#pragma unroll
    for (int j = 0; j < 4; ++j) gq[j] = ((const float4*)g)[lane + 64 * j];
    const float brv = br[tid & 31];
    float4 vv[4][4]; uint2 dd[4][4];
#define RT_LOAD(tile_) do { const int tk_ = (tile_) * 32; _Pragma("unroll") for (int rr = 0; rr < 4; ++rr) { const int row = w * 4 + rr; \
        const float4* xr = (const float4*)(hh_ + (size_t)(tk_ + row) * DM); const uint2* dr = (const uint2*)(dl_ + (size_t)(tk_ + row) * DM); \
        _Pragma("unroll") for (int j = 0; j < 4; ++j) { vv[rr][j] = xr[lane + 64 * j]; dd[rr][j] = dr[lane + 64 * j]; } } } while (0)
    if (bid < T / 32) RT_LOAD(bid);
    for (int tile = bid; tile < T / 32; tile += nb) {
        const int tk0 = tile * 32;
        __syncthreads();
        if (tid < NE) hist[tid] = 0u;
#pragma unroll
        for (int rr = 0; rr < 4; ++rr) { const int row = w * 4 + rr; float4 (&v)[4] = vv[rr]; float s = 0.f;
#pragma unroll
            for (int j = 0; j < 4; ++j) { const uint2 dw = dd[rr][j]; v[j].x += bflo(dw.x); v[j].y += bfhi(dw.x); v[j].z += bflo(dw.y); v[j].w += bfhi(dw.y);
                s += v[j].x * v[j].x + v[j].y * v[j].y + v[j].z * v[j].z + v[j].w * v[j].w; }
            const float rs = rsqrtf(wave_sum(s) * (1.f / DM) + EPS);
#pragma unroll
            for (int j = 0; j < 4; ++j) { const float4 gg = gq[j];
                const float un[4] = {v[j].x * rs * gg.x, v[j].y * rs * gg.y, v[j].z * rs * gg.z, v[j].w * rs * gg.w};
                *(unsigned*)(u2 + (size_t)(tk0 + row) * DM + 4 * lane + 256 * j) = pk4_fp8(un[0], un[1], un[2], un[3]);
                LAS float* ur = U + row * RT_UST + 4 * lane + 256 * j; ur[0] = un[0]; ur[1] = un[1]; ur[2] = un[2]; ur[3] = un[3]; } }
        if (tile + nb < T / 32) RT_LOAD(tile + nb);
        __syncthreads();
        f32x16 acc;
#pragma unroll
        for (int i = 0; i < 16; ++i) acc[i] = 0.f;
#pragma unroll
        for (int kk = 0; kk < 64; ++kk) acc = __builtin_amdgcn_mfma_f32_32x32x2f32(U[qc * RT_UST + 128 * w + 2 * kk + hh], breg[kk], acc, 0, 0, 0);
        __syncthreads();
#pragma unroll
        for (int i = 0; i < 16; ++i) P[(w * 32 + (i & 3) + 8 * (i >> 2) + 4 * hh) * 32 + qc] = acc[i];
        __syncthreads();
#pragma unroll
        for (int o2 = 0; o2 < 2; ++o2) { const int o = tid + 512 * o2; float sacc = brv;
#pragma unroll
            for (int ww = 0; ww < 8; ++ww) sacc += P[ww * 1024 + o];
            L[o] = sacc; }
        __syncthreads();
#pragma unroll 1
        for (int it = 0; it < 2; ++it) { const int tok = w * 4 + it * 2 + hh;
            float cur = L[tok * 32 + qc]; int idx[4]; float val[4];
#pragma unroll
            for (int k = 0; k < 4; ++k) { const float m = half32_max(cur);
                const unsigned long long bal = __ballot(cur == m); const unsigned hb = hh ? (unsigned)(bal >> 32) : (unsigned)bal; const int wi = __ffs((int)hb) - 1;
                idx[k] = wi; val[k] = m; if (qc == wi) cur = -INFINITY; }
            if (qc < 4) { const float e1 = __expf(val[1] - val[0]), e2 = __expf(val[2] - val[0]), e3 = __expf(val[3] - val[0]); const float inv = 1.f / (1.f + e1 + e2 + e3);
                const float gsel = qc == 0 ? inv : (qc == 1 ? e1 * inv : (qc == 2 ? e2 * inv : e3 * inv)); const int esel = qc == 0 ? idx[0] : (qc == 1 ? idx[1] : (qc == 2 ? idx[2] : idx[3]));
                se[tok * 4 + qc] = esel; sg[tok * 4 + qc] = gsel; ssl[tok * 4 + qc] = atomicAdd((unsigned*)&hist[esel], 1u); } }
        __syncthreads();
        if (tid < NE) basev[tid] = atomicAdd(&cnt[tid], hist[tid]);
        __syncthreads();
        if (tid < 128) { const int tok = tid >> 2, e = se[tid]; const unsigned sl = basev[e] + ssl[tid]; const int tg = tk0 + tok;
            toke[tg * 4 + (tid & 3)] = e; toks[tg * 4 + (tid & 3)] = (int)sl; ltok[(size_t)e * T + sl] = tg; lgate[(size_t)e * T + sl] = sg[tid]; }
    }
}
#undef RT_LOAD
__device__ __forceinline__ void moe_setup(const Args& a, LAS unsigned char* lds, int nct, int G, int c, bool gather, unsigned pitch, bool plain) {
    LAS int* s_cnt = (LAS int*)(lds + TB_CNT); LAS int* s_ptile = (LAS int*)(lds + TB_PTILE); LAS int* s_re = (LAS int*)(lds + TB_RE); LAS int* s_tstart = (LAS int*)(lds + TB_TSTART);
    LAS int* s_misc = (LAS int*)(lds + TB_MISC); LAS int* s_units = (LAS int*)(lds + TB_UNITS); LAS unsigned* rowtab = (LAS unsigned*)(lds + TB_ROWTAB);
    const unsigned* cnt = (const unsigned*)(a.ws + WS_CTL); const int* ltok = (const int*)(a.ws + WS_LTOK);
    const int tid = threadIdx.x;
    __syncthreads();
    if (tid < NE) s_cnt[tid] = (int)cnt[tid];
    __syncthreads();
    if (tid == 0) { int pt = 0, ts = 0;
        for (int e = 0; e < NE; ++e) { const int cn = s_cnt[e], re = (cn + 255) >> 8; s_ptile[e] = pt; s_re[e] = re; s_tstart[e] = ts; pt += re; ts += re * nct; }
        s_ptile[NE] = pt; s_tstart[NE] = ts; s_misc[0] = ts; s_misc[1] = (ts + G - 1) / G; }
    __syncthreads();
    if (tid < 16) { const int nwg = s_misc[0]; const long L = (long)tid * G + c; int pm = -1, pn = 0;
        if (L < nwg) { int wgid = (int)L; { const int q = nwg / 8, r = nwg % 8, xcd = wgid % 8, off = wgid / 8; wgid = (xcd < r ? xcd * (q + 1) : r * (q + 1) + (xcd - r) * q) + off; }
            int e = 0; while (wgid >= s_tstart[e + 1]) ++e;
            const int local = wgid - s_tstart[e], re = s_re[e]; pm = s_ptile[e] + local % re; pn = e * nct + local / re; }
        s_units[2 * tid] = pm; s_units[2 * tid + 1] = pn; }
    __syncthreads();
    if (gather) { const int nr = s_misc[1] < 9 ? s_misc[1] : 9;
        LAS float* btab = (LAS float*)(lds + 131072); LAS float* gtab = btab + 5 * 256;
        float bv_[5], gv_[5]; unsigned rv_[5];
#pragma unroll
        for (int q = 0; q < 5; ++q) { const int idx = tid + q * NT, i = idx >> 8, r = idx & 255; bv_[q] = 0.f; gv_[q] = 0.f; rv_[q] = 0u;
            if (i < nr) { const int pm = s_units[2 * i]; if (pm >= 0) { const int e = s_units[2 * i + 1] / nct, ct = s_units[2 * i + 1] % nct, sl = (pm - s_ptile[e]) * 256 + r; const bool ok = sl < s_cnt[e];
                if (plain) { bv_[q] = a.in[19][(size_t)e * 1024 + ct * 256 + r]; gv_[q] = ok ? ((const float*)(a.ws + WS_LGATE))[(size_t)e * T + sl] : 0.f; rv_[q] = (unsigned)(pm * 256 + r) * pitch; }
                else { bv_[q] = a.in[17][(size_t)e * 2048 + (r < 128 ? 0 : 1024 - 128) + ct * 128 + r]; rv_[q] = ok ? (unsigned)ltok[(size_t)e * T + sl] * pitch : 0u; } } } }
#pragma unroll
        for (int q = 0; q < 5; ++q) { const int idx = tid + q * NT, i = idx >> 8; if (i < nr) { btab[idx] = bv_[q]; rowtab[idx] = rv_[q]; if (plain) gtab[idx] = gv_[q]; } } }
    __syncthreads();
}
typedef float float2v __attribute__((ext_vector_type(2)));
__device__ __forceinline__ void ph_final(const Args& a, LAS unsigned char* lds, int bid, int nb) {
    const float* hh = a.in[0]; const bf16* dl = (const bf16*)(a.ws + WS_H); const unsigned char* ys = a.ws + WS_YS; const int* toke = (const int*)(a.ws + WS_TOKE); const int* toks = (const int*)(a.ws + WS_TOKS);
    const unsigned* cnt = (const unsigned*)(a.ws + WS_CTL); const float* g = a.in[20]; float* out = a.out;
    LAS int* s_ps = (LAS int*)(lds + TB_PTILE);
    __syncthreads();
    LAS int* s_c = (LAS int*)(lds + TB_CNT); if (threadIdx.x < NE) s_c[threadIdx.x] = (int)cnt[threadIdx.x];
    __syncthreads();
    if (threadIdx.x == 0) { int pt = 0; for (int e = 0; e < NE; ++e) { s_ps[e] = pt; pt += (s_c[e] + 255) >> 8; } }
    __syncthreads();
    const int lane = threadIdx.x & 63, gw = bid * 8 + (threadIdx.x >> 6), ngw = nb * 8;
    size_t myoff = 0; { const int j = lane >> 2, k = lane & 3, r = gw + j * ngw; if (lane < 32 && r < T) myoff = ((size_t)s_ps[toke[r * 4 + k]] * 256 + toks[r * 4 + k]) * 1024; }
    for (int j = 0; gw + j * ngw < T; ++j) { const int r = gw + j * ngw;
        float4 v[4]; int wq[4][4];
        if (j < 8) {
#pragma unroll
            for (int k = 0; k < 4; ++k) { const int li = (j & 7) * 4 + k; const size_t off = ((size_t)(unsigned)__builtin_amdgcn_readlane((int)(unsigned)(myoff >> 32), li) << 32) | (size_t)(unsigned)__builtin_amdgcn_readlane((int)(unsigned)myoff, li);
#pragma unroll
                for (int jj = 0; jj < 4; ++jj) wq[k][jj] = *(const int*)(ys + off + 4 * lane + 256 * jj); } }
        else {
#pragma unroll
            for (int k = 0; k < 4; ++k) { const size_t off = ((size_t)s_ps[toke[r * 4 + k]] * 256 + toks[r * 4 + k]) * 1024;
#pragma unroll
                for (int jj = 0; jj < 4; ++jj) wq[k][jj] = *(const int*)(ys + off + 4 * lane + 256 * jj); } }
#pragma unroll
        for (int jj = 0; jj < 4; ++jj) { v[jj] = *(const float4*)(hh + (size_t)r * DM + 4 * lane + 256 * jj); const uint2 dw = *(const uint2*)(dl + (size_t)r * DM + 4 * lane + 256 * jj);
            v[jj].x += bflo(dw.x); v[jj].y += bfhi(dw.x); v[jj].z += bflo(dw.y); v[jj].w += bfhi(dw.y); }
#pragma unroll
        for (int k = 0; k < 4; ++k)
#pragma unroll
            for (int jj = 0; jj < 4; ++jj) { const int w = wq[k][jj];
                const float2v lo = __builtin_amdgcn_cvt_pk_f32_fp8(w, false), hi = __builtin_amdgcn_cvt_pk_f32_fp8(w, true);
                v[jj].x += lo[0] * (1.f / YS8_SCALE); v[jj].y += lo[1] * (1.f / YS8_SCALE); v[jj].z += hi[0] * (1.f / YS8_SCALE); v[jj].w += hi[1] * (1.f / YS8_SCALE); }
        float s = 0.f;
#pragma unroll
        for (int jj = 0; jj < 4; ++jj) s += v[jj].x * v[jj].x + v[jj].y * v[jj].y + v[jj].z * v[jj].z + v[jj].w * v[jj].w;
        const float rs = rsqrtf(wave_sum(s) * (1.f / DM) + EPS);
#pragma unroll
        for (int jj = 0; jj < 4; ++jj) { const float4 gg = *(const float4*)(g + 4 * lane + 256 * jj);
            *(float4*)(out + (size_t)r * DM + 4 * lane + 256 * jj) = make_float4(v[jj].x * rs * gg.x, v[jj].y * rs * gg.y, v[jj].z * rs * gg.z, v[jj].w * rs * gg.w); }
    }
}

__global__ void __launch_bounds__(NT, 2) mk_fwd(Args args) {
    extern __shared__ __attribute__((aligned(16))) unsigned char smem[];
    LAS unsigned char* lds = (LAS unsigned char*)smem;
    const int tid = threadIdx.x, bid = blockIdx.x, G = gridDim.x;
    unsigned char* ws = args.ws;
    const int lo = args.ph_lo, hi = args.ph_hi;
#define IN(k) (lo <= (k) && (k) < hi)
#define BOTH(k) (IN(k) && IN((k) + 1))
    XcdBarrier bar; bar.bar = (unsigned*)(ws + WS_CTL) + CW_BAR + args.bar_sel * XCD_BAR_WORDS; bar.x = 0; bar.st = nullptr;
    if (MK_ONE_LAUNCH) {
        if (tid < 4) ((volatile LAS unsigned*)(lds + XBW_OFF))[tid] = 0u;
        __syncthreads();
        bar = xcd_barrier_post((unsigned*)(ws + WS_CTL) + CW_BAR + args.bar_sel * XCD_BAR_WORDS, (volatile LAS unsigned*)(lds + XBW_OFF));
    }
#define GRID_BAR() do { if (MK_ONE_LAUNCH) xcd_barrier(bar); } while (0)

    if (IN(0)) { ph_prologue(args, lds, bid, G); if (BOTH(0)) GRID_BAR(); }
    if (IN(1)) {
        const int gp = G > 192 ? 192 : G;
        if (bid < gp) {
            pg8::Gemm g{(const bf16*)(ws + WS_U), (const bf16*)(ws + WS_WIN), T, NP, DM}; pg8::StaticOrder S; S.init(T, NP, gp, bid);
            pg8::EpiStoreBf16 E{(bf16*)(ws + WS_PROJ), NP};
            pg8::gemm_phase<pg8::EpiStoreBf16, pg8::StaticOrder, true, true, false>(lds, g, S, E); }
        __syncthreads();
        moe_weight_queue(args, lds, bid);
        if (BOTH(1)) GRID_BAR();
    }
    if (IN(3)) { ph_ssd_local(args, lds, bid, G); if (BOTH(3)) GRID_BAR(); }
    if (IN(4)) { ph_scan(args, bid, G); if (BOTH(4)) GRID_BAR(); }
    if (IN(5)) { ph_ssd_out(args, lds, bid, G); ph_attn(args, lds, bid, G); if (BOTH(5)) GRID_BAR(); }
    if (IN(7)) {
        __syncthreads();
        pg8::Gemm g{(const bf16*)(ws + WS_CAT), (const bf16*)(ws + WS_WOUT), T, DM, DM}; pg8::StaticOrder S; S.init(T, DM, G, bid);
        LAS float* r1 = (LAS float*)(lds + TAB_OFF); LAS float* r2 = r1 + 256;
        { pg8::Unit u0; if (S.next(0, u0) && tid < 256) { const size_t row = (size_t)u0.pm * 256 + tid; const float* sd = (const float*)(ws + WS_SSSD) + row * 2; const float* sa = (const float*)(ws + WS_SSAT) + row * 8;
            const float s1 = sd[0] + sd[1], s2 = ((sa[0] + sa[1]) + (sa[2] + sa[3])) + ((sa[4] + sa[5]) + (sa[6] + sa[7]));
            r1[tid] = rsqrtf(s1 * (1.f / 512) + EPS); r2[tid] = rsqrtf(s2 * (1.f / 512) + EPS); } }
        __syncthreads();
        pg8::EpiResScale E{(bf16*)(ws + WS_H), DM, r1, r2};
        pg8::gemm_phase<pg8::EpiResScale, pg8::StaticOrder, false, true, false>(lds, g, S, E);
        if (BOTH(7)) GRID_BAR();
    }
    if (IN(8)) { ph_router(args, lds, bid, G); if (BOTH(8)) GRID_BAR(); }
    if (IN(9)) {
        moe_setup(args, lds, 8, G, bid, true, 1024u, false);
        pg8::Gemm g{(const bf16*)(ws + WS_U2), (const bf16*)(ws + WS_W1), MAXROWS, NE * 2048, DM / 2};
        pg8::MoeOrder S{(const LAS int*)(lds + TB_UNITS), (const LAS unsigned*)(lds + TB_ROWTAB), __builtin_amdgcn_readfirstlane(*(const LAS int*)(lds + TB_MISC + 4))};
        pg8::EpiSwiglu E{ws + WS_ACT, (const LAS float*)(lds + 131072), 1.f / W8_SCALE, ACT8_SCALE};
        pg8::gemm_phase<pg8::EpiSwiglu, pg8::MoeOrder, true, true, true, true>(lds, g, S, E);
        if (BOTH(9)) GRID_BAR();
    }
    if (IN(10)) {
        moe_setup(args, lds, 4, G, bid, true, 1024u, true);
        pg8::Gemm g{(const bf16*)(ws + WS_ACT), (const bf16*)(ws + WS_W2), MAXROWS, NE * 1024, DM / 2};
        pg8::MoeOrder S{(const LAS int*)(lds + TB_UNITS), (const LAS unsigned*)(lds + TB_ROWTAB), __builtin_amdgcn_readfirstlane(*(const LAS int*)(lds + TB_MISC + 4))};
        pg8::EpiMoe2 E{ws + WS_YS, (const LAS float*)(lds + 131072), (const LAS float*)(lds + 131072) + 5 * 256, 1.f / (W8_SCALE * ACT8_SCALE), YS8_SCALE};
        pg8::gemm_phase<pg8::EpiMoe2, pg8::MoeOrder, true, true, true, true>(lds, g, S, E);
        if (BOTH(10)) GRID_BAR();
    }
    if (IN(11)) { ph_final(args, lds, bid, G); }
#undef IN
#undef BOTH
}

extern "C" void kernel_launch(void* const* d_in, const int* in_sizes, int n_in, void* d_out, int out_size, void* d_ws, size_t ws_size, hipStream_t stream) {
    static int grid = 0;
    if (grid == 0) {
        if (n_in != 21 || out_size != T * DM || ws_size < WS_END) { fprintf(stderr, "kernel_launch: unexpected shapes (n_in %d out %d ws %zu)\n", n_in, out_size, ws_size); grid = -1; return; }
        int dev = 0, cus = 0, per_cu = 0;
        if (hipGetDevice(&dev) != hipSuccess || hipDeviceGetAttribute(&cus, hipDeviceAttributeMultiprocessorCount, dev) != hipSuccess) { grid = -1; return; }
        if (hipFuncSetAttribute((const void*)mk_fwd, hipFuncAttributeMaxDynamicSharedMemorySize, LDS_BYTES) != hipSuccess) { fprintf(stderr, "kernel_launch: hipFuncSetAttribute failed\n"); grid = -1; return; }
        if (hipOccupancyMaxActiveBlocksPerMultiprocessor(&per_cu, (const void*)mk_fwd, NT, LDS_BYTES) != hipSuccess || per_cu < 1) { fprintf(stderr, "kernel_launch: occupancy query says %d blocks per CU\n", per_cu); }
        (void)hipGetLastError();
        grid = cus;
    }
    if (grid < 0) return;
    if (hipMemsetAsync((char*)d_ws + WS_CTL, 0, 65536, stream) != hipSuccess) return;
    Args a{};
    for (int i = 0; i < 21; ++i) a.in[i] = (const float*)d_in[i];
    a.out = (float*)d_out; a.ws = (unsigned char*)d_ws;
#if MK_ONE_LAUNCH
    a.ph_lo = 0; a.ph_hi = NPH;
    hipLaunchKernelGGL(mk_fwd, dim3(grid), dim3(NT), LDS_BYTES, stream, a);
#if defined(PROBE_LO)
    a.ph_lo = PROBE_LO; a.ph_hi = PROBE_HI; a.bar_sel = 1;
    hipLaunchKernelGGL(mk_fwd, dim3(grid), dim3(NT), LDS_BYTES, stream, a);
#endif
#if defined(PROBE_LO2)
    a.ph_lo = PROBE_LO2; a.ph_hi = PROBE_HI2; a.bar_sel = 2;
    hipLaunchKernelGGL(mk_fwd, dim3(grid), dim3(NT), LDS_BYTES, stream, a);
#endif
#else
    for (int ph = 0; ph < NPH; ++ph) { a.ph_lo = ph; a.ph_hi = ph + 1; hipLaunchKernelGGL(mk_fwd, dim3(grid), dim3(NT), LDS_BYTES, stream, a); }
#endif
}
```

```cpp
#include <hip/hip_runtime.h>
#include <cstdio>
#include <cstdint>

#ifndef MK_ONE_LAUNCH
#define MK_ONE_LAUNCH 1
#endif

constexpr int BATCH = 8, SEQ = 2048, T = BATCH * SEQ, DM = 1024, DPROJ = 2312;
constexpr int NCH = SEQ / 128;
constexpr int NE = 32, TOPK = 4;
constexpr int O_DT = 1536;
constexpr int NP = 2304;
constexpr int PZ = 0, PXBC = 512, PQ = 1536, PK = 2048, PV = 2176;
constexpr float EPS = 1e-5f;
constexpr int NT = 512;
constexpr int MAXROWS = T * TOPK + NE * 256;
constexpr int NPH = 12;

__constant__ int c_bucket[129] = {0, 1, 2, 3, 4, 5, 6, 7, 8, 9, 10, 11, 12, 13, 14, 15, 16, 16, 16, 17, 17, 18, 18, 18, 19, 19, 19, 20, 20, 20, 20, 21, 21, 21, 21, 22, 22, 22, 22, 22, 23, 23, 23, 23, 23, 23, 24, 24, 24, 24, 24, 24, 25, 25, 25, 25, 25, 25, 25, 26, 26, 26, 26, 26, 26, 26, 26, 27, 27, 27, 27, 27, 27, 27, 27, 27, 27, 28, 28, 28, 28, 28, 28, 28, 28, 28, 28, 29, 29, 29, 29, 29, 29, 29, 29, 29, 29, 29, 29, 30, 30, 30, 30, 30, 30, 30, 30, 30, 30, 30, 30, 30, 30, 31, 31, 31, 31, 31, 31, 31, 31, 31, 31, 31, 31, 31, 31, 31, 31};

constexpr size_t MiB = 1ull << 20;
constexpr size_t WS_CTL = 0, CTL_ZERO_BYTES = 1 * MiB;
constexpr int CW_BAR = 4096;
static_assert((CW_BAR + 3 * 3456) * 4 <= 65536, "control words inside the per-call memset");
constexpr size_t WS_WIN = 1 * MiB;
constexpr size_t WS_WOUT = WS_WIN + (size_t)NP * DM * 2;
constexpr size_t WS_W1 = WS_WOUT + (size_t)DM * DM * 2;
constexpr size_t WS_W2 = WS_W1 + (size_t)NE * 2048 * 1024 * 2;
constexpr size_t WS_U = WS_W2 + (size_t)NE * 1024 * 1024 * 2;
constexpr size_t WS_DTRAW = WS_U + (size_t)T * DM * 2;
constexpr size_t WS_PROJ = WS_DTRAW + (size_t)T * 8 * 4;
constexpr size_t WS_XC = WS_PROJ + (size_t)T * NP * 2;
constexpr size_t WS_DT = WS_XC + (size_t)T * 1024 * 4;
constexpr size_t WS_ACUM = WS_DT + (size_t)T * 8 * 4;
constexpr size_t WS_CDEC = WS_ACUM + (size_t)T * 8 * 4;
constexpr size_t WS_STATES = WS_CDEC + 1 * MiB;
constexpr size_t WS_PREV = WS_STATES + (size_t)BATCH * NCH * 8 * 8192 * 4;
constexpr size_t WS_YG = WS_PREV + (size_t)BATCH * NCH * 8 * 8192 * 4;
constexpr size_t WS_YGB = WS_YG;
constexpr size_t WS_SSSD = WS_YG + (size_t)T * 512 * 2;
constexpr size_t WS_AO = WS_YG + (size_t)T * 512 * 4;
constexpr size_t WS_SSAT = WS_AO + (size_t)T * 512 * 2;
constexpr size_t WS_CAT = WS_SSAT + (size_t)T * 8 * 4;
constexpr size_t WS_H = WS_CAT + (size_t)T * DM * 2;
constexpr size_t WS_U2 = WS_H + (size_t)T * DM * 4;
constexpr size_t WS_TOKE = WS_U2 + (size_t)T * DM * 2;
constexpr size_t WS_TOKS = WS_TOKE + (size_t)T * 4 * 4;
constexpr size_t WS_LTOK = WS_TOKS + (size_t)T * 4 * 4;
constexpr size_t WS_LGATE = WS_LTOK + (size_t)NE * T * 4;
constexpr size_t WS_ACT = WS_LGATE + (size_t)NE * T * 4;
constexpr size_t WS_YS = WS_ACT + (size_t)MAXROWS * 1024 * 2;
constexpr size_t WS_END = WS_YS + (size_t)MAXROWS * 1024 * 2;
static_assert(WS_END <= 1024 * MiB, "workspace");

constexpr int SCR_BYTES = 143360;
constexpr int TAB_OFF = SCR_BYTES;
constexpr int TB_CNT = TAB_OFF, TB_PTILE = TAB_OFF + 128, TB_RE = TAB_OFF + 272, TB_TSTART = TAB_OFF + 400, TB_MISC = TAB_OFF + 544, TB_UNITS = TAB_OFF + 576, TB_ROWTAB = TAB_OFF + 1024;
constexpr int XBW_OFF = TB_ROWTAB + 9 * 256 * 4;
constexpr int LDS_BYTES = 163840;
static_assert(XBW_OFF + 16 <= LDS_BYTES && XBW_OFF % 16 == 0, "LDS map");

#define GAS __attribute__((address_space(1)))
#define LAS __attribute__((address_space(3)))
typedef unsigned short bf16;
typedef unsigned v4u __attribute__((ext_vector_type(4)));
#define LDS_WAIT() asm volatile("s_waitcnt lgkmcnt(0)" ::: "memory")
#define VM_WAIT() asm volatile("s_waitcnt vmcnt(0)" ::: "memory")
__device__ __forceinline__ unsigned f2bf(float f) { unsigned u = __builtin_bit_cast(unsigned, f); return (u + 0x7fffu + ((u >> 16) & 1u)) >> 16; }
__device__ __forceinline__ unsigned pk2(float lo, float hi) { return f2bf(lo) | (f2bf(hi) << 16); }
__device__ __forceinline__ float bf2f(unsigned short b) { return __uint_as_float((unsigned)b << 16); }
__device__ __forceinline__ float bflo(unsigned w) { return __uint_as_float(w << 16); }
__device__ __forceinline__ float bfhi(unsigned w) { return __uint_as_float(w & 0xffff0000u); }

namespace pg8 {
#define PG8_LAS __attribute__((address_space(3)))
typedef unsigned short bf16_t;
typedef short bf16x8 __attribute__((ext_vector_type(8)));
typedef float f32x4 __attribute__((ext_vector_type(4)));
typedef unsigned u32x4 __attribute__((ext_vector_type(4)));
typedef unsigned u32x2 __attribute__((ext_vector_type(2)));
typedef int i32x8 __attribute__((ext_vector_type(8)));
typedef int i32x4 __attribute__((ext_vector_type(4)));
constexpr int BM = 256, BK = 64, HALF = 128, HTB = HALF * BK * 2  , STAGE_BYTES = 8 * HTB, NXCD = 8, WGM = 8;

__host__ __device__ __forceinline__ int lds_byte(int r, int c) { const int st = (r >> 4) * 2 + (c >> 5), rr = r & 15, cc = c & 31, ob = rr * 64 + cc * 2; return st * 1024 + (ob ^ (((ob >> 9) & 1) << 5)); }
__host__ __device__ __forceinline__ void stage_rc(int b, int& R, int& C) { const int st = b / 1024, sb = b % 1024, swz = sb ^ (((sb >> 9) & 1) << 5); R = (st >> 1) * 16 + swz / 64; C = (st & 1) * 32 + (swz % 64) / 2; }
__host__ __device__ __forceinline__ int perm32(int rho) { const int n = rho >> 4, i = rho & 15; return 8 * (i >> 2) + 4 * n + (i & 3); }

struct Unit { int pm, pn, rid; };
struct Gemm { const bf16_t* A; const bf16_t* Bt; int M, N, K; };

struct StaticOrder {
    int nM, nN, nwg, G, c;
    __host__ __device__ __forceinline__ void init(int M, int N, int G_, int c_) { nM = M / BM; nN = N / BM; nwg = nM * nN; G = G_; c = c_; }
    __host__ __device__ __forceinline__ bool next(int i, Unit& u) const {
        const long L = (long)i * G + c; if (L >= nwg) return false;
        int wgid = (int)L; { const int q = nwg / NXCD, r = nwg % NXCD, xcd = wgid % NXCD, off = wgid / NXCD; wgid = (xcd < r ? xcd * (q + 1) : r * (q + 1) + (xcd - r) * q) + off; }
        const int nig = WGM * nN, gid = wgid / nig, fm = gid * WGM, gsz = (nM - fm) < WGM ? (nM - fm) : WGM;
        u.pm = fm + ((wgid % nig) % gsz); u.pn = (wgid % nig) / gsz; u.rid = 0; return true;
    }
    __device__ __forceinline__ void a_ready(const Unit&) const {}
    __device__ __forceinline__ void done(const Unit&) const {}
};


typedef float f32x2 __attribute__((ext_vector_type(2)));
__device__ __forceinline__ unsigned cvt_pk_bf16(float lo, float hi) { unsigned r; asm volatile("v_cvt_pk_bf16_f32 %0, %1, %2" : "=v"(r) : "v"(lo), "v"(hi)); return r; }

struct EpiStoreBf16 {
    static constexpr bool PERM = true, AFTER_DRAIN = false, HAS_MID = false;
    bf16_t* O; int ldc;
    __device__ __forceinline__ void operator()(const f32x4 (&acc)[2][2][4][2], const Unit& u, int wr, int wc, int fr, int fq) const {
        const int row0 = u.pm * BM + wr * 64 + fr, col0 = u.pn * BM + wc * 32 + 8 * fq;
#pragma unroll
        for (int ai = 0; ai < 2; ++ai)
#pragma unroll
            for (int m = 0; m < 4; ++m) { bf16_t* rowp = O + (size_t)(row0 + ai * HALF + m * 16) * ldc + col0;
#pragma unroll
                for (int bj = 0; bj < 2; ++bj) { const f32x4 v0 = acc[ai][bj][m][0], v1 = acc[ai][bj][m][1];
                    u32x4 w; w.x = cvt_pk_bf16(v0[0], v0[1]); w.y = cvt_pk_bf16(v0[2], v0[3]); w.z = cvt_pk_bf16(v1[0], v1[1]); w.w = cvt_pk_bf16(v1[2], v1[3]);
                    *(u32x4*)(rowp + bj * HALF) = w; } }
    }
};
struct EpiResF32 {
    static constexpr bool PERM = false, AFTER_DRAIN = false, HAS_MID = false;
    const float* __restrict__ base; float* __restrict__ C; int ldc;
    __device__ __forceinline__ void operator()(const f32x4 (&acc)[2][2][4][2], const Unit& u, int wr, int wc, int fr, int fq) const {
        const int row0 = u.pm * BM + wr * 64 + fr, col0 = u.pn * BM + wc * 32 + 4 * fq;
#pragma unroll
        for (int ai = 0; ai < 2; ++ai)
#pragma unroll
            for (int m = 0; m < 4; ++m) { const size_t off = (size_t)(row0 + ai * HALF + m * 16) * ldc + col0; f32x4 bs[2][2];
#pragma unroll
                for (int bj = 0; bj < 2; ++bj)
#pragma unroll
                    for (int n = 0; n < 2; ++n) bs[bj][n] = __builtin_nontemporal_load((const f32x4*)(base + off + bj * HALF + n * 16));
#pragma unroll
                for (int bj = 0; bj < 2; ++bj)
#pragma unroll
                    for (int n = 0; n < 2; ++n) *(f32x4*)(C + off + bj * HALF + n * 16) = bs[bj][n] + acc[ai][bj][m][n]; }
    }
};
struct EpiResScale {
    static constexpr bool PERM = true, AFTER_DRAIN = false, HAS_MID = true;
    bf16_t* D; int ldc; const PG8_LAS float* r1; const PG8_LAS float* r2;
    __device__ __forceinline__ void mid(f32x4 (&acc)[2][2][4][2], const Unit&, int wr, int, int fr, int) const {
#pragma unroll
        for (int ai = 0; ai < 2; ++ai)
#pragma unroll
            for (int m = 0; m < 4; ++m) { const int rl = ai * HALF + wr * 64 + m * 16 + fr; const float f = r1[rl] / r2[rl];
#pragma unroll
                for (int bj = 0; bj < 2; ++bj)
#pragma unroll
                    for (int n = 0; n < 2; ++n) acc[ai][bj][m][n] *= f; }
    }
    __device__ __forceinline__ void operator()(const f32x4 (&acc)[2][2][4][2], const Unit& u, int wr, int wc, int fr, int fq) const {
        const int row0 = u.pm * BM + wr * 64 + fr, col0 = u.pn * BM + wc * 32 + 8 * fq;
#pragma unroll
        for (int ai = 0; ai < 2; ++ai)
#pragma unroll
            for (int m = 0; m < 4; ++m) { bf16_t* rowp = D + (size_t)(row0 + ai * HALF + m * 16) * ldc + col0; const float f = r2[ai * HALF + wr * 64 + m * 16 + fr];
#pragma unroll
                for (int bj = 0; bj < 2; ++bj) { const f32x4 v0 = acc[ai][bj][m][0] * f, v1 = acc[ai][bj][m][1] * f;
                    u32x4 w; w.x = cvt_pk_bf16(v0[0], v0[1]); w.y = cvt_pk_bf16(v0[2], v0[3]); w.z = cvt_pk_bf16(v1[0], v1[1]); w.w = cvt_pk_bf16(v1[2], v1[3]);
                    *(u32x4*)(rowp + bj * HALF) = w; } }
    }
};
struct EpiSwiglu {
    static constexpr bool PERM = true, AFTER_DRAIN = false, HAS_MID = false;
    unsigned char* act; const PG8_LAS float* btab; float dq, asc;
    __device__ __forceinline__ void operator()(const f32x4 (&acc)[2][2][4][2], const Unit& u, int wr, int wc, int fr, int fq) const {
        const int e = u.pn >> 3, ct = u.pn & 7, colo = ct * 128 + wc * 32 + 8 * fq;
        const PG8_LAS float* bg = btab + u.rid * 256 + wc * 32 + 8 * fq; (void)e;
        const f32x4 g0 = *(const PG8_LAS f32x4*)bg, g1 = *(const PG8_LAS f32x4*)(bg + 4), l0 = *(const PG8_LAS f32x4*)(bg + 128), l1 = *(const PG8_LAS f32x4*)(bg + 132);
        const int row0 = u.pm * BM + wr * 64 + fr;
#pragma unroll
        for (int ai = 0; ai < 2; ++ai)
#pragma unroll
            for (int m = 0; m < 4; ++m) {
                const f32x4 xg[2] = {acc[ai][0][m][0] * dq + g0, acc[ai][0][m][1] * dq + g1}; const f32x4 xl[2] = {acc[ai][1][m][0] * dq + l0, acc[ai][1][m][1] * dq + l1};
                float o[8];
#pragma unroll
                for (int q = 0; q < 4; ++q) {
                    f32x2 a2 = {xg[q >> 1][2 * (q & 1)], xg[q >> 1][2 * (q & 1) + 1]}, b2 = {xl[q >> 1][2 * (q & 1)], xl[q >> 1][2 * (q & 1) + 1]};
                    a2 = __builtin_elementwise_min(a2, (f32x2){7.f, 7.f}); b2 = __builtin_elementwise_min(__builtin_elementwise_max(b2, (f32x2){-7.f, -7.f}), (f32x2){7.f, 7.f});
                    const f32x2 t2 = a2 * (-1.702f * 1.4426950408889634f); f32x2 e2; e2.x = __builtin_amdgcn_exp2f(t2.x); e2.y = __builtin_amdgcn_exp2f(t2.y);
                    const f32x2 d2 = e2 + 1.f; f32x2 r2; r2.x = __builtin_amdgcn_rcpf(d2.x); r2.y = __builtin_amdgcn_rcpf(d2.y);
                    const f32x2 o2 = (a2 * r2) * (b2 * asc + asc); o[2 * q] = o2.x; o[2 * q + 1] = o2.y; }
                int w0 = 0, w1 = 0; w0 = __builtin_amdgcn_cvt_pk_fp8_f32(o[0], o[1], w0, false); w0 = __builtin_amdgcn_cvt_pk_fp8_f32(o[2], o[3], w0, true);
                w1 = __builtin_amdgcn_cvt_pk_fp8_f32(o[4], o[5], w1, false); w1 = __builtin_amdgcn_cvt_pk_fp8_f32(o[6], o[7], w1, true);
                u32x2 w; w.x = (unsigned)w0; w.y = (unsigned)w1;
                *(u32x2*)(act + (size_t)(row0 + ai * HALF + m * 16) * 1024 + colo) = w; }
    }
};
struct EpiMoe2 {
    static constexpr bool PERM = true, AFTER_DRAIN = false, HAS_MID = false;
    unsigned char* ys; const PG8_LAS float* btab; const PG8_LAS float* gtab; float dq, ysc;
    __device__ __forceinline__ void operator()(const f32x4 (&acc)[2][2][4][2], const Unit& u, int wr, int wc, int fr, int fq) const {
        const int e = u.pn >> 2, ct = u.pn & 3, colb = ct * 256 + wc * 32 + 8 * fq;
        (void)e;
        f32x4 bv[2][2];
#pragma unroll
        for (int bj = 0; bj < 2; ++bj)
#pragma unroll
            for (int n = 0; n < 2; ++n) bv[bj][n] = *(const PG8_LAS f32x4*)(btab + u.rid * 256 + bj * HALF + wc * 32 + 8 * fq + 4 * n);
        const int row0 = u.pm * BM + wr * 64 + fr;
#pragma unroll
        for (int ai = 0; ai < 2; ++ai)
#pragma unroll
            for (int m = 0; m < 4; ++m) { const float gt = gtab[u.rid * 256 + ai * HALF + wr * 64 + m * 16 + fr] * ysc;
                unsigned char* rowp = ys + (size_t)(row0 + ai * HALF + m * 16) * 1024 + colb;
#pragma unroll
                for (int bj = 0; bj < 2; ++bj) { f32x4 v0 = (acc[ai][bj][m][0] * dq + bv[bj][0]) * gt, v1 = (acc[ai][bj][m][1] * dq + bv[bj][1]) * gt;
                    v0 = __builtin_elementwise_min(__builtin_elementwise_max(v0, (f32x4){-440.f, -440.f, -440.f, -440.f}), (f32x4){440.f, 440.f, 440.f, 440.f});
                    v1 = __builtin_elementwise_min(__builtin_elementwise_max(v1, (f32x4){-440.f, -440.f, -440.f, -440.f}), (f32x4){440.f, 440.f, 440.f, 440.f});
                    int w0 = 0, w1 = 0; w0 = __builtin_amdgcn_cvt_pk_fp8_f32(v0[0], v0[1], w0, false); w0 = __builtin_amdgcn_cvt_pk_fp8_f32(v0[2], v0[3], w0, true);
                    w1 = __builtin_amdgcn_cvt_pk_fp8_f32(v1[0], v1[1], w1, false); w1 = __builtin_amdgcn_cvt_pk_fp8_f32(v1[2], v1[3], w1, true);
                    u32x2 w; w.x = (unsigned)w0; w.y = (unsigned)w1; *(u32x2*)(rowp + bj * HALF) = w; } }
    }
};
struct MoeOrder {
    const PG8_LAS int* units; const PG8_LAS unsigned* rowtab; int nr;
    __device__ __forceinline__ bool next(int i, Unit& u) const {
        if (i >= nr) return false;
        const int pm = __builtin_amdgcn_readfirstlane(units[2 * i]); if (pm < 0) return false;
        u.pm = pm; u.pn = __builtin_amdgcn_readfirstlane(units[2 * i + 1]); u.rid = i; return true;
    }
    __device__ __forceinline__ unsigned arow(const Unit& u, int r) const { return rowtab[u.rid * 256 + r]; }
    __device__ __forceinline__ void a_ready(const Unit&) const {}
    __device__ __forceinline__ void done(const Unit&) const {}
};

template <class Epi, class Sched, bool ALIGN_EPI = false, bool SP2 = false, bool GATHER = false, bool FP8 = false>
__device__ __forceinline__ void gemm_phase(PG8_LAS unsigned char* lds, const Gemm g, const Sched& S, const Epi& E) {
    const int tid = threadIdx.x, wid = __builtin_amdgcn_readfirstlane(tid >> 6), lane = tid & 63, wr = wid >> 2, wc = wid & 3, fr = lane & 15, fq = lane >> 4;
    const int K = g.K, nt = K / BK;
    unsigned voffA[2], voffB[2];
#pragma unroll
    for (int i = 0; i < 2; ++i) { int R, C; stage_rc(tid * 16 + i * 8192, R, C); const int Rb = Epi::PERM ? ((R & ~31) + perm32(R & 31)) : R;
        voffA[i] = (unsigned)(R * K + C) * 2u; voffB[i] = (unsigned)(Rb * K + C) * 2u; }
    const size_t kstep = (size_t)(BK * 2);
    const size_t hstep = (size_t)HALF * K * 2;
    const size_t tstep = 2 * hstep;
    const unsigned ldsw = (unsigned)wid * 1024u;
    const int aoff = lds_byte(wr * 64 + fr, fq * 8), boff = lds_byte(wc * 32 + fr, fq * 8);
#define PG8_SA(b, h) (((b) * 2 + (h)) * HTB)
#define PG8_SB(b, h) ((4 + (b) * 2 + (h)) * HTB)
#define PG8_STAGE(bufoff, gbase, voff) do { _Pragma("unroll") for (int _i = 0; _i < 2; ++_i) \
        __builtin_amdgcn_global_load_lds((const unsigned*)((const char*)(gbase) + (voff)[_i]), (PG8_LAS unsigned*)(lds + (bufoff) + ldsw + _i * 8192), 16, 0, 0); } while (0)
#define PG8_STAGE_A(b, h, U, koff) do { if constexpr (GATHER) { PG8_STAGE(PG8_SA(b, h), Ab + (koff), c_ao[h]); } else { PG8_STAGE(PG8_SA(b, h), U##_A + (size_t)(h) * hstep + (koff), voffA); } } while (0)
#define PG8_LDA(dst, b, h) do { _Pragma("unroll") for (int m = 0; m < 4; ++m) _Pragma("unroll") for (int k = 0; k < 2; ++k) dst[m][k] = *(const PG8_LAS bf16x8*)(lds + PG8_SA(b, h) + aoff + m * 2048 + k * 1024); } while (0)
#define PG8_LDB(dst, b, h) do { _Pragma("unroll") for (int n = 0; n < 2; ++n) _Pragma("unroll") for (int k = 0; k < 2; ++k) dst[n][k] = *(const PG8_LAS bf16x8*)(lds + PG8_SB(b, h) + boff + n * 2048 + k * 1024); } while (0)
#define PG8_MMA(ai, bj, At, Bt) do { __builtin_amdgcn_s_setprio(1); _Pragma("unroll") for (int m = 0; m < 4; ++m) _Pragma("unroll") for (int n = 0; n < 2; ++n) { \
        if constexpr (FP8) { const i32x8 ub_ = __builtin_shufflevector(__builtin_bit_cast(i32x4, Bt[n][0]), __builtin_bit_cast(i32x4, Bt[n][1]), 0, 1, 2, 3, 4, 5, 6, 7); \
            const i32x8 ua_ = __builtin_shufflevector(__builtin_bit_cast(i32x4, At[m][0]), __builtin_bit_cast(i32x4, At[m][1]), 0, 1, 2, 3, 4, 5, 6, 7); \
            acc[ai][bj][m][n] = __builtin_amdgcn_mfma_scale_f32_16x16x128_f8f6f4(ub_, ua_, acc[ai][bj][m][n], 0, 0, 0, 0x7f7f7f7f, 0, 0x7f7f7f7f); } \
        else { _Pragma("unroll") for (int k = 0; k < 2; ++k) acc[ai][bj][m][n] = __builtin_amdgcn_mfma_f32_16x16x32_bf16(Bt[n][k], At[m][k], acc[ai][bj][m][n], 0, 0, 0); } } \
        __builtin_amdgcn_s_setprio(0); } while (0)
#define PG8_WAIT_V(n) asm volatile("s_waitcnt vmcnt(" #n ")" ::: "memory")
#define PG8_WAIT_L(n) asm volatile("s_waitcnt lgkmcnt(" #n ")" ::: "memory")
#define PG8_BAR __builtin_amdgcn_s_barrier()
#define PG8_SCHED __builtin_amdgcn_sched_barrier(0)
    Unit cur, nxt; int ui = 0;
    if (!S.next(0, cur)) return;
    f32x4 acc[2][2][4][2];
#pragma unroll
    for (int a = 0; a < 2; ++a)
#pragma unroll
        for (int b = 0; b < 2; ++b)
#pragma unroll
            for (int m = 0; m < 4; ++m)
#pragma unroll
                for (int n = 0; n < 2; ++n) acc[a][b][m][n] = (f32x4){0.f, 0.f, 0.f, 0.f};
    bf16x8 At[4][2], B0[2][2], B1[2][2];
    const char* const Ab = (const char*)g.A; (void)Ab;
    unsigned c_ao[2][2] = {{0u, 0u}, {0u, 0u}}; (void)c_ao;
    int RA0, CA0; stage_rc(tid * 16, RA0, CA0);
    const char* c_A = (const char*)g.A + (size_t)cur.pm * tstep; const char* cB = (const char*)g.Bt + (size_t)cur.pn * tstep;
    if constexpr (GATHER) { _Pragma("unroll") for (int h_ = 0; h_ < 2; ++h_) _Pragma("unroll") for (int i_ = 0; i_ < 2; ++i_) c_ao[h_][i_] = S.arow(cur, h_ * HALF + RA0 + i_ * 64) + (unsigned)CA0 * 2u; }
    S.a_ready(cur);
    if constexpr (SP2) {
        PG8_STAGE(PG8_SB(0, 0), cB, voffB); PG8_STAGE(PG8_SB(0, 1), cB + hstep, voffB); PG8_STAGE_A(0, 0, c, (size_t)0); PG8_STAGE_A(0, 1, c, (size_t)0);
        if (wr == 1) PG8_BAR;
        PG8_WAIT_V(2); PG8_BAR;
        PG8_STAGE(PG8_SB(1, 0), cB + kstep, voffB); PG8_STAGE_A(1, 0, c, kstep); PG8_STAGE(PG8_SB(1, 1), cB + hstep + kstep, voffB);
        PG8_WAIT_V(6); PG8_BAR;
    } else {
        PG8_STAGE(PG8_SB(0, 0), cB, voffB); PG8_STAGE_A(0, 0, c, (size_t)0); PG8_STAGE(PG8_SB(0, 1), cB + hstep, voffB); PG8_STAGE_A(0, 1, c, (size_t)0);
        if (wr == 1) PG8_BAR;
        PG8_WAIT_V(4); PG8_BAR;
        PG8_STAGE(PG8_SB(1, 0), cB + kstep, voffB); PG8_STAGE_A(1, 0, c, kstep); PG8_STAGE(PG8_SB(1, 1), cB + hstep + kstep, voffB);
        PG8_WAIT_V(6); PG8_BAR;
    }
    for (;;) {
        const bool has_next = S.next(ui + 1, nxt);
        const char* n_A = has_next ? (const char*)g.A + (size_t)nxt.pm * tstep : c_A; const char* nB = has_next ? (const char*)g.Bt + (size_t)nxt.pn * tstep : cB;
#pragma unroll 1
        for (int t = 0; t < nt; t += 2) {
            const bool last = (t == nt - 2);
            if constexpr (Epi::HAS_MID) { if (t == (nt >> 1)) E.mid(acc, cur, wr, wc, fr, fq); }
            const char* s_A = last ? n_A : c_A; const size_t k2 = last ? (size_t)0 : (size_t)(t + 2) * kstep; const char* b2 = last ? nB : cB + (size_t)(t + 2) * kstep;
            const char* b3 = b2 + kstep; (void)s_A;
            if (last && has_next) S.a_ready(nxt);
            if constexpr (SP2) {
            PG8_LDB(B0, 0, 0); PG8_LDB(B1, 0, 1); PG8_SCHED; PG8_LDA(At, 0, 0); PG8_STAGE_A(1, 1, c, (size_t)(t + 1) * kstep); if constexpr (GATHER) { if (last && has_next) { _Pragma("unroll") for (int h_ = 0; h_ < 2; ++h_) _Pragma("unroll") for (int i_ = 0; i_ < 2; ++i_) c_ao[h_][i_] = S.arow(nxt, h_ * HALF + RA0 + i_ * 64) + (unsigned)CA0 * 2u; } }
            PG8_WAIT_V(8); PG8_WAIT_L(0); PG8_BAR; PG8_MMA(0, 0, At, B0); PG8_MMA(0, 1, At, B1); PG8_BAR; PG8_SCHED;
            PG8_LDA(At, 0, 1); PG8_STAGE(PG8_SB(0, 0), b2, voffB); PG8_STAGE(PG8_SB(0, 1), b2 + hstep, voffB); PG8_STAGE_A(0, 0, s, k2);
            PG8_WAIT_V(8); PG8_WAIT_L(0); PG8_BAR; PG8_MMA(1, 0, At, B0); PG8_MMA(1, 1, At, B1); PG8_BAR; PG8_SCHED;
            PG8_LDB(B0, 1, 0); PG8_LDB(B1, 1, 1); PG8_SCHED; PG8_LDA(At, 1, 0); PG8_STAGE_A(0, 1, s, k2);
            PG8_WAIT_V(8); PG8_WAIT_L(0); PG8_BAR; PG8_MMA(0, 0, At, B0); PG8_MMA(0, 1, At, B1); PG8_BAR; PG8_SCHED;
            PG8_LDA(At, 1, 1); PG8_STAGE(PG8_SB(1, 0), b3, voffB); PG8_STAGE(PG8_SB(1, 1), b3 + hstep, voffB); PG8_STAGE_A(1, 0, s, k2 + kstep);
            PG8_WAIT_V(8); PG8_WAIT_L(0); PG8_BAR; PG8_MMA(1, 0, At, B0); PG8_MMA(1, 1, At, B1); PG8_BAR; PG8_SCHED;
            } else {
            PG8_LDB(B0, 0, 0); PG8_SCHED; PG8_LDA(At, 0, 0); PG8_STAGE_A(1, 1, c, (size_t)(t + 1) * kstep); if constexpr (GATHER) { if (last && has_next) { _Pragma("unroll") for (int h_ = 0; h_ < 2; ++h_) _Pragma("unroll") for (int i_ = 0; i_ < 2; ++i_) c_ao[h_][i_] = S.arow(nxt, h_ * HALF + RA0 + i_ * 64) + (unsigned)CA0 * 2u; } }
            PG8_WAIT_L(8); PG8_BAR; PG8_WAIT_L(0); PG8_MMA(0, 0, At, B0); PG8_BAR; PG8_SCHED;
            PG8_LDB(B1, 0, 1); PG8_STAGE(PG8_SB(0, 0), b2, voffB);
            PG8_BAR; PG8_WAIT_L(0); PG8_MMA(0, 1, At, B1); PG8_BAR;
            PG8_LDA(At, 0, 1); PG8_STAGE_A(0, 0, s, k2);
            PG8_BAR; PG8_WAIT_L(0); PG8_MMA(1, 0, At, B0); PG8_BAR; PG8_SCHED;
            PG8_STAGE(PG8_SB(0, 1), b2 + hstep, voffB);
            PG8_WAIT_V(6); PG8_BAR; PG8_MMA(1, 1, At, B1); PG8_BAR;
            PG8_LDB(B0, 1, 0); PG8_SCHED; PG8_LDA(At, 1, 0); PG8_STAGE_A(0, 1, s, k2);
            PG8_WAIT_L(8); PG8_BAR; PG8_WAIT_L(0); PG8_MMA(0, 0, At, B0); PG8_BAR; PG8_SCHED;
            PG8_LDB(B1, 1, 1); PG8_STAGE(PG8_SB(1, 0), b3, voffB);
            PG8_BAR; PG8_WAIT_L(0); PG8_MMA(0, 1, At, B1); PG8_BAR;
            PG8_LDA(At, 1, 1); PG8_STAGE_A(1, 0, s, k2 + kstep);
            PG8_BAR; PG8_WAIT_L(0); PG8_MMA(1, 0, At, B0); PG8_BAR; PG8_SCHED;
            PG8_STAGE(PG8_SB(1, 1), b3 + hstep, voffB);
            PG8_WAIT_V(6); PG8_BAR; PG8_MMA(1, 1, At, B1); PG8_BAR;
            }
        }
        if constexpr (ALIGN_EPI) { if (wr == 0) PG8_BAR; }
        if constexpr (!Epi::AFTER_DRAIN) { E(acc, cur, wr, wc, fr, fq); S.done(cur); }
        if (!has_next) break;
#pragma unroll
        for (int a = 0; a < 2; ++a)
#pragma unroll
            for (int b = 0; b < 2; ++b)
#pragma unroll
                for (int m = 0; m < 4; ++m)
#pragma unroll
                    for (int n = 0; n < 2; ++n) acc[a][b][m][n] = (f32x4){0.f, 0.f, 0.f, 0.f};
        cur = nxt; c_A = n_A; cB = nB; ++ui;
        if constexpr (ALIGN_EPI) { if (wr == 1) PG8_BAR; }
    }
    PG8_WAIT_V(0);
    if constexpr (!ALIGN_EPI) { if (wr == 0) PG8_BAR; }
    PG8_BAR;
    if constexpr (Epi::AFTER_DRAIN) { E.fused(acc, cur, wr, wc, fr, fq, lds, wid, lane); S.done(cur); }
#undef PG8_SA
#undef PG8_SB
#undef PG8_STAGE
#undef PG8_STAGE_A
#undef PG8_LDA
#undef PG8_LDB
#undef PG8_MMA
#undef PG8_WAIT_V
#undef PG8_WAIT_L
#undef PG8_BAR
#undef PG8_SCHED
}
}

#define XB_TMO      128
#define XB_XCNT(j)  (256  + 64 * (j))
#define XB_XSUB(j)  (1280 + 64 * (j))
#define XB_XGEN(j)  (2304 + 64 * (j))
#define XB_TOP      3328
#define XB_TOPGEN   3392
#define XCD_BAR_WORDS 3456
#define XB_SPIN_CAP (1u << 18)

__device__ __forceinline__ unsigned xb_ld(unsigned* p)              { return __hip_atomic_load(p, __ATOMIC_RELAXED, __HIP_MEMORY_SCOPE_AGENT); }
__device__ __forceinline__ unsigned xb_add(unsigned* p, unsigned v) { return __hip_atomic_fetch_add(p, v, __ATOMIC_RELAXED, __HIP_MEMORY_SCOPE_AGENT); }
__device__ __forceinline__ unsigned xb_xcc_id() { return (unsigned)__builtin_amdgcn_s_getreg((3 << 11) | 20) & 0xFu; }
#define XB_SPIN(cond, bar) do { unsigned _sp = 0; while (cond) { __builtin_amdgcn_s_sleep(1); \
    if ((++_sp & 255u) == 0u) { if (xb_ld(&(bar)[XB_TMO])) break; if (_sp > XB_SPIN_CAP) { atomicAdd(&(bar)[XB_TMO], 1u); break; } } } } while (0)

struct XcdBarrier {
    unsigned* bar; unsigned x;
    volatile LAS unsigned* st;
};

__device__ __forceinline__ XcdBarrier xcd_barrier_post(unsigned* bar, volatile LAS unsigned* st) {
    XcdBarrier b; b.bar = bar; b.x = xb_xcc_id(); b.st = st;
    if (threadIdx.x == 0) (void)xb_add(&bar[XB_XCNT(b.x)], 1u);
    return b;
}
__device__ __forceinline__ void xcd_barrier_complete(unsigned* bar, unsigned x, unsigned& nloc, unsigned& nx) {
    const unsigned G = gridDim.x * gridDim.y * gridDim.z;
    unsigned sum, cnt, mine, sp = 0u;
    for (;;) {
        sum = 0u; cnt = 0u; mine = 0u;
#pragma unroll
        for (unsigned j = 0; j < 16; ++j) { const unsigned c = xb_ld(&bar[XB_XCNT(j)]); sum += c; cnt += (c > 0u) ? 1u : 0u; mine = (j == x) ? c : mine; }
        if (sum == G) break;
        __builtin_amdgcn_s_sleep(1);
        if ((++sp & 255u) == 0u) { if (xb_ld(&bar[XB_TMO])) break; if (sp > XB_SPIN_CAP) { atomicAdd(&bar[XB_TMO], 1u); break; } }
    }
    nloc = mine > 0u ? mine : 1u; nx = cnt > 0u ? cnt : 1u;
}

__device__ __forceinline__ void xcd_barrier(const XcdBarrier& b) {
    asm volatile("s_waitcnt vmcnt(0)" ::: "memory");
    __syncthreads();
    if (threadIdx.x == 0) {
        unsigned* bar = b.bar;
        __builtin_amdgcn_s_waitcnt(0);
        unsigned nloc = b.st[0], nx = b.st[1];
        if (nloc == 0u) { xcd_barrier_complete(bar, b.x, nloc, nx); b.st[0] = nloc; b.st[1] = nx; }
        const unsigned old = xb_add(&bar[XB_XSUB(b.x)], 1u);
        const unsigned gen = old / nloc;
        if (old + 1u == (gen + 1u) * nloc) {
            __builtin_amdgcn_fence(__ATOMIC_RELEASE, "agent");
            asm volatile("s_waitcnt vmcnt(0)" ::: "memory");
            const unsigned og = xb_add(&bar[XB_TOP], 1u);
            const unsigned tg = og / nx;
            if (og + 1u == (tg + 1u) * nx) xb_add(&bar[XB_TOPGEN], 1u);
            else XB_SPIN(xb_ld(&bar[XB_TOPGEN]) == tg, bar);
            __builtin_amdgcn_fence(__ATOMIC_ACQUIRE, "agent");
            xb_add(&bar[XB_XGEN(b.x)], 1u);
            asm volatile("s_waitcnt vmcnt(0)" ::: "memory");
        } else {
            XB_SPIN(xb_ld(&bar[XB_XGEN(b.x)]) == gen, bar);
            __builtin_amdgcn_fence(__ATOMIC_ACQUIRE, "agent");
            asm volatile("s_waitcnt vmcnt(0)" ::: "memory");
        }
    }
    __syncthreads();
}

typedef short bf16x8 __attribute__((ext_vector_type(8)));
typedef float f32x16 __attribute__((ext_vector_type(16)));
typedef float f32x4v __attribute__((ext_vector_type(4)));
typedef unsigned u32x2v __attribute__((ext_vector_type(2)));
struct Args { const float* in[21]; float* out; unsigned char* ws; int ph_lo, ph_hi, bar_sel, pad; };

template <int CTRL> __device__ __forceinline__ float dppf(float v) { return __builtin_bit_cast(float, __builtin_amdgcn_update_dpp(0, __builtin_bit_cast(int, v), CTRL, 0xf, 0xf, false)); }
__device__ __forceinline__ float rdlane(float v, int l) { return __builtin_bit_cast(float, __builtin_amdgcn_readlane(__builtin_bit_cast(int, v), l)); }
__device__ __forceinline__ float row16_sum(float v) { v += dppf<0xB1>(v); v += dppf<0x4E>(v); v += dppf<0x141>(v); v += dppf<0x140>(v); return v; }
__device__ __forceinline__ float row16_max(float v) { v = fmaxf(v, dppf<0xB1>(v)); v = fmaxf(v, dppf<0x4E>(v)); v = fmaxf(v, dppf<0x141>(v)); v = fmaxf(v, dppf<0x140>(v)); return v; }
__device__ __forceinline__ float wave_sum(float v) { v = row16_sum(v); return (rdlane(v, 0) + rdlane(v, 16)) + (rdlane(v, 32) + rdlane(v, 48)); }
__device__ __forceinline__ float wave_max(float v) { v = row16_max(v); return fmaxf(fmaxf(rdlane(v, 0), rdlane(v, 16)), fmaxf(rdlane(v, 32), rdlane(v, 48))); }
typedef unsigned xl_u2 __attribute__((ext_vector_type(2)));
#define XL_SWAP(WHICH, v, X, Y) const auto xl_r_ = __builtin_amdgcn_permlane##WHICH##_swap(__builtin_bit_cast(unsigned, v), __builtin_bit_cast(unsigned, v), false, false); \
    const unsigned xl_x_ = xl_r_[0], xl_y_ = xl_r_[1]; const float X = __uint_as_float(xl_x_), Y = __uint_as_float(xl_y_)
__device__ __forceinline__ float half32_sum(float v) { v = row16_sum(v); XL_SWAP(16, v, x, y); return x + y; }
__device__ __forceinline__ float half32_max(float v) { v = row16_max(v); XL_SWAP(16, v, x, y); return fmaxf(x, y); }
__device__ __forceinline__ float pair32_sum(float v) { XL_SWAP(32, v, x, y); return x + y; }
__device__ __forceinline__ float pair32_max(float v) { XL_SWAP(32, v, x, y); return fmaxf(x, y); }
#undef XL_SWAP
__device__ __forceinline__ float wave_scan_incl(float x, int lane) {
    x += dppf<0x111>(x); x += dppf<0x112>(x); x += dppf<0x114>(x); x += dppf<0x118>(x);
    const float s0 = rdlane(x, 15), s1 = rdlane(x, 31), s2 = rdlane(x, 47); const int r = lane >> 4;
    return x + (r == 0 ? 0.f : (r == 1 ? s0 : (r == 2 ? s0 + s1 : (s0 + s1) + s2)));
}
__device__ __forceinline__ float silu_f(float x) { return x / (1.f + __expf(-x)); }

template <bool GAIN>
__device__ __forceinline__ void cvt_item(const float* W, int ldw, int n0src, bf16* WT, int K, int drow0, int k0, LAS float* scr, int lane, const float* gk = nullptr) {
#pragma unroll 16
    for (int i = 0; i < 32; ++i) { const int kk = 2 * i + (lane >> 5); float v = W[(size_t)(k0 + kk) * ldw + n0src + (lane & 31)]; if (GAIN) v *= gk[kk]; scr[kk * 33 + (lane & 31)] = v; }
    LDS_WAIT(); asm volatile("" ::: "memory");
    const int c = lane & 7;
#pragma unroll
    for (int j = 0; j < 4; ++j) { const int n = (lane >> 3) + 8 * j; const LAS float* s = scr + (8 * c) * 33 + n;
        v4u o; o.x = pk2(s[0 * 33], s[1 * 33]); o.y = pk2(s[2 * 33], s[3 * 33]); o.z = pk2(s[4 * 33], s[5 * 33]); o.w = pk2(s[6 * 33], s[7 * 33]);
        *(GAS v4u*)(WT + (size_t)(drow0 + n) * K + k0 + 8 * c) = o; }
    LDS_WAIT(); asm volatile("" ::: "memory");
}
constexpr float W8_SCALE = 64.f, ACT8_SCALE = 4.f, YS8_SCALE = 16.f;
__device__ __forceinline__ unsigned pk4_fp8(float a, float b, float c, float d) { int w = 0; w = __builtin_amdgcn_cvt_pk_fp8_f32(a, b, w, false); w = __builtin_amdgcn_cvt_pk_fp8_f32(c, d, w, true); return (unsigned)w; }
__device__ __forceinline__ void cvt_item_fp8(const float* W, int ldw, int n0src, unsigned char* WT, int K, int drow0, int k0, LAS float* scr, int lane) {
#pragma unroll 16
    for (int i = 0; i < 32; ++i) { const int kk = 2 * i + (lane >> 5); scr[kk * 33 + (lane & 31)] = W[(size_t)(k0 + kk) * ldw + n0src + (lane & 31)] * W8_SCALE; }
    LDS_WAIT(); asm volatile("" ::: "memory");
    const int c = lane & 3;
#pragma unroll
    for (int j = 0; j < 2; ++j) { const int n = (lane >> 2) + 16 * j; const LAS float* s = scr + (16 * c) * 33 + n;
        v4u o; o.x = pk4_fp8(s[0 * 33], s[1 * 33], s[2 * 33], s[3 * 33]); o.y = pk4_fp8(s[4 * 33], s[5 * 33], s[6 * 33], s[7 * 33]);
        o.z = pk4_fp8(s[8 * 33], s[9 * 33], s[10 * 33], s[11 * 33]); o.w = pk4_fp8(s[12 * 33], s[13 * 33], s[14 * 33], s[15 * 33]);
        *(GAS v4u*)(WT + (size_t)(drow0 + n) * K + k0 + 16 * c) = o; }
    LDS_WAIT(); asm volatile("" ::: "memory");
}
__device__ __forceinline__ void ph_prologue(const Args& a, LAS unsigned char* lds, int bid, int nb) {
    const int tid = threadIdx.x, lane = tid & 63, wave = tid >> 6;
    unsigned char* ws = a.ws;
    LAS float* scr = (LAS float*)(lds + 32768 + wave * 8704);
    const int gw = bid * 8 + wave, ngw = nb * 8;
    constexpr int I_IN = 16 * 72, I_OUT = 16 * 32;
    const float* x = a.in[0]; const float* g = a.in[1]; bf16* u = (bf16*)(ws + WS_U); float* dtraw = (float*)(ws + WS_DTRAW);
    float4 cur[2][4], nxt[2][4];
#define P0_LOAD(dst, r0_) do { _Pragma("unroll") for (int q = 0; q < 2; ++q) { const int r_ = (r0_) + q * ngw; if (r_ < T) { const float4* xr = (const float4*)(x + (size_t)r_ * DM); \
        _Pragma("unroll") for (int j = 0; j < 4; ++j) dst[q][j] = xr[lane + 64 * j]; } } } while (0)
    P0_LOAD(cur, gw);
    LAS float* wdt = (LAS float*)lds;
    for (int i = tid; i < 1024 * 8; i += NT) wdt[(i & 7) * 1024 + (i >> 3)] = a.in[2][(size_t)(i >> 3) * DPROJ + O_DT + (i & 7)];
    float4 gq[4];
#pragma unroll
    for (int j = 0; j < 4; ++j) gq[j] = ((const float4*)g)[lane + 64 * j];
    __syncthreads();
#pragma unroll
    for (int j = 0; j < 4; ++j) asm volatile("" :: "v"(gq[j].x), "v"(gq[j].y), "v"(gq[j].z), "v"(gq[j].w));
    for (int r0 = gw; r0 < T; r0 += 2 * ngw) {
        if (r0 + 2 * ngw < T) P0_LOAD(nxt, r0 + 2 * ngw);
#pragma unroll
        for (int q = 0; q < 2; ++q) { const int r = r0 + q * ngw; if (r < T) {
        float4 (&v)[4] = cur[q]; float s = 0.f;
#pragma unroll
        for (int j = 0; j < 4; ++j) s += v[j].x * v[j].x + v[j].y * v[j].y + v[j].z * v[j].z + v[j].w * v[j].w;
        const float rs = rsqrtf(wave_sum(s) * (1.f / DM) + EPS);
        float dacc[8];
#pragma unroll
        for (int h = 0; h < 8; ++h) dacc[h] = 0.f;
#pragma unroll
        for (int j = 0; j < 4; ++j) { const float4 gg = gq[j];
            const float un[4] = {v[j].x * rs * gg.x, v[j].y * rs * gg.y, v[j].z * rs * gg.z, v[j].w * rs * gg.w};
            uint2 o; o.x = pg8::cvt_pk_bf16(un[0], un[1]); o.y = pg8::cvt_pk_bf16(un[2], un[3]);
            *(uint2*)(u + (size_t)r * DM + 4 * lane + 256 * j) = o;
#pragma unroll
            for (int h = 0; h < 8; ++h) { const f32x4v w4 = *(const LAS f32x4v*)(wdt + h * 1024 + 4 * lane + 256 * j); dacc[h] += (un[0] * w4[0] + un[1] * w4[1]) + (un[2] * w4[2] + un[3] * w4[3]); } }
#pragma unroll
        for (int h = 0; h < 8; ++h) dacc[h] = wave_sum(dacc[h]);
        if (lane == 0) {
#pragma unroll
            for (int h = 0; h < 8; ++h) dtraw[(size_t)r * 8 + h] = dacc[h]; }
        } }
#pragma unroll
        for (int q = 0; q < 2; ++q)
#pragma unroll
            for (int j = 0; j < 4; ++j) cur[q][j] = nxt[q][j];
    }
#undef P0_LOAD
    for (int it0 = gw; it0 < I_IN + I_OUT; it0 += ngw) {
        int it = it0;
        if (it < I_IN) { const int kb = it / 72, d0 = 32 * (it % 72); cvt_item<false>(a.in[2], DPROJ, d0 < 1536 ? d0 : d0 + 8, (bf16*)(ws + WS_WIN), DM, d0, 64 * kb, scr, lane); continue; }
        it -= I_IN;
        { const int kb = it / 32, d0 = 32 * (it % 32); cvt_item<true>(a.in[12], DM, d0, (bf16*)(ws + WS_WOUT), DM, d0, 64 * kb, scr, lane, (kb < 8 ? a.in[8] : a.in[11] - 512) + 64 * kb); }
    }
}

constexpr int CW_QHEAD = 1024;
constexpr int I_W1 = NE * 8 * 64, I_W2 = NE * 8 * 32;
struct CvtItem { const float* W; unsigned char* WT; int ldw, n0src, drow0, k0; };
__device__ __forceinline__ CvtItem moe_item(const Args& a, int it) {
    CvtItem c; unsigned char* ws = a.ws;
    if (it < I_W1) { const int e = it >> 9, r = it & 511, kb = r >> 6, d0 = 32 * (r & 63), pn = d0 >> 8, j0 = d0 & 255;
        c.W = a.in[16] + (size_t)e * 1024 * 2048; c.ldw = 2048; c.n0src = j0 < 128 ? pn * 128 + j0 : 1024 + pn * 128 + (j0 - 128); c.WT = ws + WS_W1 + (size_t)e * 2048 * 1024; c.drow0 = d0; c.k0 = 128 * kb; }
    else { it -= I_W1; const int e = it >> 8, r = it & 255, kb = r >> 5, d0 = 32 * (r & 31);
        c.W = a.in[18] + (size_t)e * 1024 * 1024; c.ldw = 1024; c.n0src = d0; c.WT = ws + WS_W2 + (size_t)e * 1024 * 1024; c.drow0 = d0; c.k0 = 128 * kb; }
    return c;
}
__device__ __forceinline__ void cvt8_load(const CvtItem& c, int lane, f32x4v (&v)[16]) {
    const float* p = c.W + (size_t)(c.k0 + 16 * (lane >> 3)) * c.ldw + c.n0src + (lane & 7) * 4;
#pragma unroll
    for (int i = 0; i < 16; ++i) v[i] = __builtin_nontemporal_load((const f32x4v*)(p + (size_t)i * c.ldw));
}
__device__ __forceinline__ void cvt8_finish(const CvtItem& c, int lane, const f32x4v (&v)[16]) {
    unsigned char* q = c.WT + (size_t)(c.drow0 + 4 * (lane & 7)) * DM + c.k0 + 16 * (lane >> 3);
#pragma unroll
    for (int cc = 0; cc < 4; ++cc) { v4u o;
        o.x = pk4_fp8(v[0][cc] * W8_SCALE, v[1][cc] * W8_SCALE, v[2][cc] * W8_SCALE, v[3][cc] * W8_SCALE); o.y = pk4_fp8(v[4][cc] * W8_SCALE, v[5][cc] * W8_SCALE, v[6][cc] * W8_SCALE, v[7][cc] * W8_SCALE);
        o.z = pk4_fp8(v[8][cc] * W8_SCALE, v[9][cc] * W8_SCALE, v[10][cc] * W8_SCALE, v[11][cc] * W8_SCALE); o.w = pk4_fp8(v[12][cc] * W8_SCALE, v[13][cc] * W8_SCALE, v[14][cc] * W8_SCALE, v[15][cc] * W8_SCALE);
        *(GAS v4u*)(q + (size_t)cc * DM) = o; }
}
constexpr int I_MOE = I_W1 + I_W2, QB8 = 4, QPART = I_MOE / 8;
static_assert(QPART % QB8 == 0, "queue partition");
__device__ __forceinline__ void moe_weight_queue(const Args& a, LAS unsigned char* lds, int bid) {
    const int tid = threadIdx.x, lane = tid & 63; (void)lds;
    unsigned* heads = (unsigned*)(a.ws + WS_CTL) + CW_QHEAD;
    for (int k = 0; k < 8; ++k) { const int part = (bid + k) & 7;
        for (;;) { unsigned b0 = 0u; if (lane == 0) b0 = atomicAdd(&heads[64 * part], (unsigned)QB8); b0 = (unsigned)__builtin_amdgcn_readfirstlane((int)b0);
            if (b0 >= (unsigned)QPART) break;
            const int base = part * QPART + (int)b0;
            f32x4v A[16], B[16];
#define QL(j, R) cvt8_load(moe_item(a, base + (j)), lane, R)
#define QF(j, R) cvt8_finish(moe_item(a, base + (j)), lane, R)
            QL(0, A); QL(1, B);
            QF(0, A); QL(2, A); QF(1, B); QL(3, B);
            QF(2, A); QF(3, B); } }
#undef QL
#undef QF
}
__device__ __forceinline__ void ph_conv(const Args& a, int bid, int nb) {
    const bf16* proj = (const bf16*)(a.ws + WS_PROJ); const float* cw = a.in[3]; const float* cb = a.in[4]; const float* dtb = a.in[5]; const float* dtraw = (const float*)(a.ws + WS_DTRAW);
    float* xc = (float*)(a.ws + WS_XC); float* dt = (float*)(a.ws + WS_DT);
    const size_t n = (size_t)T * 1024;
    for (size_t i = (size_t)bid * NT + threadIdx.x; i < n; i += (size_t)nb * NT) {
        const int t = (int)(i >> 10), c = (int)(i & 1023), s = t % SEQ;
        float v = cb[c];
#pragma unroll
        for (int k = 0; k < 4; ++k) { const int ss = s - 3 + k; if (ss >= 0) v += cw[k * 1024 + c] * bf2f(proj[(size_t)(t - 3 + k) * NP + PXBC + c]); }
        xc[i] = silu_f(v);
    }
    for (int i = bid * NT + threadIdx.x; i < T * 8; i += nb * NT) {
        const float v = dtraw[i] + dtb[i & 7];
        dt[i] = v > 20.f ? v : log1pf(__expf(v));
    }
}
__device__ __forceinline__ unsigned cvtpk(float lo, float hi) { unsigned r; asm volatile("v_cvt_pk_bf16_f32 %0, %1, %2" : "=v"(r) : "v"(lo), "v"(hi)); return r; }
__device__ __forceinline__ float silu_fast(float x) { return x * __builtin_amdgcn_rcpf(1.f + __expf(-x)); }
__device__ __forceinline__ void conv_load(const bf16* proj, int t0, int s0, int l0, int ch, unsigned (&raw)[11]) {
#pragma unroll
    for (int i = 0; i < 11; ++i) { const int l = l0 - 3 + i; unsigned wv = 0u; if (s0 + l >= 0) wv = *(const unsigned*)(proj + (size_t)(t0 + l) * NP + PXBC + ch); raw[i] = wv; }
}
__device__ __forceinline__ void conv_compute(const unsigned (&raw)[11], const float* cw, const float* cb, int ch, float (&o0)[8], float (&o1)[8]) {
    float w0[4], w1[4];
#pragma unroll
    for (int k = 0; k < 4; ++k) { const float2 wv = *(const float2*)(cw + k * 1024 + ch); w0[k] = wv.x; w1[k] = wv.y; }
    const float2 bb = *(const float2*)(cb + ch);
#pragma unroll
    for (int j = 0; j < 8; ++j) { float v0 = bb.x, v1 = bb.y;
#pragma unroll
        for (int k = 0; k < 4; ++k) { v0 += w0[k] * bflo(raw[j + k]); v1 += w1[k] * bfhi(raw[j + k]); }
        o0[j] = silu_fast(v0); o1[j] = silu_fast(v1); }
}
constexpr int SL_ST = 272, SL_XW = 0, SL_BMT = 256 * SL_ST, SL_WL = SL_BMT + 128 * SL_ST, SL_TMP = SL_WL + 2048;
__device__ __forceinline__ void ph_ssd_local(const Args& a, LAS unsigned char* lds, int bid, int nb) {
    const bf16* proj = (const bf16*)(a.ws + WS_PROJ); const float* dtraw = (const float*)(a.ws + WS_DTRAW); const float* dtb = a.in[5]; const float* alog = a.in[6];
    float* dtg = (float*)(a.ws + WS_DT); float* acum = (float*)(a.ws + WS_ACUM); float* cdec = (float*)(a.ws + WS_CDEC); float* states = (float*)(a.ws + WS_STATES);
    const int tid = threadIdx.x, lane = tid & 63, w = tid >> 6;
    LAS unsigned char* XW = lds + SL_XW; LAS unsigned char* BMT = lds + SL_BMT; LAS float* wl = (LAS float*)(lds + SL_WL); LAS float* tmp = (LAS float*)(lds + SL_TMP);
    for (int unit = bid; unit < BATCH * NCH * 2; unit += nb) {
        const int g = unit & 1, c = (unit >> 1) % NCH, b = unit / (2 * NCH); const int t0 = b * SEQ + c * 128;
        __syncthreads();
        { const int r = tid >> 7, l = tid & 127, h = g * 4 + r;
          const float v = dtraw[(size_t)(t0 + l) * 8 + h] + dtb[h]; const float dtv = fmaxf(v, 0.f) + log1pf(__expf(-fabsf(v))); const float av = -__expf(alog[h]);
          float x = dtv * av;
          x = wave_scan_incl(x, lane);
          if (lane == 63) tmp[w] = x;
          __syncthreads();
          if (w & 1) x += tmp[w - 1];
          const float last = tmp[2 * r] + tmp[2 * r + 1];
          dtg[(size_t)(t0 + l) * 8 + h] = dtv; acum[(size_t)(t0 + l) * 8 + h] = x; wl[r * 128 + l] = dtv * __expf(last - x);
          if (l == 127) cdec[(b * NCH + c) * 8 + h] = __expf(x); }
        __syncthreads();
        { unsigned raw[6][11];
#pragma unroll
          for (int it = 0; it < 6; ++it) { const int task = tid + it * NT, pi = task % 192, l0 = (task / 192) * 8;
              const int ch = pi < 128 ? g * 256 + 2 * pi : 512 + g * 128 + 2 * (pi - 128); conv_load(proj, t0, c * 128, l0, ch, raw[it]); }
#pragma unroll
          for (int it = 0; it < 6; ++it) { const int task = tid + it * NT, pi = task % 192, l0 = (task / 192) * 8;
            const int ch = pi < 128 ? g * 256 + 2 * pi : 512 + g * 128 + 2 * (pi - 128);
            float o0[8], o1[8]; conv_compute(raw[it], a.in[3], a.in[4], ch, o0, o1);
            if (pi < 128) { const int row = 2 * pi; const LAS float* ws_ = wl + (row >> 6) * 128 + l0;
#pragma unroll
                for (int j = 0; j < 8; ++j) { o0[j] *= ws_[j]; o1[j] *= ws_[j]; }
                v4u p0, p1; p0.x = cvtpk(o0[0], o0[1]); p0.y = cvtpk(o0[2], o0[3]); p0.z = cvtpk(o0[4], o0[5]); p0.w = cvtpk(o0[6], o0[7]);
                p1.x = cvtpk(o1[0], o1[1]); p1.y = cvtpk(o1[2], o1[3]); p1.z = cvtpk(o1[4], o1[5]); p1.w = cvtpk(o1[6], o1[7]);
                *(LAS v4u*)(XW + row * SL_ST + l0 * 2) = p0; *(LAS v4u*)(XW + (row + 1) * SL_ST + l0 * 2) = p1; }
            else { const int row = 2 * (pi - 128);
                v4u p0, p1; p0.x = cvtpk(o0[0], o0[1]); p0.y = cvtpk(o0[2], o0[3]); p0.z = cvtpk(o0[4], o0[5]); p0.w = cvtpk(o0[6], o0[7]);
                p1.x = cvtpk(o1[0], o1[1]); p1.y = cvtpk(o1[2], o1[3]); p1.z = cvtpk(o1[4], o1[5]); p1.w = cvtpk(o1[6], o1[7]);
                *(LAS v4u*)(BMT + row * SL_ST + l0 * 2) = p0; *(LAS v4u*)(BMT + (row + 1) * SL_ST + l0 * 2) = p1; } } }
        __syncthreads();
        { const int r = w >> 1, ph = w & 1, qc = lane & 31, hh = lane >> 5, h = g * 4 + r;
          f32x16 acc[4];
#pragma unroll
          for (int n4 = 0; n4 < 4; ++n4)
#pragma unroll
              for (int i = 0; i < 16; ++i) acc[n4][i] = 0.f;
#pragma unroll
          for (int ks = 0; ks < 8; ++ks) { const bf16x8 af = *(const LAS bf16x8*)(XW + (r * 64 + ph * 32 + qc) * SL_ST + (16 * ks + 8 * hh) * 2);
#pragma unroll
              for (int n4 = 0; n4 < 4; ++n4) { const bf16x8 bfr = *(const LAS bf16x8*)(BMT + (n4 * 32 + qc) * SL_ST + (16 * ks + 8 * hh) * 2);
                  acc[n4] = __builtin_amdgcn_mfma_f32_32x32x16_bf16(af, bfr, acc[n4], 0, 0, 0); } }
          float* st = states + ((size_t)((b * NCH + c) * 8 + h)) * 8192;
#pragma unroll
          for (int n4 = 0; n4 < 4; ++n4)
#pragma unroll
              for (int i = 0; i < 16; ++i) { const int pp = ph * 32 + (i & 3) + 8 * (i >> 2) + 4 * hh; st[pp * 128 + n4 * 32 + qc] = acc[n4][i]; } }
    }
}
__device__ __forceinline__ void ph_scan(const Args& a, int bid, int nb) {
    const float* states = (const float*)(a.ws + WS_STATES); const float* cdec = (const float*)(a.ws + WS_CDEC); bf16* prev = (bf16*)(a.ws + WS_PREV);
    const int n4 = BATCH * 8 * 2048;
    for (int i = bid * NT + threadIdx.x; i < n4; i += nb * NT) {
        const int e4 = i & 2047, h = (i >> 11) & 7, b = i >> 14;
        f32x4v st[NCH]; float dc[NCH];
#pragma unroll
        for (int c = 0; c < NCH; ++c) { st[c] = *(const f32x4v*)(states + ((size_t)((b * NCH + c) * 8 + h)) * 8192 + e4 * 4); dc[c] = cdec[(b * NCH + c) * 8 + h]; }
        f32x4v hc = {0.f, 0.f, 0.f, 0.f};
#pragma unroll
        for (int c = 0; c < NCH; ++c) { u32x2v pk; pk.x = cvtpk(hc[0], hc[1]); pk.y = cvtpk(hc[2], hc[3]); *(u32x2v*)(prev + ((size_t)((b * NCH + c) * 8 + h)) * 8192 + e4 * 4) = pk; hc = hc * dc[c] + st[c]; }
    }
}
constexpr int SO_XST = 264, SO_NST = 272, SO_XS = 0, SO_BM = 256 * SO_XST, SO_CM = SO_BM + 128 * SO_NST, SO_AC = SO_CM + 128 * SO_NST, SO_DT = SO_AC + 2048, SO_EA = SO_DT + 2048, SO_END = SO_EA + 2048;
constexpr int SO_YST = 260;
static_assert(128 * SO_YST * 4 <= SO_AC && SO_END <= SCR_BYTES, "ssd_out LDS map");
__device__ __forceinline__ void ph_ssd_out(const Args& a, LAS unsigned char* lds, int bid, int nb) {
    const bf16* proj = (const bf16*)(a.ws + WS_PROJ); const float* dtg = (const float*)(a.ws + WS_DT); const float* acum = (const float*)(a.ws + WS_ACUM);
    const bf16* prev = (const bf16*)(a.ws + WS_PREV); const float* dsk = a.in[7];
    bf16* ygb = (bf16*)(a.ws + WS_CAT); float* ssd = (float*)(a.ws + WS_SSSD);
    const int tid = threadIdx.x, lane = tid & 63, w = tid >> 6, r = w >> 1, lsel = w & 1, qc = lane & 31, hh = lane >> 5;
    LAS unsigned char* XS = lds + SO_XS; LAS unsigned char* BM = lds + SO_BM; LAS unsigned char* CM = lds + SO_CM;
    LAS float* AC = (LAS float*)(lds + SO_AC); LAS float* DT = (LAS float*)(lds + SO_DT); LAS float* EA = (LAS float*)(lds + SO_EA); LAS float* YS = (LAS float*)lds;
    for (int unit = bid; unit < BATCH * NCH * 2; unit += nb) {
        const int g = unit & 1, c = (unit >> 1) % NCH, b = unit / (2 * NCH); const int t0 = b * SEQ + c * 128;
        __syncthreads();
        bf16x8 pf[2][8];
        { const bf16* pvb = prev + ((size_t)((b * NCH + c) * 8 + g * 4 + r)) * 8192 + qc * 128 + 8 * hh;
#pragma unroll
          for (int pb = 0; pb < 2; ++pb)
#pragma unroll
              for (int ks = 0; ks < 8; ++ks) pf[pb][ks] = *(const bf16x8*)(pvb + pb * 32 * 128 + 16 * ks); }
        { const int rr = tid >> 7, l = tid & 127, h = g * 4 + rr; const float ac = acum[(size_t)(t0 + l) * 8 + h];
          AC[rr * 128 + l] = ac; DT[rr * 128 + l] = dtg[(size_t)(t0 + l) * 8 + h]; EA[rr * 128 + l] = __expf(ac); }
#pragma unroll 1
        for (int bt = 0; bt < 2; ++bt) { unsigned raw[4][11];
#pragma unroll
          for (int it = 0; it < 4; ++it) { const int task = tid + (bt * 4 + it) * NT, pi = task & 255, l0 = (task >> 8) * 8;
              const int ch = pi < 128 ? g * 256 + 2 * pi : (pi < 192 ? 512 + g * 128 + 2 * (pi - 128) : 768 + g * 128 + 2 * (pi - 192)); conv_load(proj, t0, c * 128, l0, ch, raw[it]); }
#pragma unroll
          for (int it = 0; it < 4; ++it) { const int task = tid + (bt * 4 + it) * NT, pi = task & 255, l0 = (task >> 8) * 8;
            const int ch = pi < 128 ? g * 256 + 2 * pi : (pi < 192 ? 512 + g * 128 + 2 * (pi - 128) : 768 + g * 128 + 2 * (pi - 192));
            float o0[8], o1[8]; conv_compute(raw[it], a.in[3], a.in[4], ch, o0, o1);
            if (pi < 128) { const int row = 2 * pi; u32x2v q0, q1;
                q0.x = cvtpk(o0[0], o0[1]); q0.y = cvtpk(o0[2], o0[3]); q1.x = cvtpk(o0[4], o0[5]); q1.y = cvtpk(o0[6], o0[7]);
                *(LAS u32x2v*)(XS + row * SO_XST + l0 * 2) = q0; *(LAS u32x2v*)(XS + row * SO_XST + l0 * 2 + 8) = q1;
                q0.x = cvtpk(o1[0], o1[1]); q0.y = cvtpk(o1[2], o1[3]); q1.x = cvtpk(o1[4], o1[5]); q1.y = cvtpk(o1[6], o1[7]);
                *(LAS u32x2v*)(XS + (row + 1) * SO_XST + l0 * 2) = q0; *(LAS u32x2v*)(XS + (row + 1) * SO_XST + l0 * 2 + 8) = q1; }
            else { LAS unsigned char* img = pi < 192 ? BM : CM; const int n = 2 * ((pi - 128) & 63);
#pragma unroll
                for (int j = 0; j < 8; ++j) *(LAS unsigned*)(img + (l0 + j) * SO_NST + n * 2) = cvtpk(o0[j], o1[j]); } } }
        __syncthreads();
        const int h = g * 4 + r; const float dskip = dsk[h];
        f32x16 Y[2][2];
#pragma unroll
        for (int li = 0; li < 2; ++li) {
            const int lb = lsel ? (1 + li) : (li ? 3 : 0);
#pragma unroll
            for (int pb = 0; pb < 2; ++pb)
#pragma unroll
                for (int i = 0; i < 16; ++i) Y[li][pb][i] = 0.f;
#pragma unroll
            for (int ks = 0; ks < 8; ++ks) { const bf16x8 bfr = *(const LAS bf16x8*)(CM + (lb * 32 + qc) * SO_NST + (16 * ks + 8 * hh) * 2);
#pragma unroll
                for (int pb = 0; pb < 2; ++pb) Y[li][pb] = __builtin_amdgcn_mfma_f32_32x32x16_bf16(pf[pb][ks], bfr, Y[li][pb], 0, 0, 0); }
            const float ea = EA[r * 128 + lb * 32 + qc], acl = AC[r * 128 + lb * 32 + qc];
#pragma unroll
            for (int pb = 0; pb < 2; ++pb)
#pragma unroll
                for (int i = 0; i < 16; ++i) Y[li][pb][i] *= ea;
            for (int sb = 0; sb <= lb; ++sb) {
                f32x16 X;
#pragma unroll
                for (int i = 0; i < 16; ++i) X[i] = 0.f;
#pragma unroll
                for (int ks = 0; ks < 8; ++ks) { const bf16x8 af = *(const LAS bf16x8*)(BM + (sb * 32 + qc) * SO_NST + (16 * ks + 8 * hh) * 2);
                    const bf16x8 bfr = *(const LAS bf16x8*)(CM + (lb * 32 + qc) * SO_NST + (16 * ks + 8 * hh) * 2);
                    X = __builtin_amdgcn_mfma_f32_32x32x16_bf16(af, bfr, X, 0, 0, 0); }
                const bool dg = (sb == lb);
#pragma unroll
                for (int q = 0; q < 4; ++q) { const f32x4v as4 = *(const LAS f32x4v*)(AC + r * 128 + sb * 32 + 8 * q + 4 * hh), ds4 = *(const LAS f32x4v*)(DT + r * 128 + sb * 32 + 8 * q + 4 * hh);
#pragma unroll
                    for (int i = 0; i < 4; ++i) { const int sl = 8 * q + 4 * hh + i;
                        const float e = __expf(acl - as4[i]) * ds4[i]; const bool ok = !dg || sl <= qc; float f = ok ? e : 0.f;
                        float xv = X[4 * q + i] * f; if (dg && sl == qc) xv += dskip; X[4 * q + i] = xv; } }
#pragma unroll
                for (int k2 = 0; k2 < 2; ++k2) { union { bf16x8 v; unsigned u[4]; } gb;
#pragma unroll
                    for (int e = 0; e < 4; ++e) gb.u[e] = cvtpk(X[8 * k2 + 2 * e], X[8 * k2 + 2 * e + 1]);
#pragma unroll
                    for (int pb = 0; pb < 2; ++pb) { const LAS unsigned char* xp = XS + (r * 64 + pb * 32 + qc) * SO_XST + (sb * 32 + 16 * k2 + 4 * hh) * 2;
                        union { bf16x8 v; u32x2v h2[2]; } af; af.h2[0] = *(const LAS u32x2v*)xp; af.h2[1] = *(const LAS u32x2v*)(xp + 16);
                        Y[li][pb] = __builtin_amdgcn_mfma_f32_32x32x16_bf16(af.v, gb.v, Y[li][pb], 0, 0, 0); } }
            }
        }
        __syncthreads();
#pragma unroll
        for (int li = 0; li < 2; ++li) { const int lb = lsel ? (1 + li) : (li ? 3 : 0);
#pragma unroll
            for (int pb = 0; pb < 2; ++pb)
#pragma unroll
                for (int q = 0; q < 4; ++q) { f32x4v v4; v4[0] = Y[li][pb][4 * q]; v4[1] = Y[li][pb][4 * q + 1]; v4[2] = Y[li][pb][4 * q + 2]; v4[3] = Y[li][pb][4 * q + 3];
                    *(LAS f32x4v*)(YS + (lb * 32 + qc) * SO_YST + r * 64 + pb * 32 + 8 * q + 4 * hh) = v4; } }
        __syncthreads();
        { v4u zz8[8];
#pragma unroll
          for (int it = 0; it < 8; ++it) { const int task = tid + it * NT, row = task >> 5, ck = task & 31; zz8[it] = *(const v4u*)(proj + (size_t)(t0 + row) * NP + PZ + g * 256 + ck * 8); }
#pragma unroll
          for (int it = 0; it < 8; ++it) { const int task = tid + it * NT, row = task >> 5, ck = task & 31; const v4u zz = zz8[it];
            const f32x4v y0 = *(const LAS f32x4v*)(YS + row * SO_YST + ck * 8), y1 = *(const LAS f32x4v*)(YS + row * SO_YST + ck * 8 + 4);
            float o[8]; o[0] = y0[0] * silu_fast(bflo(zz.x)); o[1] = y0[1] * silu_fast(bfhi(zz.x)); o[2] = y0[2] * silu_fast(bflo(zz.y)); o[3] = y0[3] * silu_fast(bfhi(zz.y));
            o[4] = y1[0] * silu_fast(bflo(zz.z)); o[5] = y1[1] * silu_fast(bfhi(zz.z)); o[6] = y1[2] * silu_fast(bflo(zz.w)); o[7] = y1[3] * silu_fast(bfhi(zz.w));
            float ss = 0.f;
#pragma unroll
            for (int e = 0; e < 8; ++e) ss += o[e] * o[e];
            ss = half32_sum(ss);
            if (ck == 0) ssd[(size_t)(t0 + row) * 2 + g] = ss;
            v4u ov; ov.x = cvtpk(o[0], o[1]); ov.y = cvtpk(o[2], o[3]); ov.z = cvtpk(o[4], o[5]); ov.w = cvtpk(o[6], o[7]);
            *(v4u*)(ygb + (size_t)(t0 + row) * 1024 + g * 256 + ck * 8) = ov; } }
    }
}
constexpr int AT_KST = 144, AT_VST = 520, AT_K = 0, AT_V = 256 * AT_KST, AT_B = AT_V + 64 * AT_VST;
__device__ __forceinline__ void ph_attn(const Args& a, LAS unsigned char* lds, int bid, int nb) {
    const bf16* proj = (const bf16*)(a.ws + WS_PROJ); const float* sinks = a.in[9]; const float* relb = a.in[10];
    bf16* ao = (bf16*)(a.ws + WS_CAT) + 512; float* ssat = (float*)(a.ws + WS_SSAT);
    const int tid = threadIdx.x, lane = tid & 63, w = tid >> 6, g = w >> 1, half = w & 1, qc = lane & 31, hh = lane >> 5;
    LAS unsigned char* Kimg = lds + AT_K; LAS unsigned char* VT = lds + AT_V; LAS float* biasT = (LAS float*)(lds + AT_B);
    for (int unit = bid; unit < BATCH * NCH * 2; unit += nb) {
        const int kvh = unit & 1, blk = (unit >> 1) % NCH, b = unit / (2 * NCH); const int t0 = b * SEQ + blk * 128;
        __syncthreads();
        { v4u kv4[4], vv4[4];
#pragma unroll
          for (int it = 0; it < 4; ++it) { const int c = tid + it * NT, row = c >> 3, part = c & 7; kv4[it] = (v4u){0u, 0u, 0u, 0u}; vv4[it] = (v4u){0u, 0u, 0u, 0u};
            if (blk > 0 || row >= 128) { const bf16* src = proj + (size_t)(t0 - 128 + row) * NP + kvh * 64 + part * 8; kv4[it] = *(const v4u*)(src + PK); vv4[it] = *(const v4u*)(src + PV); } }
#pragma unroll
          for (int it = 0; it < 4; ++it) { const int c = tid + it * NT, row = c >> 3, part = c & 7; const v4u kv = kv4[it], vv = vv4[it];
            *(LAS v4u*)(Kimg + row * AT_KST + part * 16) = kv;
            LAS unsigned short* vt = (LAS unsigned short*)(VT + (part * 8) * AT_VST + row * 2);
            vt[0 * (AT_VST / 2)] = (unsigned short)(vv.x & 0xffffu); vt[1 * (AT_VST / 2)] = (unsigned short)(vv.x >> 16);
            vt[2 * (AT_VST / 2)] = (unsigned short)(vv.y & 0xffffu); vt[3 * (AT_VST / 2)] = (unsigned short)(vv.y >> 16);
            vt[4 * (AT_VST / 2)] = (unsigned short)(vv.z & 0xffffu); vt[5 * (AT_VST / 2)] = (unsigned short)(vv.z >> 16);
            vt[6 * (AT_VST / 2)] = (unsigned short)(vv.w & 0xffffu); vt[7 * (AT_VST / 2)] = (unsigned short)(vv.w >> 16); } }
        { const int gg = tid >> 7, dist = tid & 127; biasT[gg * 128 + dist] = relb[c_bucket[dist] * 8 + kvh * 4 + gg]; }
        __syncthreads();
        const int hq = kvh * 4 + g; const float sink = sinks[hq];
#pragma unroll 1
        for (int qb = 0; qb < 2; ++qb) {
            const int q0 = half * 64 + qb * 32; const size_t tq = (size_t)(t0 + q0 + qc);
            bf16x8 qf[4];
            { const bf16* qp = proj + tq * NP + PQ + hq * 64 + 8 * hh;
#pragma unroll
              for (int ks = 0; ks < 4; ++ks) qf[ks] = *(const bf16x8*)(qp + 16 * ks); }
            f32x16 sc[5];
#pragma unroll
            for (int kb = 0; kb < 5; ++kb) {
#pragma unroll
                for (int r = 0; r < 16; ++r) sc[kb][r] = 0.f;
#pragma unroll
                for (int ks = 0; ks < 4; ++ks) { const bf16x8 kf = *(const LAS bf16x8*)(Kimg + (q0 + 32 * kb + qc) * AT_KST + (16 * ks + 8 * hh) * 2);
                    sc[kb] = __builtin_amdgcn_mfma_f32_32x32x16_bf16(kf, qf[ks], sc[kb], 0, 0, 0); } }
            float m = -INFINITY;
#pragma unroll
            for (int kb = 0; kb < 5; ++kb)
#pragma unroll
                for (int r = 0; r < 16; ++r) { const int ki = (r & 3) + 8 * (r >> 2) + 4 * hh, dist = qc + 128 - 32 * kb - ki, j = q0 + 32 * kb + ki;
                    const bool ok = dist >= 0 && dist < 128 && (blk > 0 || j >= 128);
                    const float v = ok ? sc[kb][r] * 0.125f + biasT[g * 128 + (dist & 127)] : -INFINITY; sc[kb][r] = v; m = fmaxf(m, v); }
            m = pair32_max(m); m = fmaxf(m, sink);
            float l = 0.f;
#pragma unroll
            for (int kb = 0; kb < 5; ++kb)
#pragma unroll
                for (int r = 0; r < 16; ++r) { const float pv = __expf(sc[kb][r] - m); sc[kb][r] = pv; l += pv; }
            l = pair32_sum(l); l += __expf(sink - m);
            f32x16 o[2];
#pragma unroll
            for (int db = 0; db < 2; ++db)
#pragma unroll
                for (int r = 0; r < 16; ++r) o[db][r] = 0.f;
#pragma unroll
            for (int kb = 0; kb < 5; ++kb)
#pragma unroll
                for (int k2 = 0; k2 < 2; ++k2) {
                    union { bf16x8 v; unsigned u[4]; } pb;
#pragma unroll
                    for (int e = 0; e < 4; ++e) pb.u[e] = cvtpk(sc[kb][8 * k2 + 2 * e], sc[kb][8 * k2 + 2 * e + 1]);
#pragma unroll
                    for (int db = 0; db < 2; ++db) { const LAS unsigned char* vp = VT + (db * 32 + qc) * AT_VST + (q0 + 32 * kb + 16 * k2 + 4 * hh) * 2;
                        union { bf16x8 v; u32x2v h2[2]; } va; va.h2[0] = *(const LAS u32x2v*)vp; va.h2[1] = *(const LAS u32x2v*)(vp + 16);
                        o[db] = __builtin_amdgcn_mfma_f32_32x32x16_bf16(va.v, pb.v, o[db], 0, 0, 0); } }
            const float inv = 1.f / l; float ss = 0.f;
#pragma unroll
            for (int db = 0; db < 2; ++db)
#pragma unroll
                for (int r = 0; r < 16; ++r) { o[db][r] *= inv; ss += o[db][r] * o[db][r]; }
            ss = pair32_sum(ss);
            if (hh == 0) ssat[tq * 8 + hq] = ss;
#pragma unroll
            for (int db = 0; db < 2; ++db)
#pragma unroll
                for (int q4 = 0; q4 < 4; ++q4) { uint2 pk; pk.x = cvtpk(o[db][4 * q4], o[db][4 * q4 + 1]); pk.y = cvtpk(o[db][4 * q4 + 2], o[db][4 * q4 + 3]);
                    *(uint2*)(ao + tq * 1024 + hq * 64 + db * 32 + 8 * q4 + 4 * hh) = pk; }
        }
    }
}
constexpr int RT_UST = 1025;
constexpr int RT_P = 0, RT_L = 32768;
constexpr int RT_HIST = TAB_OFF, RT_BASE = TAB_OFF + 128, RT_SE = TAB_OFF + 256, RT_SG = RT_SE + 512, RT_SS = RT_SG + 512;
static_assert(32 * RT_UST * 4 <= SCR_BYTES, "router LDS map");
__device__ __forceinline__ void ph_router(const Args& a, LAS unsigned char* lds, int bid, int nb) {
    const float* hh_ = a.in[0]; const bf16* dl_ = (const bf16*)(a.ws + WS_H); const float* g = a.in[13]; const float* wr = a.in[14]; const float* br = a.in[15];
    unsigned char* u2 = a.ws + WS_U2; int* toke = (int*)(a.ws + WS_TOKE); int* toks = (int*)(a.ws + WS_TOKS);
    int* ltok = (int*)(a.ws + WS_LTOK); float* lgate = (float*)(a.ws + WS_LGATE); unsigned* cnt = (unsigned*)(a.ws + WS_CTL);
    const int tid = threadIdx.x, lane = tid & 63, w = tid >> 6, qc = lane & 31, hh = lane >> 5;
    LAS float* U = (LAS float*)lds; LAS float* P = (LAS float*)(lds + RT_P); LAS float* L = (LAS float*)(lds + RT_L);
    LAS unsigned* hist = (LAS unsigned*)(lds + RT_HIST); LAS unsigned* basev = (LAS unsigned*)(lds + RT_BASE);
    LAS int* se = (LAS int*)(lds + RT_SE); LAS float* sg = (LAS float*)(lds + RT_SG); LAS unsigned* ssl = (LAS unsigned*)(lds + RT_SS);
    float breg[64];
#pragma unroll
    for (int kk = 0; kk < 64; ++kk) breg[kk] = wr[(size_t)(128 * w + 2 * kk + hh) * NE + qc];
    float4 gq[4];
#pragma unroll
    for (int j = 0; j < 4; ++j) gq[j] = ((const float4*)g)[lane + 64 * j];
    const float brv = br[tid & 31];
    float4 vv[4][4]; uint2 dd[4][4];
#define RT_LOAD(tile_) do { const int tk_ = (tile_) * 32; _Pragma("unroll") for (int rr = 0; rr < 4; ++rr) { const int row = w * 4 + rr; \
        const float4* xr = (const float4*)(hh_ + (size_t)(tk_ + row) * DM); const uint2* dr = (const uint2*)(dl_ + (size_t)(tk_ + row) * DM); \
        _Pragma("unroll") for (int j = 0; j < 4; ++j) { vv[rr][j] = xr[lane + 64 * j]; dd[rr][j] = dr[lane + 64 * j]; } } } while (0)
    if (bid < T / 32) RT_LOAD(bid);
    for (int tile = bid; tile < T / 32; tile += nb) {
        const int tk0 = tile * 32;
        __syncthreads();
        if (tid < NE) hist[tid] = 0u;
#pragma unroll
        for (int rr = 0; rr < 4; ++rr) { const int row = w * 4 + rr; float4 (&v)[4] = vv[rr]; float s = 0.f;
#pragma unroll
            for (int j = 0; j < 4; ++j) { const uint2 dw = dd[rr][j]; v[j].x += bflo(dw.x); v[j].y += bfhi(dw.x); v[j].z += bflo(dw.y); v[j].w += bfhi(dw.y);
                s += v[j].x * v[j].x + v[j].y * v[j].y + v[j].z * v[j].z + v[j].w * v[j].w; }
            const float rs = rsqrtf(wave_sum(s) * (1.f / DM) + EPS);
#pragma unroll
            for (int j = 0; j < 4; ++j) { const float4 gg = gq[j];
                const float un[4] = {v[j].x * rs * gg.x, v[j].y * rs * gg.y, v[j].z * rs * gg.z, v[j].w * rs * gg.w};
                *(unsigned*)(u2 + (size_t)(tk0 + row) * DM + 4 * lane + 256 * j) = pk4_fp8(un[0], un[1], un[2], un[3]);
                LAS float* ur = U + row * RT_UST + 4 * lane + 256 * j; ur[0] = un[0]; ur[1] = un[1]; ur[2] = un[2]; ur[3] = un[3]; } }
        if (tile + nb < T / 32) RT_LOAD(tile + nb);
        __syncthreads();
        f32x16 acc;
#pragma unroll
        for (int i = 0; i < 16; ++i) acc[i] = 0.f;
#pragma unroll
        for (int kk = 0; kk < 64; ++kk) acc = __builtin_amdgcn_mfma_f32_32x32x2f32(U[qc * RT_UST + 128 * w + 2 * kk + hh], breg[kk], acc, 0, 0, 0);
        __syncthreads();
#pragma unroll
        for (int i = 0; i < 16; ++i) P[(w * 32 + (i & 3) + 8 * (i >> 2) + 4 * hh) * 32 + qc] = acc[i];
        __syncthreads();
#pragma unroll
        for (int o2 = 0; o2 < 2; ++o2) { const int o = tid + 512 * o2; float sacc = brv;
#pragma unroll
            for (int ww = 0; ww < 8; ++ww) sacc += P[ww * 1024 + o];
            L[o] = sacc; }
        __syncthreads();
#pragma unroll 1
        for (int it = 0; it < 2; ++it) { const int tok = w * 4 + it * 2 + hh;
            float cur = L[tok * 32 + qc]; int idx[4]; float val[4];
#pragma unroll
            for (int k = 0; k < 4; ++k) { const float m = half32_max(cur);
                const unsigned long long bal = __ballot(cur == m); const unsigned hb = hh ? (unsigned)(bal >> 32) : (unsigned)bal; const int wi = __ffs((int)hb) - 1;
                idx[k] = wi; val[k] = m; if (qc == wi) cur = -INFINITY; }
            if (qc < 4) { const float e1 = __expf(val[1] - val[0]), e2 = __expf(val[2] - val[0]), e3 = __expf(val[3] - val[0]); const float inv = 1.f / (1.f + e1 + e2 + e3);
                const float gsel = qc == 0 ? inv : (qc == 1 ? e1 * inv : (qc == 2 ? e2 * inv : e3 * inv)); const int esel = qc == 0 ? idx[0] : (qc == 1 ? idx[1] : (qc == 2 ? idx[2] : idx[3]));
                se[tok * 4 + qc] = esel; sg[tok * 4 + qc] = gsel; ssl[tok * 4 + qc] = atomicAdd((unsigned*)&hist[esel], 1u); } }
        __syncthreads();
        if (tid < NE) basev[tid] = atomicAdd(&cnt[tid], hist[tid]);
        __syncthreads();
        if (tid < 128) { const int tok = tid >> 2, e = se[tid]; const unsigned sl = basev[e] + ssl[tid]; const int tg = tk0 + tok;
            toke[tg * 4 + (tid & 3)] = e; toks[tg * 4 + (tid & 3)] = (int)sl; ltok[(size_t)e * T + sl] = tg; lgate[(size_t)e * T + sl] = sg[tid]; }
    }
}
#undef RT_LOAD
__device__ __forceinline__ void moe_setup(const Args& a, LAS unsigned char* lds, int nct, int G, int c, bool gather, unsigned pitch, bool plain) {
    LAS int* s_cnt = (LAS int*)(lds + TB_CNT); LAS int* s_ptile = (LAS int*)(lds + TB_PTILE); LAS int* s_re = (LAS int*)(lds + TB_RE); LAS int* s_tstart = (LAS int*)(lds + TB_TSTART);
    LAS int* s_misc = (LAS int*)(lds + TB_MISC); LAS int* s_units = (LAS int*)(lds + TB_UNITS); LAS unsigned* rowtab = (LAS unsigned*)(lds + TB_ROWTAB);
    const unsigned* cnt = (const unsigned*)(a.ws + WS_CTL); const int* ltok = (const int*)(a.ws + WS_LTOK);
    const int tid = threadIdx.x;
    __syncthreads();
    if (tid < NE) s_cnt[tid] = (int)cnt[tid];
    __syncthreads();
    if (tid == 0) { int pt = 0, ts = 0;
        for (int e = 0; e < NE; ++e) { const int cn = s_cnt[e], re = (cn + 255) >> 8; s_ptile[e] = pt; s_re[e] = re; s_tstart[e] = ts; pt += re; ts += re * nct; }
        s_ptile[NE] = pt; s_tstart[NE] = ts; s_misc[0] = ts; s_misc[1] = (ts + G - 1) / G; }
    __syncthreads();
    if (tid < 16) { const int nwg = s_misc[0]; const long L = (long)tid * G + c; int pm = -1, pn = 0;
        if (L < nwg) { int wgid = (int)L; { const int q = nwg / 8, r = nwg % 8, xcd = wgid % 8, off = wgid / 8; wgid = (xcd < r ? xcd * (q + 1) : r * (q + 1) + (xcd - r) * q) + off; }
            int e = 0; while (wgid >= s_tstart[e + 1]) ++e;
            const int local = wgid - s_tstart[e], re = s_re[e]; pm = s_ptile[e] + local % re; pn = e * nct + local / re; }
        s_units[2 * tid] = pm; s_units[2 * tid + 1] = pn; }
    __syncthreads();
    if (gather) { const int nr = s_misc[1] < 9 ? s_misc[1] : 9;
        LAS float* btab = (LAS float*)(lds + 131072); LAS float* gtab = btab + 5 * 256;
        float bv_[5], gv_[5]; unsigned rv_[5];
#pragma unroll
        for (int q = 0; q < 5; ++q) { const int idx = tid + q * NT, i = idx >> 8, r = idx & 255; bv_[q] = 0.f; gv_[q] = 0.f; rv_[q] = 0u;
            if (i < nr) { const int pm = s_units[2 * i]; if (pm >= 0) { const int e = s_units[2 * i + 1] / nct, ct = s_units[2 * i + 1] % nct, sl = (pm - s_ptile[e]) * 256 + r; const bool ok = sl < s_cnt[e];
                if (plain) { bv_[q] = a.in[19][(size_t)e * 1024 + ct * 256 + r]; gv_[q] = ok ? ((const float*)(a.ws + WS_LGATE))[(size_t)e * T + sl] : 0.f; rv_[q] = (unsigned)(pm * 256 + r) * pitch; }
                else { bv_[q] = a.in[17][(size_t)e * 2048 + (r < 128 ? 0 : 1024 - 128) + ct * 128 + r]; rv_[q] = ok ? (unsigned)ltok[(size_t)e * T + sl] * pitch : 0u; } } } }
#pragma unroll
        for (int q = 0; q < 5; ++q) { const int idx = tid + q * NT, i = idx >> 8; if (i < nr) { btab[idx] = bv_[q]; rowtab[idx] = rv_[q]; if (plain) gtab[idx] = gv_[q]; } } }
    __syncthreads();
}
typedef float float2v __attribute__((ext_vector_type(2)));
__device__ __forceinline__ void ph_final(const Args& a, LAS unsigned char* lds, int bid, int nb) {
    const float* hh = a.in[0]; const bf16* dl = (const bf16*)(a.ws + WS_H); const unsigned char* ys = a.ws + WS_YS; const int* toke = (const int*)(a.ws + WS_TOKE); const int* toks = (const int*)(a.ws + WS_TOKS);
    const unsigned* cnt = (const unsigned*)(a.ws + WS_CTL); const float* g = a.in[20]; float* out = a.out;
    LAS int* s_ps = (LAS int*)(lds + TB_PTILE);
    __syncthreads();
    LAS int* s_c = (LAS int*)(lds + TB_CNT); if (threadIdx.x < NE) s_c[threadIdx.x] = (int)cnt[threadIdx.x];
    __syncthreads();
    if (threadIdx.x == 0) { int pt = 0; for (int e = 0; e < NE; ++e) { s_ps[e] = pt; pt += (s_c[e] + 255) >> 8; } }
    __syncthreads();
    const int lane = threadIdx.x & 63, gw = bid * 8 + (threadIdx.x >> 6), ngw = nb * 8;
    size_t myoff = 0; { const int j = lane >> 2, k = lane & 3, r = gw + j * ngw; if (lane < 32 && r < T) myoff = ((size_t)s_ps[toke[r * 4 + k]] * 256 + toks[r * 4 + k]) * 1024; }
    for (int j = 0; gw + j * ngw < T; ++j) { const int r = gw + j * ngw;
        float4 v[4]; int wq[4][4];
        if (j < 8) {
#pragma unroll
            for (int k = 0; k < 4; ++k) { const int li = (j & 7) * 4 + k; const size_t off = ((size_t)(unsigned)__builtin_amdgcn_readlane((int)(unsigned)(myoff >> 32), li) << 32) | (size_t)(unsigned)__builtin_amdgcn_readlane((int)(unsigned)myoff, li);
#pragma unroll
                for (int jj = 0; jj < 4; ++jj) wq[k][jj] = *(const int*)(ys + off + 4 * lane + 256 * jj); } }
        else {
#pragma unroll
            for (int k = 0; k < 4; ++k) { const size_t off = ((size_t)s_ps[toke[r * 4 + k]] * 256 + toks[r * 4 + k]) * 1024;
#pragma unroll
                for (int jj = 0; jj < 4; ++jj) wq[k][jj] = *(const int*)(ys + off + 4 * lane + 256 * jj); } }
#pragma unroll
        for (int jj = 0; jj < 4; ++jj) { v[jj] = *(const float4*)(hh + (size_t)r * DM + 4 * lane + 256 * jj); const uint2 dw = *(const uint2*)(dl + (size_t)r * DM + 4 * lane + 256 * jj);
            v[jj].x += bflo(dw.x); v[jj].y += bfhi(dw.x); v[jj].z += bflo(dw.y); v[jj].w += bfhi(dw.y); }
#pragma unroll
        for (int k = 0; k < 4; ++k)
#pragma unroll
            for (int jj = 0; jj < 4; ++jj) { const int w = wq[k][jj];
                const float2v lo = __builtin_amdgcn_cvt_pk_f32_fp8(w, false), hi = __builtin_amdgcn_cvt_pk_f32_fp8(w, true);
                v[jj].x += lo[0] * (1.f / YS8_SCALE); v[jj].y += lo[1] * (1.f / YS8_SCALE); v[jj].z += hi[0] * (1.f / YS8_SCALE); v[jj].w += hi[1] * (1.f / YS8_SCALE); }
        float s = 0.f;
#pragma unroll
        for (int jj = 0; jj < 4; ++jj) s += v[jj].x * v[jj].x + v[jj].y * v[jj].y + v[jj].z * v[jj].z + v[jj].w * v[jj].w;
        const float rs = rsqrtf(wave_sum(s) * (1.f / DM) + EPS);
#pragma unroll
        for (int jj = 0; jj < 4; ++jj) { const float4 gg = *(const float4*)(g + 4 * lane + 256 * jj);
            *(float4*)(out + (size_t)r * DM + 4 * lane + 256 * jj) = make_float4(v[jj].x * rs * gg.x, v[jj].y * rs * gg.y, v[jj].z * rs * gg.z, v[jj].w * rs * gg.w); }
    }
}

__global__ void __launch_bounds__(NT, 2) mk_fwd(Args args) {
    extern __shared__ __attribute__((aligned(16))) unsigned char smem[];
    LAS unsigned char* lds = (LAS unsigned char*)smem;
    const int tid = threadIdx.x, bid = blockIdx.x, G = gridDim.x;
    unsigned char* ws = args.ws;
    const int lo = args.ph_lo, hi = args.ph_hi;
#define IN(k) (lo <= (k) && (k) < hi)
#define BOTH(k) (IN(k) && IN((k) + 1))
    XcdBarrier bar; bar.bar = (unsigned*)(ws + WS_CTL) + CW_BAR + args.bar_sel * XCD_BAR_WORDS; bar.x = 0; bar.st = nullptr;
    if (MK_ONE_LAUNCH) {
        if (tid < 4) ((volatile LAS unsigned*)(lds + XBW_OFF))[tid] = 0u;
        __syncthreads();
        bar = xcd_barrier_post((unsigned*)(ws + WS_CTL) + CW_BAR + args.bar_sel * XCD_BAR_WORDS, (volatile LAS unsigned*)(lds + XBW_OFF));
    }
#define GRID_BAR() do { if (MK_ONE_LAUNCH) xcd_barrier(bar); } while (0)

    if (IN(0)) { ph_prologue(args, lds, bid, G); if (BOTH(0)) GRID_BAR(); }
    if (IN(1)) {
        const int gp = G > 192 ? 192 : G;
        if (bid < gp) {
            pg8::Gemm g{(const bf16*)(ws + WS_U), (const bf16*)(ws + WS_WIN), T, NP, DM}; pg8::StaticOrder S; S.init(T, NP, gp, bid);
            pg8::EpiStoreBf16 E{(bf16*)(ws + WS_PROJ), NP};
            pg8::gemm_phase<pg8::EpiStoreBf16, pg8::StaticOrder, true, true, false>(lds, g, S, E); }
        __syncthreads();
        moe_weight_queue(args, lds, bid);
        if (BOTH(1)) GRID_BAR();
    }
    if (IN(3)) { ph_ssd_local(args, lds, bid, G); if (BOTH(3)) GRID_BAR(); }
    if (IN(4)) { ph_scan(args, bid, G); if (BOTH(4)) GRID_BAR(); }
    if (IN(5)) { ph_ssd_out(args, lds, bid, G); ph_attn(args, lds, bid, G); if (BOTH(5)) GRID_BAR(); }
    if (IN(7)) {
        __syncthreads();
        pg8::Gemm g{(const bf16*)(ws + WS_CAT), (const bf16*)(ws + WS_WOUT), T, DM, DM}; pg8::StaticOrder S; S.init(T, DM, G, bid);
        LAS float* r1 = (LAS float*)(lds + TAB_OFF); LAS float* r2 = r1 + 256;
        { pg8::Unit u0; if (S.next(0, u0) && tid < 256) { const size_t row = (size_t)u0.pm * 256 + tid; const float* sd = (const float*)(ws + WS_SSSD) + row * 2; const float* sa = (const float*)(ws + WS_SSAT) + row * 8;
            const float s1 = sd[0] + sd[1], s2 = ((sa[0] + sa[1]) + (sa[2] + sa[3])) + ((sa[4] + sa[5]) + (sa[6] + sa[7]));
            r1[tid] = rsqrtf(s1 * (1.f / 512) + EPS); r2[tid] = rsqrtf(s2 * (1.f / 512) + EPS); } }
        __syncthreads();
        pg8::EpiResScale E{(bf16*)(ws + WS_H), DM, r1, r2};
        pg8::gemm_phase<pg8::EpiResScale, pg8::StaticOrder, false, true, false>(lds, g, S, E);
        if (BOTH(7)) GRID_BAR();
    }
    if (IN(8)) { ph_router(args, lds, bid, G); if (BOTH(8)) GRID_BAR(); }
    if (IN(9)) {
        moe_setup(args, lds, 8, G, bid, true, 1024u, false);
        pg8::Gemm g{(const bf16*)(ws + WS_U2), (const bf16*)(ws + WS_W1), MAXROWS, NE * 2048, DM / 2};
        pg8::MoeOrder S{(const LAS int*)(lds + TB_UNITS), (const LAS unsigned*)(lds + TB_ROWTAB), __builtin_amdgcn_readfirstlane(*(const LAS int*)(lds + TB_MISC + 4))};
        pg8::EpiSwiglu E{ws + WS_ACT, (const LAS float*)(lds + 131072), 1.f / W8_SCALE, ACT8_SCALE};
        pg8::gemm_phase<pg8::EpiSwiglu, pg8::MoeOrder, true, true, true, true>(lds, g, S, E);
        if (BOTH(9)) GRID_BAR();
    }
    if (IN(10)) {
        moe_setup(args, lds, 4, G, bid, true, 1024u, true);
        pg8::Gemm g{(const bf16*)(ws + WS_ACT), (const bf16*)(ws + WS_W2), MAXROWS, NE * 1024, DM / 2};
        pg8::MoeOrder S{(const LAS int*)(lds + TB_UNITS), (const LAS unsigned*)(lds + TB_ROWTAB), __builtin_amdgcn_readfirstlane(*(const LAS int*)(lds + TB_MISC + 4))};
        pg8::EpiMoe2 E{ws + WS_YS, (const LAS float*)(lds + 131072), (const LAS float*)(lds + 131072) + 5 * 256, 1.f / (W8_SCALE * ACT8_SCALE), YS8_SCALE};
        pg8::gemm_phase<pg8::EpiMoe2, pg8::MoeOrder, true, true, true, true>(lds, g, S, E);
        if (BOTH(10)) GRID_BAR();
    }
    if (IN(11)) { ph_final(args, lds, bid, G); }
#undef IN
#undef BOTH
}

extern "C" void kernel_launch(void* const* d_in, const int* in_sizes, int n_in, void* d_out, int out_size, void* d_ws, size_t ws_size, hipStream_t stream) {
    static int grid = 0;
    if (grid == 0) {
        if (n_in != 21 || out_size != T * DM || ws_size < WS_END) { fprintf(stderr, "kernel_launch: unexpected shapes (n_in %d out %d ws %zu)\n", n_in, out_size, ws_size); grid = -1; return; }
        int dev = 0, cus = 0, per_cu = 0;
        if (hipGetDevice(&dev) != hipSuccess || hipDeviceGetAttribute(&cus, hipDeviceAttributeMultiprocessorCount, dev) != hipSuccess) { grid = -1; return; }
        if (hipFuncSetAttribute((const void*)mk_fwd, hipFuncAttributeMaxDynamicSharedMemorySize, LDS_BYTES) != hipSuccess) { fprintf(stderr, "kernel_launch: hipFuncSetAttribute failed\n"); grid = -1; return; }
        if (hipOccupancyMaxActiveBlocksPerMultiprocessor(&per_cu, (const void*)mk_fwd, NT, LDS_BYTES) != hipSuccess || per_cu < 1) { fprintf(stderr, "kernel_launch: occupancy query says %d blocks per CU\n", per_cu); }
        (void)hipGetLastError();
        grid = cus;
    }
    if (grid < 0) return;
    if (hipMemsetAsync((char*)d_ws + WS_CTL, 0, 65536, stream) != hipSuccess) return;
    Args a{};
    for (int i = 0; i < 21; ++i) a.in[i] = (const float*)d_in[i];
    a.out = (float*)d_out; a.ws = (unsigned char*)d_ws;
#if MK_ONE_LAUNCH
    a.ph_lo = 0; a.ph_hi = NPH;
    hipLaunchKernelGGL(mk_fwd, dim3(grid), dim3(NT), LDS_BYTES, stream, a);
#if defined(PROBE_LO)
    a.ph_lo = PROBE_LO; a.ph_hi = PROBE_HI; a.bar_sel = 1;
    hipLaunchKernelGGL(mk_fwd, dim3(grid), dim3(NT), LDS_BYTES, stream, a);
#endif
#if defined(PROBE_LO2)
    a.ph_lo = PROBE_LO2; a.ph_hi = PROBE_HI2; a.bar_sel = 2;
    hipLaunchKernelGGL(mk_fwd, dim3(grid), dim3(NT), LDS_BYTES, stream, a);
#endif
#else
    for (int ph = 0; ph < NPH; ++ph) { a.ph_lo = ph; a.ph_hi = ph + 1; hipLaunchKernelGGL(mk_fwd, dim3(grid), dim3(NT), LDS_BYTES, stream, a); }
#endif
}
```

```cpp
#include <hip/hip_runtime.h>
#include <cstdio>
#include <cstdint>

#ifndef MK_ONE_LAUNCH
#define MK_ONE_LAUNCH 1
#endif

constexpr int BATCH = 8, SEQ = 2048, T = BATCH * SEQ, DM = 1024, DPROJ = 2312;
constexpr int NCH = SEQ / 128;
constexpr int NE = 32, TOPK = 4;
constexpr int O_DT = 1536;
constexpr int NP = 2304;
constexpr int PZ = 0, PXBC = 512, PQ = 1536, PK = 2048, PV = 2176;
constexpr float EPS = 1e-5f;
constexpr int NT = 512;
constexpr int MAXROWS = T * TOPK + NE * 256;
constexpr int NPH = 12;

__constant__ int c_bucket[129] = {0, 1, 2, 3, 4, 5, 6, 7, 8, 9, 10, 11, 12, 13, 14, 15, 16, 16, 16, 17, 17, 18, 18, 18, 19, 19, 19, 20, 20, 20, 20, 21, 21, 21, 21, 22, 22, 22, 22, 22, 23, 23, 23, 23, 23, 23, 24, 24, 24, 24, 24, 24, 25, 25, 25, 25, 25, 25, 25, 26, 26, 26, 26, 26, 26, 26, 26, 27, 27, 27, 27, 27, 27, 27, 27, 27, 27, 28, 28, 28, 28, 28, 28, 28, 28, 28, 28, 29, 29, 29, 29, 29, 29, 29, 29, 29, 29, 29, 29, 30, 30, 30, 30, 30, 30, 30, 30, 30, 30, 30, 30, 30, 30, 31, 31, 31, 31, 31, 31, 31, 31, 31, 31, 31, 31, 31, 31, 31, 31};

constexpr size_t MiB = 1ull << 20;
constexpr size_t WS_CTL = 0, CTL_ZERO_BYTES = 1 * MiB;
constexpr int CW_BAR = 4096;
static_assert((CW_BAR + 3 * 3456) * 4 <= 65536, "control words inside the per-call memset");
constexpr size_t WS_WIN = 1 * MiB;
constexpr size_t WS_WOUT = WS_WIN + (size_t)NP * DM * 2;
constexpr size_t WS_W1 = WS_WOUT + (size_t)DM * DM * 2;
constexpr size_t WS_W2 = WS_W1 + (size_t)NE * 2048 * 1024 * 2;
constexpr size_t WS_U = WS_W2 + (size_t)NE * 1024 * 1024 * 2;
constexpr size_t WS_DTRAW = WS_U + (size_t)T * DM * 2;
constexpr size_t WS_PROJ = WS_DTRAW + (size_t)T * 8 * 4;
constexpr size_t WS_XC = WS_PROJ + (size_t)T * NP * 2;
constexpr size_t WS_DT = WS_XC + (size_t)T * 1024 * 4;
constexpr size_t WS_ACUM = WS_DT + (size_t)T * 8 * 4;
constexpr size_t WS_CDEC = WS_ACUM + (size_t)T * 8 * 4;
constexpr size_t WS_STATES = WS_CDEC + 1 * MiB;
constexpr size_t WS_PREV = WS_STATES + (size_t)BATCH * NCH * 8 * 8192 * 4;
constexpr size_t WS_YG = WS_PREV + (size_t)BATCH * NCH * 8 * 8192 * 4;
constexpr size_t WS_YGB = WS_YG;
constexpr size_t WS_SSSD = WS_YG + (size_t)T * 512 * 2;
constexpr size_t WS_AO = WS_YG + (size_t)T * 512 * 4;
constexpr size_t WS_SSAT = WS_AO + (size_t)T * 512 * 2;
constexpr size_t WS_CAT = WS_SSAT + (size_t)T * 8 * 4;
constexpr size_t WS_H = WS_CAT + (size_t)T * DM * 2;
constexpr size_t WS_U2 = WS_H + (size_t)T * DM * 4;
constexpr size_t WS_TOKE = WS_U2 + (size_t)T * DM * 2;
constexpr size_t WS_TOKS = WS_TOKE + (size_t)T * 4 * 4;
constexpr size_t WS_LTOK = WS_TOKS + (size_t)T * 4 * 4;
constexpr size_t WS_LGATE = WS_LTOK + (size_t)NE * T * 4;
constexpr size_t WS_ACT = WS_LGATE + (size_t)NE * T * 4;
constexpr size_t WS_YS = WS_ACT + (size_t)MAXROWS * 1024 * 2;
constexpr size_t WS_END = WS_YS + (size_t)MAXROWS * 1024 * 2;
static_assert(WS_END <= 1024 * MiB, "workspace");

constexpr int SCR_BYTES = 143360;
constexpr int TAB_OFF = SCR_BYTES;
constexpr int TB_CNT = TAB_OFF, TB_PTILE = TAB_OFF + 128, TB_RE = TAB_OFF + 272, TB_TSTART = TAB_OFF + 400, TB_MISC = TAB_OFF + 544, TB_UNITS = TAB_OFF + 576, TB_ROWTAB = TAB_OFF + 1024;
constexpr int XBW_OFF = TB_ROWTAB + 9 * 256 * 4;
constexpr int LDS_BYTES = 163840;
static_assert(XBW_OFF + 16 <= LDS_BYTES && XBW_OFF % 16 == 0, "LDS map");

#define GAS __attribute__((address_space(1)))
#define LAS __attribute__((address_space(3)))
typedef unsigned short bf16;
typedef unsigned v4u __attribute__((ext_vector_type(4)));
#define LDS_WAIT() asm volatile("s_waitcnt lgkmcnt(0)" ::: "memory")
#define VM_WAIT() asm volatile("s_waitcnt vmcnt(0)" ::: "memory")
__device__ __forceinline__ unsigned f2bf(float f) { unsigned u = __builtin_bit_cast(unsigned, f); return (u + 0x7fffu + ((u >> 16) & 1u)) >> 16; }
__device__ __forceinline__ unsigned pk2(float lo, float hi) { return f2bf(lo) | (f2bf(hi) << 16); }
__device__ __forceinline__ float bf2f(unsigned short b) { return __uint_as_float((unsigned)b << 16); }
__device__ __forceinline__ float bflo(unsigned w) { return __uint_as_float(w << 16); }
__device__ __forceinline__ float bfhi(unsigned w) { return __uint_as_float(w & 0xffff0000u); }

namespace pg8 {
#define PG8_LAS __attribute__((address_space(3)))
typedef unsigned short bf16_t;
typedef short bf16x8 __attribute__((ext_vector_type(8)));
typedef float f32x4 __attribute__((ext_vector_type(4)));
typedef unsigned u32x4 __attribute__((ext_vector_type(4)));
typedef unsigned u32x2 __attribute__((ext_vector_type(2)));
typedef int i32x8 __attribute__((ext_vector_type(8)));
typedef int i32x4 __attribute__((ext_vector_type(4)));
constexpr int BM = 256, BK = 64, HALF = 128, HTB = HALF * BK * 2  , STAGE_BYTES = 8 * HTB, NXCD = 8, WGM = 8;

__host__ __device__ __forceinline__ int lds_byte(int r, int c) { const int st = (r >> 4) * 2 + (c >> 5), rr = r & 15, cc = c & 31, ob = rr * 64 + cc * 2; return st * 1024 + (ob ^ (((ob >> 9) & 1) << 5)); }
__host__ __device__ __forceinline__ void stage_rc(int b, int& R, int& C) { const int st = b / 1024, sb = b % 1024, swz = sb ^ (((sb >> 9) & 1) << 5); R = (st >> 1) * 16 + swz / 64; C = (st & 1) * 32 + (swz % 64) / 2; }
__host__ __device__ __forceinline__ int perm32(int rho) { const int n = rho >> 4, i = rho & 15; return 8 * (i >> 2) + 4 * n + (i & 3); }

struct Unit { int pm, pn, rid; };
struct Gemm { const bf16_t* A; const bf16_t* Bt; int M, N, K; };

struct StaticOrder {
    int nM, nN, nwg, G, c;
    __host__ __device__ __forceinline__ void init(int M, int N, int G_, int c_) { nM = M / BM; nN = N / BM; nwg = nM * nN; G = G_; c = c_; }
    __host__ __device__ __forceinline__ bool next(int i, Unit& u) const {
        const long L = (long)i * G + c; if (L >= nwg) return false;
        int wgid = (int)L; { const int q = nwg / NXCD, r = nwg % NXCD, xcd = wgid % NXCD, off = wgid / NXCD; wgid = (xcd < r ? xcd * (q + 1) : r * (q + 1) + (xcd - r) * q) + off; }
        const int nig = WGM * nN, gid = wgid / nig, fm = gid * WGM, gsz = (nM - fm) < WGM ? (nM - fm) : WGM;
        u.pm = fm + ((wgid % nig) % gsz); u.pn = (wgid % nig) / gsz; u.rid = 0; return true;
    }
    __device__ __forceinline__ void a_ready(const Unit&) const {}
    __device__ __forceinline__ void done(const Unit&) const {}
};


typedef float f32x2 __attribute__((ext_vector_type(2)));
__device__ __forceinline__ unsigned cvt_pk_bf16(float lo, float hi) { unsigned r; asm volatile("v_cvt_pk_bf16_f32 %0, %1, %2" : "=v"(r) : "v"(lo), "v"(hi)); return r; }

struct EpiStoreBf16 {
    static constexpr bool PERM = true, AFTER_DRAIN = false, HAS_MID = false, HAS_PRE = false;
    bf16_t* O; int ldc;
    __device__ __forceinline__ void operator()(const f32x4 (&acc)[2][2][4][2], const Unit& u, int wr, int wc, int fr, int fq) const {
        const int row0 = u.pm * BM + wr * 64 + fr, col0 = u.pn * BM + wc * 32 + 8 * fq;
#pragma unroll
        for (int ai = 0; ai < 2; ++ai)
#pragma unroll
            for (int m = 0; m < 4; ++m) { bf16_t* rowp = O + (size_t)(row0 + ai * HALF + m * 16) * ldc + col0;
#pragma unroll
                for (int bj = 0; bj < 2; ++bj) { const f32x4 v0 = acc[ai][bj][m][0], v1 = acc[ai][bj][m][1];
                    u32x4 w; w.x = cvt_pk_bf16(v0[0], v0[1]); w.y = cvt_pk_bf16(v0[2], v0[3]); w.z = cvt_pk_bf16(v1[0], v1[1]); w.w = cvt_pk_bf16(v1[2], v1[3]);
                    *(u32x4*)(rowp + bj * HALF) = w; } }
    }
};
struct EpiResF32 {
    static constexpr bool PERM = false, AFTER_DRAIN = false, HAS_MID = false, HAS_PRE = false;
    const float* __restrict__ base; float* __restrict__ C; int ldc;
    __device__ __forceinline__ void operator()(const f32x4 (&acc)[2][2][4][2], const Unit& u, int wr, int wc, int fr, int fq) const {
        const int row0 = u.pm * BM + wr * 64 + fr, col0 = u.pn * BM + wc * 32 + 4 * fq;
#pragma unroll
        for (int ai = 0; ai < 2; ++ai)
#pragma unroll
            for (int m = 0; m < 4; ++m) { const size_t off = (size_t)(row0 + ai * HALF + m * 16) * ldc + col0; f32x4 bs[2][2];
#pragma unroll
                for (int bj = 0; bj < 2; ++bj)
#pragma unroll
                    for (int n = 0; n < 2; ++n) bs[bj][n] = __builtin_nontemporal_load((const f32x4*)(base + off + bj * HALF + n * 16));
#pragma unroll
                for (int bj = 0; bj < 2; ++bj)
#pragma unroll
                    for (int n = 0; n < 2; ++n) *(f32x4*)(C + off + bj * HALF + n * 16) = bs[bj][n] + acc[ai][bj][m][n]; }
    }
};
struct EpiResScale {
    static constexpr bool PERM = true, AFTER_DRAIN = false, HAS_MID = true, HAS_PRE = true;
    bf16_t* D; int ldc; const PG8_LAS float* r1; const PG8_LAS float* r2; const float* ssd; const float* ssa;
    __device__ __forceinline__ void pre(const Unit& u) const {
        const int t = threadIdx.x;
        if (t < 256) { const size_t row = (size_t)u.pm * 256 + t; const float* sd = ssd + row * 2; const float* sa = ssa + row * 8;
            const float s1 = sd[0] + sd[1], s2 = ((sa[0] + sa[1]) + (sa[2] + sa[3])) + ((sa[4] + sa[5]) + (sa[6] + sa[7]));
            ((PG8_LAS float*)r1)[t] = rsqrtf(s1 * (1.f / 512) + 1e-5f); ((PG8_LAS float*)r2)[t] = rsqrtf(s2 * (1.f / 512) + 1e-5f); }
    }
    __device__ __forceinline__ void mid(f32x4 (&acc)[2][2][4][2], const Unit&, int wr, int, int fr, int) const {
#pragma unroll
        for (int ai = 0; ai < 2; ++ai)
#pragma unroll
            for (int m = 0; m < 4; ++m) { const int rl = ai * HALF + wr * 64 + m * 16 + fr; const float f = r1[rl] / r2[rl];
#pragma unroll
                for (int bj = 0; bj < 2; ++bj)
#pragma unroll
                    for (int n = 0; n < 2; ++n) acc[ai][bj][m][n] *= f; }
    }
    __device__ __forceinline__ void operator()(const f32x4 (&acc)[2][2][4][2], const Unit& u, int wr, int wc, int fr, int fq) const {
        const int row0 = u.pm * BM + wr * 64 + fr, col0 = u.pn * BM + wc * 32 + 8 * fq;
#pragma unroll
        for (int ai = 0; ai < 2; ++ai)
#pragma unroll
            for (int m = 0; m < 4; ++m) { bf16_t* rowp = D + (size_t)(row0 + ai * HALF + m * 16) * ldc + col0; const float f = r2[ai * HALF + wr * 64 + m * 16 + fr];
#pragma unroll
                for (int bj = 0; bj < 2; ++bj) { const f32x4 v0 = acc[ai][bj][m][0] * f, v1 = acc[ai][bj][m][1] * f;
                    u32x4 w; w.x = cvt_pk_bf16(v0[0], v0[1]); w.y = cvt_pk_bf16(v0[2], v0[3]); w.z = cvt_pk_bf16(v1[0], v1[1]); w.w = cvt_pk_bf16(v1[2], v1[3]);
                    *(u32x4*)(rowp + bj * HALF) = w; } }
    }
};
struct EpiSwiglu {
    static constexpr bool PERM = true, AFTER_DRAIN = false, HAS_MID = false, HAS_PRE = false;
    unsigned char* act; const PG8_LAS float* btab; float dq, asc;
    __device__ __forceinline__ void operator()(const f32x4 (&acc)[2][2][4][2], const Unit& u, int wr, int wc, int fr, int fq) const {
        const int e = u.pn >> 3, ct = u.pn & 7, colo = ct * 128 + wc * 32 + 8 * fq;
        const PG8_LAS float* bg = btab + u.rid * 256 + wc * 32 + 8 * fq; (void)e;
        const f32x4 g0 = *(const PG8_LAS f32x4*)bg, g1 = *(const PG8_LAS f32x4*)(bg + 4), l0 = *(const PG8_LAS f32x4*)(bg + 128), l1 = *(const PG8_LAS f32x4*)(bg + 132);
        const int row0 = u.pm * BM + wr * 64 + fr;
#pragma unroll
        for (int ai = 0; ai < 2; ++ai)
#pragma unroll
            for (int m = 0; m < 4; ++m) {
                const f32x4 xg[2] = {acc[ai][0][m][0] * dq + g0, acc[ai][0][m][1] * dq + g1}; const f32x4 xl[2] = {acc[ai][1][m][0] * dq + l0, acc[ai][1][m][1] * dq + l1};
                float o[8];
#pragma unroll
                for (int q = 0; q < 4; ++q) {
                    f32x2 a2 = {xg[q >> 1][2 * (q & 1)], xg[q >> 1][2 * (q & 1) + 1]}, b2 = {xl[q >> 1][2 * (q & 1)], xl[q >> 1][2 * (q & 1) + 1]};
                    a2 = __builtin_elementwise_min(a2, (f32x2){7.f, 7.f}); b2 = __builtin_elementwise_min(__builtin_elementwise_max(b2, (f32x2){-7.f, -7.f}), (f32x2){7.f, 7.f});
                    const f32x2 t2 = a2 * (-1.702f * 1.4426950408889634f); f32x2 e2; e2.x = __builtin_amdgcn_exp2f(t2.x); e2.y = __builtin_amdgcn_exp2f(t2.y);
                    const f32x2 d2 = e2 + 1.f; f32x2 r2; r2.x = __builtin_amdgcn_rcpf(d2.x); r2.y = __builtin_amdgcn_rcpf(d2.y);
                    const f32x2 o2 = (a2 * r2) * (b2 * asc + asc); o[2 * q] = o2.x; o[2 * q + 1] = o2.y; }
                int w0 = 0, w1 = 0; w0 = __builtin_amdgcn_cvt_pk_fp8_f32(o[0], o[1], w0, false); w0 = __builtin_amdgcn_cvt_pk_fp8_f32(o[2], o[3], w0, true);
                w1 = __builtin_amdgcn_cvt_pk_fp8_f32(o[4], o[5], w1, false); w1 = __builtin_amdgcn_cvt_pk_fp8_f32(o[6], o[7], w1, true);
                u32x2 w; w.x = (unsigned)w0; w.y = (unsigned)w1;
                *(u32x2*)(act + (size_t)(row0 + ai * HALF + m * 16) * 1024 + colo) = w; }
    }
};
struct EpiMoe2 {
    static constexpr bool PERM = true, AFTER_DRAIN = false, HAS_MID = false, HAS_PRE = false;
    unsigned char* ys; const PG8_LAS float* btab; const PG8_LAS float* gtab; float dq, ysc;
    __device__ __forceinline__ void operator()(const f32x4 (&acc)[2][2][4][2], const Unit& u, int wr, int wc, int fr, int fq) const {
        const int e = u.pn >> 2, ct = u.pn & 3, colb = ct * 256 + wc * 32 + 8 * fq;
        (void)e;
        f32x4 bv[2][2];
#pragma unroll
        for (int bj = 0; bj < 2; ++bj)
#pragma unroll
            for (int n = 0; n < 2; ++n) bv[bj][n] = *(const PG8_LAS f32x4*)(btab + u.rid * 256 + bj * HALF + wc * 32 + 8 * fq + 4 * n);
        const int row0 = u.pm * BM + wr * 64 + fr;
#pragma unroll
        for (int ai = 0; ai < 2; ++ai)
#pragma unroll
            for (int m = 0; m < 4; ++m) { const float gt = gtab[u.rid * 256 + ai * HALF + wr * 64 + m * 16 + fr] * ysc;
                unsigned char* rowp = ys + (size_t)(row0 + ai * HALF + m * 16) * 1024 + colb;
#pragma unroll
                for (int bj = 0; bj < 2; ++bj) { f32x4 v0 = (acc[ai][bj][m][0] * dq + bv[bj][0]) * gt, v1 = (acc[ai][bj][m][1] * dq + bv[bj][1]) * gt;
                    v0 = __builtin_elementwise_min(__builtin_elementwise_max(v0, (f32x4){-440.f, -440.f, -440.f, -440.f}), (f32x4){440.f, 440.f, 440.f, 440.f});
                    v1 = __builtin_elementwise_min(__builtin_elementwise_max(v1, (f32x4){-440.f, -440.f, -440.f, -440.f}), (f32x4){440.f, 440.f, 440.f, 440.f});
                    int w0 = 0, w1 = 0; w0 = __builtin_amdgcn_cvt_pk_fp8_f32(v0[0], v0[1], w0, false); w0 = __builtin_amdgcn_cvt_pk_fp8_f32(v0[2], v0[3], w0, true);
                    w1 = __builtin_amdgcn_cvt_pk_fp8_f32(v1[0], v1[1], w1, false); w1 = __builtin_amdgcn_cvt_pk_fp8_f32(v1[2], v1[3], w1, true);
                    u32x2 w; w.x = (unsigned)w0; w.y = (unsigned)w1; *(u32x2*)(rowp + bj * HALF) = w; } }
    }
};
struct MoeOrder {
    const PG8_LAS int* units; const PG8_LAS unsigned* rowtab; int nr;
    __device__ __forceinline__ bool next(int i, Unit& u) const {
        if (i >= nr) return false;
        const int pm = __builtin_amdgcn_readfirstlane(units[2 * i]); if (pm < 0) return false;
        u.pm = pm; u.pn = __builtin_amdgcn_readfirstlane(units[2 * i + 1]); u.rid = i; return true;
    }
    __device__ __forceinline__ unsigned arow(const Unit& u, int r) const { return rowtab[u.rid * 256 + r]; }
    __device__ __forceinline__ void a_ready(const Unit&) const {}
    __device__ __forceinline__ void done(const Unit&) const {}
};

template <class Epi, class Sched, bool ALIGN_EPI = false, bool SP2 = false, bool GATHER = false, bool FP8 = false>
__device__ __forceinline__ void gemm_phase(PG8_LAS unsigned char* lds, const Gemm g, const Sched& S, const Epi& E) {
    const int tid = threadIdx.x, wid = __builtin_amdgcn_readfirstlane(tid >> 6), lane = tid & 63, wr = wid >> 2, wc = wid & 3, fr = lane & 15, fq = lane >> 4;
    const int K = g.K, nt = K / BK;
    unsigned voffA[2], voffB[2];
#pragma unroll
    for (int i = 0; i < 2; ++i) { int R, C; stage_rc(tid * 16 + i * 8192, R, C); const int Rb = Epi::PERM ? ((R & ~31) + perm32(R & 31)) : R;
        voffA[i] = (unsigned)(R * K + C) * 2u; voffB[i] = (unsigned)(Rb * K + C) * 2u; }
    const size_t kstep = (size_t)(BK * 2);
    const size_t hstep = (size_t)HALF * K * 2;
    const size_t tstep = 2 * hstep;
    const unsigned ldsw = (unsigned)wid * 1024u;
    const int aoff = lds_byte(wr * 64 + fr, fq * 8), boff = lds_byte(wc * 32 + fr, fq * 8);
#define PG8_SA(b, h) (((b) * 2 + (h)) * HTB)
#define PG8_SB(b, h) ((4 + (b) * 2 + (h)) * HTB)
#define PG8_STAGE(bufoff, gbase, voff) do { _Pragma("unroll") for (int _i = 0; _i < 2; ++_i) \
        __builtin_amdgcn_global_load_lds((const unsigned*)((const char*)(gbase) + (voff)[_i]), (PG8_LAS unsigned*)(lds + (bufoff) + ldsw + _i * 8192), 16, 0, 0); } while (0)
#define PG8_STAGE_A(b, h, U, koff) do { if constexpr (GATHER) { PG8_STAGE(PG8_SA(b, h), Ab + (koff), c_ao[h]); } else { PG8_STAGE(PG8_SA(b, h), U##_A + (size_t)(h) * hstep + (koff), voffA); } } while (0)
#define PG8_LDA(dst, b, h) do { _Pragma("unroll") for (int m = 0; m < 4; ++m) _Pragma("unroll") for (int k = 0; k < 2; ++k) dst[m][k] = *(const PG8_LAS bf16x8*)(lds + PG8_SA(b, h) + aoff + m * 2048 + k * 1024); } while (0)
#define PG8_LDB(dst, b, h) do { _Pragma("unroll") for (int n = 0; n < 2; ++n) _Pragma("unroll") for (int k = 0; k < 2; ++k) dst[n][k] = *(const PG8_LAS bf16x8*)(lds + PG8_SB(b, h) + boff + n * 2048 + k * 1024); } while (0)
#define PG8_MMA(ai, bj, At, Bt) do { __builtin_amdgcn_s_setprio(1); _Pragma("unroll") for (int m = 0; m < 4; ++m) _Pragma("unroll") for (int n = 0; n < 2; ++n) { \
        if constexpr (FP8) { const i32x8 ub_ = __builtin_shufflevector(__builtin_bit_cast(i32x4, Bt[n][0]), __builtin_bit_cast(i32x4, Bt[n][1]), 0, 1, 2, 3, 4, 5, 6, 7); \
            const i32x8 ua_ = __builtin_shufflevector(__builtin_bit_cast(i32x4, At[m][0]), __builtin_bit_cast(i32x4, At[m][1]), 0, 1, 2, 3, 4, 5, 6, 7); \
            acc[ai][bj][m][n] = __builtin_amdgcn_mfma_scale_f32_16x16x128_f8f6f4(ub_, ua_, acc[ai][bj][m][n], 0, 0, 0, 0x7f7f7f7f, 0, 0x7f7f7f7f); } \
        else { _Pragma("unroll") for (int k = 0; k < 2; ++k) acc[ai][bj][m][n] = __builtin_amdgcn_mfma_f32_16x16x32_bf16(Bt[n][k], At[m][k], acc[ai][bj][m][n], 0, 0, 0); } } \
        __builtin_amdgcn_s_setprio(0); } while (0)
#define PG8_WAIT_V(n) asm volatile("s_waitcnt vmcnt(" #n ")" ::: "memory")
#define PG8_WAIT_L(n) asm volatile("s_waitcnt lgkmcnt(" #n ")" ::: "memory")
#define PG8_BAR __builtin_amdgcn_s_barrier()
#define PG8_SCHED __builtin_amdgcn_sched_barrier(0)
    Unit cur, nxt; int ui = 0;
    if (!S.next(0, cur)) return;
    f32x4 acc[2][2][4][2];
#pragma unroll
    for (int a = 0; a < 2; ++a)
#pragma unroll
        for (int b = 0; b < 2; ++b)
#pragma unroll
            for (int m = 0; m < 4; ++m)
#pragma unroll
                for (int n = 0; n < 2; ++n) acc[a][b][m][n] = (f32x4){0.f, 0.f, 0.f, 0.f};
    bf16x8 At[4][2], B0[2][2], B1[2][2];
    const char* const Ab = (const char*)g.A; (void)Ab;
    unsigned c_ao[2][2] = {{0u, 0u}, {0u, 0u}}; (void)c_ao;
    int RA0, CA0; stage_rc(tid * 16, RA0, CA0);
    const char* c_A = (const char*)g.A + (size_t)cur.pm * tstep; const char* cB = (const char*)g.Bt + (size_t)cur.pn * tstep;
    if constexpr (GATHER) { _Pragma("unroll") for (int h_ = 0; h_ < 2; ++h_) _Pragma("unroll") for (int i_ = 0; i_ < 2; ++i_) c_ao[h_][i_] = S.arow(cur, h_ * HALF + RA0 + i_ * 64) + (unsigned)CA0 * 2u; }
    S.a_ready(cur);
    if constexpr (SP2) {
        PG8_STAGE(PG8_SB(0, 0), cB, voffB); PG8_STAGE(PG8_SB(0, 1), cB + hstep, voffB); PG8_STAGE_A(0, 0, c, (size_t)0); PG8_STAGE_A(0, 1, c, (size_t)0);
        if constexpr (Epi::HAS_PRE) E.pre(cur);
        if (wr == 1) PG8_BAR;
        PG8_WAIT_V(2); PG8_BAR;
        PG8_STAGE(PG8_SB(1, 0), cB + kstep, voffB); PG8_STAGE_A(1, 0, c, kstep); PG8_STAGE(PG8_SB(1, 1), cB + hstep + kstep, voffB);
        PG8_WAIT_V(6); PG8_BAR;
    } else {
        PG8_STAGE(PG8_SB(0, 0), cB, voffB); PG8_STAGE_A(0, 0, c, (size_t)0); PG8_STAGE(PG8_SB(0, 1), cB + hstep, voffB); PG8_STAGE_A(0, 1, c, (size_t)0);
        if (wr == 1) PG8_BAR;
        PG8_WAIT_V(4); PG8_BAR;
        PG8_STAGE(PG8_SB(1, 0), cB + kstep, voffB); PG8_STAGE_A(1, 0, c, kstep); PG8_STAGE(PG8_SB(1, 1), cB + hstep + kstep, voffB);
        PG8_WAIT_V(6); PG8_BAR;
    }
    for (;;) {
        const bool has_next = S.next(ui + 1, nxt);
        const char* n_A = has_next ? (const char*)g.A + (size_t)nxt.pm * tstep : c_A; const char* nB = has_next ? (const char*)g.Bt + (size_t)nxt.pn * tstep : cB;
#pragma unroll 1
        for (int t = 0; t < nt; t += 2) {
            const bool last = (t == nt - 2);
            if constexpr (Epi::HAS_MID) { if (t == (nt >> 1)) E.mid(acc, cur, wr, wc, fr, fq); }
            const char* s_A = last ? n_A : c_A; const size_t k2 = last ? (size_t)0 : (size_t)(t + 2) * kstep; const char* b2 = last ? nB : cB + (size_t)(t + 2) * kstep;
            const char* b3 = b2 + kstep; (void)s_A;
            if (last && has_next) S.a_ready(nxt);
            if constexpr (SP2) {
            PG8_LDB(B0, 0, 0); PG8_LDB(B1, 0, 1); PG8_SCHED; PG8_LDA(At, 0, 0); PG8_STAGE_A(1, 1, c, (size_t)(t + 1) * kstep); if constexpr (GATHER) { if (last && has_next) { _Pragma("unroll") for (int h_ = 0; h_ < 2; ++h_) _Pragma("unroll") for (int i_ = 0; i_ < 2; ++i_) c_ao[h_][i_] = S.arow(nxt, h_ * HALF + RA0 + i_ * 64) + (unsigned)CA0 * 2u; } }
            PG8_WAIT_V(8); PG8_WAIT_L(0); PG8_BAR; PG8_MMA(0, 0, At, B0); PG8_MMA(0, 1, At, B1); PG8_BAR; PG8_SCHED;
            PG8_LDA(At, 0, 1); PG8_STAGE(PG8_SB(0, 0), b2, voffB); PG8_STAGE(PG8_SB(0, 1), b2 + hstep, voffB); PG8_STAGE_A(0, 0, s, k2);
            PG8_WAIT_V(8); PG8_WAIT_L(0); PG8_BAR; PG8_MMA(1, 0, At, B0); PG8_MMA(1, 1, At, B1); PG8_BAR; PG8_SCHED;
            PG8_LDB(B0, 1, 0); PG8_LDB(B1, 1, 1); PG8_SCHED; PG8_LDA(At, 1, 0); PG8_STAGE_A(0, 1, s, k2);
            PG8_WAIT_V(8); PG8_WAIT_L(0); PG8_BAR; PG8_MMA(0, 0, At, B0); PG8_MMA(0, 1, At, B1); PG8_BAR; PG8_SCHED;
            PG8_LDA(At, 1, 1); PG8_STAGE(PG8_SB(1, 0), b3, voffB); PG8_STAGE(PG8_SB(1, 1), b3 + hstep, voffB); PG8_STAGE_A(1, 0, s, k2 + kstep);
            PG8_WAIT_V(8); PG8_WAIT_L(0); PG8_BAR; PG8_MMA(1, 0, At, B0); PG8_MMA(1, 1, At, B1); PG8_BAR; PG8_SCHED;
            } else {
            PG8_LDB(B0, 0, 0); PG8_SCHED; PG8_LDA(At, 0, 0); PG8_STAGE_A(1, 1, c, (size_t)(t + 1) * kstep); if constexpr (GATHER) { if (last && has_next) { _Pragma("unroll") for (int h_ = 0; h_ < 2; ++h_) _Pragma("unroll") for (int i_ = 0; i_ < 2; ++i_) c_ao[h_][i_] = S.arow(nxt, h_ * HALF + RA0 + i_ * 64) + (unsigned)CA0 * 2u; } }
            PG8_WAIT_L(8); PG8_BAR; PG8_WAIT_L(0); PG8_MMA(0, 0, At, B0); PG8_BAR; PG8_SCHED;
            PG8_LDB(B1, 0, 1); PG8_STAGE(PG8_SB(0, 0), b2, voffB);
            PG8_BAR; PG8_WAIT_L(0); PG8_MMA(0, 1, At, B1); PG8_BAR;
            PG8_LDA(At, 0, 1); PG8_STAGE_A(0, 0, s, k2);
            PG8_BAR; PG8_WAIT_L(0); PG8_MMA(1, 0, At, B0); PG8_BAR; PG8_SCHED;
            PG8_STAGE(PG8_SB(0, 1), b2 + hstep, voffB);
            PG8_WAIT_V(6); PG8_BAR; PG8_MMA(1, 1, At, B1); PG8_BAR;
            PG8_LDB(B0, 1, 0); PG8_SCHED; PG8_LDA(At, 1, 0); PG8_STAGE_A(0, 1, s, k2);
            PG8_WAIT_L(8); PG8_BAR; PG8_WAIT_L(0); PG8_MMA(0, 0, At, B0); PG8_BAR; PG8_SCHED;
            PG8_LDB(B1, 1, 1); PG8_STAGE(PG8_SB(1, 0), b3, voffB);
            PG8_BAR; PG8_WAIT_L(0); PG8_MMA(0, 1, At, B1); PG8_BAR;
            PG8_LDA(At, 1, 1); PG8_STAGE_A(1, 0, s, k2 + kstep);
            PG8_BAR; PG8_WAIT_L(0); PG8_MMA(1, 0, At, B0); PG8_BAR; PG8_SCHED;
            PG8_STAGE(PG8_SB(1, 1), b3 + hstep, voffB);
            PG8_WAIT_V(6); PG8_BAR; PG8_MMA(1, 1, At, B1); PG8_BAR;
            }
        }
        if constexpr (ALIGN_EPI) { if (wr == 0) PG8_BAR; }
        if constexpr (!Epi::AFTER_DRAIN) { E(acc, cur, wr, wc, fr, fq); S.done(cur); }
        if (!has_next) break;
#pragma unroll
        for (int a = 0; a < 2; ++a)
#pragma unroll
            for (int b = 0; b < 2; ++b)
#pragma unroll
                for (int m = 0; m < 4; ++m)
#pragma unroll
                    for (int n = 0; n < 2; ++n) acc[a][b][m][n] = (f32x4){0.f, 0.f, 0.f, 0.f};
        cur = nxt; c_A = n_A; cB = nB; ++ui;
        if constexpr (ALIGN_EPI) { if (wr == 1) PG8_BAR; }
    }
    PG8_WAIT_V(0);
    if constexpr (!ALIGN_EPI) { if (wr == 0) PG8_BAR; }
    PG8_BAR;
    if constexpr (Epi::AFTER_DRAIN) { E.fused(acc, cur, wr, wc, fr, fq, lds, wid, lane); S.done(cur); }
#undef PG8_SA
#undef PG8_SB
#undef PG8_STAGE
#undef PG8_STAGE_A
#undef PG8_LDA
#undef PG8_LDB
#undef PG8_MMA
#undef PG8_WAIT_V
#undef PG8_WAIT_L
#undef PG8_BAR
#undef PG8_SCHED
}
}

#define XB_TMO      128
#define XB_XCNT(j)  (256  + 64 * (j))
#define XB_XSUB(j)  (1280 + 64 * (j))
#define XB_XGEN(j)  (2304 + 64 * (j))
#define XB_TOP      3328
#define XB_TOPGEN   3392
#define XCD_BAR_WORDS 3456
#define XB_SPIN_CAP (1u << 18)

__device__ __forceinline__ unsigned xb_ld(unsigned* p)              { return __hip_atomic_load(p, __ATOMIC_RELAXED, __HIP_MEMORY_SCOPE_AGENT); }
__device__ __forceinline__ unsigned xb_add(unsigned* p, unsigned v) { return __hip_atomic_fetch_add(p, v, __ATOMIC_RELAXED, __HIP_MEMORY_SCOPE_AGENT); }
__device__ __forceinline__ unsigned xb_xcc_id() { return (unsigned)__builtin_amdgcn_s_getreg((3 << 11) | 20) & 0xFu; }
#define XB_SPIN(cond, bar) do { unsigned _sp = 0; while (cond) { __builtin_amdgcn_s_sleep(1); \
    if ((++_sp & 255u) == 0u) { if (xb_ld(&(bar)[XB_TMO])) break; if (_sp > XB_SPIN_CAP) { atomicAdd(&(bar)[XB_TMO], 1u); break; } } } } while (0)

struct XcdBarrier {
    unsigned* bar; unsigned x;
    volatile LAS unsigned* st;
};

__device__ __forceinline__ XcdBarrier xcd_barrier_post(unsigned* bar, volatile LAS unsigned* st) {
    XcdBarrier b; b.bar = bar; b.x = xb_xcc_id(); b.st = st;
    if (threadIdx.x == 0) (void)xb_add(&bar[XB_XCNT(b.x)], 1u);
    return b;
}
__device__ __forceinline__ void xcd_barrier_complete(unsigned* bar, unsigned x, unsigned& nloc, unsigned& nx) {
    const unsigned G = gridDim.x * gridDim.y * gridDim.z;
    unsigned sum, cnt, mine, sp = 0u;
    for (;;) {
        sum = 0u; cnt = 0u; mine = 0u;
#pragma unroll
        for (unsigned j = 0; j < 16; ++j) { const unsigned c = xb_ld(&bar[XB_XCNT(j)]); sum += c; cnt += (c > 0u) ? 1u : 0u; mine = (j == x) ? c : mine; }
        if (sum == G) break;
        __builtin_amdgcn_s_sleep(1);
        if ((++sp & 255u) == 0u) { if (xb_ld(&bar[XB_TMO])) break; if (sp > XB_SPIN_CAP) { atomicAdd(&bar[XB_TMO], 1u); break; } }
    }
    nloc = mine > 0u ? mine : 1u; nx = cnt > 0u ? cnt : 1u;
}

__device__ __forceinline__ void xcd_barrier(const XcdBarrier& b) {
    asm volatile("s_waitcnt vmcnt(0)" ::: "memory");
    __syncthreads();
    if (threadIdx.x == 0) {
        unsigned* bar = b.bar;
        __builtin_amdgcn_s_waitcnt(0);
        unsigned nloc = b.st[0], nx = b.st[1];
        if (nloc == 0u) { xcd_barrier_complete(bar, b.x, nloc, nx); b.st[0] = nloc; b.st[1] = nx; }
        const unsigned old = xb_add(&bar[XB_XSUB(b.x)], 1u);
        const unsigned gen = old / nloc;
        if (old + 1u == (gen + 1u) * nloc) {
            __builtin_amdgcn_fence(__ATOMIC_RELEASE, "agent");
            asm volatile("s_waitcnt vmcnt(0)" ::: "memory");
            const unsigned og = xb_add(&bar[XB_TOP], 1u);
            const unsigned tg = og / nx;
            if (og + 1u == (tg + 1u) * nx) xb_add(&bar[XB_TOPGEN], 1u);
            else XB_SPIN(xb_ld(&bar[XB_TOPGEN]) == tg, bar);
            __builtin_amdgcn_fence(__ATOMIC_ACQUIRE, "agent");
            xb_add(&bar[XB_XGEN(b.x)], 1u);
            asm volatile("s_waitcnt vmcnt(0)" ::: "memory");
        } else {
            XB_SPIN(xb_ld(&bar[XB_XGEN(b.x)]) == gen, bar);
            __builtin_amdgcn_fence(__ATOMIC_ACQUIRE, "agent");
            asm volatile("s_waitcnt vmcnt(0)" ::: "memory");
        }
    }
    __syncthreads();
}

typedef short bf16x8 __attribute__((ext_vector_type(8)));
typedef float f32x16 __attribute__((ext_vector_type(16)));
typedef float f32x4v __attribute__((ext_vector_type(4)));
typedef unsigned u32x2v __attribute__((ext_vector_type(2)));
struct Args { const float* in[21]; float* out; unsigned char* ws; int ph_lo, ph_hi, bar_sel, pad; };

template <int CTRL> __device__ __forceinline__ float dppf(float v) { return __builtin_bit_cast(float, __builtin_amdgcn_update_dpp(0, __builtin_bit_cast(int, v), CTRL, 0xf, 0xf, false)); }
__device__ __forceinline__ float rdlane(float v, int l) { return __builtin_bit_cast(float, __builtin_amdgcn_readlane(__builtin_bit_cast(int, v), l)); }
__device__ __forceinline__ float row16_sum(float v) { v += dppf<0xB1>(v); v += dppf<0x4E>(v); v += dppf<0x141>(v); v += dppf<0x140>(v); return v; }
__device__ __forceinline__ float row16_max(float v) { v = fmaxf(v, dppf<0xB1>(v)); v = fmaxf(v, dppf<0x4E>(v)); v = fmaxf(v, dppf<0x141>(v)); v = fmaxf(v, dppf<0x140>(v)); return v; }
__device__ __forceinline__ float wave_sum(float v) { v = row16_sum(v); return (rdlane(v, 0) + rdlane(v, 16)) + (rdlane(v, 32) + rdlane(v, 48)); }
__device__ __forceinline__ float wave_max(float v) { v = row16_max(v); return fmaxf(fmaxf(rdlane(v, 0), rdlane(v, 16)), fmaxf(rdlane(v, 32), rdlane(v, 48))); }
typedef unsigned xl_u2 __attribute__((ext_vector_type(2)));
#define XL_SWAP(WHICH, v, X, Y) const auto xl_r_ = __builtin_amdgcn_permlane##WHICH##_swap(__builtin_bit_cast(unsigned, v), __builtin_bit_cast(unsigned, v), false, false); \
    const unsigned xl_x_ = xl_r_[0], xl_y_ = xl_r_[1]; const float X = __uint_as_float(xl_x_), Y = __uint_as_float(xl_y_)
__device__ __forceinline__ float half32_sum(float v) { v = row16_sum(v); XL_SWAP(16, v, x, y); return x + y; }
__device__ __forceinline__ float half32_max(float v) { v = row16_max(v); XL_SWAP(16, v, x, y); return fmaxf(x, y); }
__device__ __forceinline__ float pair32_sum(float v) { XL_SWAP(32, v, x, y); return x + y; }
__device__ __forceinline__ float pair32_max(float v) { XL_SWAP(32, v, x, y); return fmaxf(x, y); }
#undef XL_SWAP
__device__ __forceinline__ float wave_scan_incl(float x, int lane) {
    x += dppf<0x111>(x); x += dppf<0x112>(x); x += dppf<0x114>(x); x += dppf<0x118>(x);
    const float s0 = rdlane(x, 15), s1 = rdlane(x, 31), s2 = rdlane(x, 47); const int r = lane >> 4;
    return x + (r == 0 ? 0.f : (r == 1 ? s0 : (r == 2 ? s0 + s1 : (s0 + s1) + s2)));
}
__device__ __forceinline__ float silu_f(float x) { return x / (1.f + __expf(-x)); }

template <bool GAIN>
__device__ __forceinline__ void cvt_item(const float* W, int ldw, int n0src, bf16* WT, int K, int drow0, int k0, LAS float* scr, int lane, const float* gk = nullptr) {
    float wv_[32];
#pragma unroll
    for (int i = 0; i < 32; ++i) wv_[i] = W[(size_t)(k0 + 2 * i + (lane >> 5)) * ldw + n0src + (lane & 31)];
#pragma unroll
    for (int i = 0; i < 32; ++i) { const int kk = 2 * i + (lane >> 5); float v = wv_[i]; if (GAIN) v *= gk[kk]; scr[kk * 33 + (lane & 31)] = v; }
    LDS_WAIT(); asm volatile("" ::: "memory");
    const int c = lane & 7;
#pragma unroll
    for (int j = 0; j < 4; ++j) { const int n = (lane >> 3) + 8 * j; const LAS float* s = scr + (8 * c) * 33 + n;
        v4u o; o.x = pk2(s[0 * 33], s[1 * 33]); o.y = pk2(s[2 * 33], s[3 * 33]); o.z = pk2(s[4 * 33], s[5 * 33]); o.w = pk2(s[6 * 33], s[7 * 33]);
        *(GAS v4u*)(WT + (size_t)(drow0 + n) * K + k0 + 8 * c) = o; }
    LDS_WAIT(); asm volatile("" ::: "memory");
}
constexpr float W8_SCALE = 64.f, ACT8_SCALE = 4.f, YS8_SCALE = 16.f;
__device__ __forceinline__ unsigned pk4_fp8(float a, float b, float c, float d) { int w = 0; w = __builtin_amdgcn_cvt_pk_fp8_f32(a, b, w, false); w = __builtin_amdgcn_cvt_pk_fp8_f32(c, d, w, true); return (unsigned)w; }
__device__ __forceinline__ void cvt_item_fp8(const float* W, int ldw, int n0src, unsigned char* WT, int K, int drow0, int k0, LAS float* scr, int lane) {
#pragma unroll 16
    for (int i = 0; i < 32; ++i) { const int kk = 2 * i + (lane >> 5); scr[kk * 33 + (lane & 31)] = W[(size_t)(k0 + kk) * ldw + n0src + (lane & 31)] * W8_SCALE; }
    LDS_WAIT(); asm volatile("" ::: "memory");
    const int c = lane & 3;
#pragma unroll
    for (int j = 0; j < 2; ++j) { const int n = (lane >> 2) + 16 * j; const LAS float* s = scr + (16 * c) * 33 + n;
        v4u o; o.x = pk4_fp8(s[0 * 33], s[1 * 33], s[2 * 33], s[3 * 33]); o.y = pk4_fp8(s[4 * 33], s[5 * 33], s[6 * 33], s[7 * 33]);
        o.z = pk4_fp8(s[8 * 33], s[9 * 33], s[10 * 33], s[11 * 33]); o.w = pk4_fp8(s[12 * 33], s[13 * 33], s[14 * 33], s[15 * 33]);
        *(GAS v4u*)(WT + (size_t)(drow0 + n) * K + k0 + 16 * c) = o; }
    LDS_WAIT(); asm volatile("" ::: "memory");
}
__device__ __forceinline__ void ph_prologue(const Args& a, LAS unsigned char* lds, int bid, int nb) {
    const int tid = threadIdx.x, lane = tid & 63, wave = tid >> 6;
    unsigned char* ws = a.ws;
    LAS float* scr = (LAS float*)(lds + 32768 + wave * 8704);
    const int gw = bid * 8 + wave, ngw = nb * 8;
    constexpr int I_IN = 16 * 72, I_OUT = 16 * 32;
    const float* x = a.in[0]; const float* g = a.in[1]; bf16* u = (bf16*)(ws + WS_U); float* dtraw = (float*)(ws + WS_DTRAW);
    float4 cur[2][4], nxt[2][4];
#define P0_LOAD(dst, r0_) do { _Pragma("unroll") for (int q = 0; q < 2; ++q) { const int r_ = (r0_) + q * ngw; if (r_ < T) { const float4* xr = (const float4*)(x + (size_t)r_ * DM); \
        _Pragma("unroll") for (int j = 0; j < 4; ++j) dst[q][j] = xr[lane + 64 * j]; } } } while (0)
    P0_LOAD(cur, gw);
    LAS float* wdt = (LAS float*)lds;
    for (int i = tid; i < 1024 * 8; i += NT) wdt[(i & 7) * 1024 + (i >> 3)] = a.in[2][(size_t)(i >> 3) * DPROJ + O_DT + (i & 7)];
    float4 gq[4];
#pragma unroll
    for (int j = 0; j < 4; ++j) gq[j] = ((const float4*)g)[lane + 64 * j];
    __syncthreads();
#pragma unroll
    for (int j = 0; j < 4; ++j) asm volatile("" :: "v"(gq[j].x), "v"(gq[j].y), "v"(gq[j].z), "v"(gq[j].w));
    for (int r0 = gw; r0 < T; r0 += 2 * ngw) {
        if (r0 + 2 * ngw < T) P0_LOAD(nxt, r0 + 2 * ngw);
#pragma unroll
        for (int q = 0; q < 2; ++q) { const int r = r0 + q * ngw; if (r < T) {
        float4 (&v)[4] = cur[q]; float s = 0.f;
#pragma unroll
        for (int j = 0; j < 4; ++j) s += v[j].x * v[j].x + v[j].y * v[j].y + v[j].z * v[j].z + v[j].w * v[j].w;
        const float rs = rsqrtf(wave_sum(s) * (1.f / DM) + EPS);
        float dacc[8];
#pragma unroll
        for (int h = 0; h < 8; ++h) dacc[h] = 0.f;
#pragma unroll
        for (int j = 0; j < 4; ++j) { const float4 gg = gq[j];
            const float un[4] = {v[j].x * rs * gg.x, v[j].y * rs * gg.y, v[j].z * rs * gg.z, v[j].w * rs * gg.w};
            uint2 o; o.x = pg8::cvt_pk_bf16(un[0], un[1]); o.y = pg8::cvt_pk_bf16(un[2], un[3]);
            *(uint2*)(u + (size_t)r * DM + 4 * lane + 256 * j) = o;
#pragma unroll
            for (int h = 0; h < 8; ++h) { const f32x4v w4 = *(const LAS f32x4v*)(wdt + h * 1024 + 4 * lane + 256 * j); dacc[h] += (un[0] * w4[0] + un[1] * w4[1]) + (un[2] * w4[2] + un[3] * w4[3]); } }
#pragma unroll
        for (int h = 0; h < 8; ++h) dacc[h] = wave_sum(dacc[h]);
        if (lane == 0) {
#pragma unroll
            for (int h = 0; h < 8; ++h) dtraw[(size_t)r * 8 + h] = dacc[h]; }
        } }
#pragma unroll
        for (int q = 0; q < 2; ++q)
#pragma unroll
            for (int j = 0; j < 4; ++j) cur[q][j] = nxt[q][j];
    }
#undef P0_LOAD
    for (int it0 = gw; it0 < I_IN + I_OUT; it0 += ngw) {
        int it = it0;
        if (it < I_IN) { const int kb = it / 72, d0 = 32 * (it % 72); cvt_item<false>(a.in[2], DPROJ, d0 < 1536 ? d0 : d0 + 8, (bf16*)(ws + WS_WIN), DM, d0, 64 * kb, scr, lane); continue; }
        it -= I_IN;
        { const int kb = it / 32, d0 = 32 * (it % 32); cvt_item<true>(a.in[12], DM, d0, (bf16*)(ws + WS_WOUT), DM, d0, 64 * kb, scr, lane, (kb < 8 ? a.in[8] : a.in[11] - 512) + 64 * kb); }
    }
}

constexpr int CW_QHEAD = 1024;
constexpr int I_W1 = NE * 8 * 64, I_W2 = NE * 8 * 32;
struct CvtItem { const float* W; unsigned char* WT; int ldw, n0src, drow0, k0; };
__device__ __forceinline__ CvtItem moe_item(const Args& a, int it) {
    CvtItem c; unsigned char* ws = a.ws;
    if (it < I_W1) { const int e = it >> 9, r = it & 511, kb = r >> 6, d0 = 32 * (r & 63), pn = d0 >> 8, j0 = d0 & 255;
        c.W = a.in[16] + (size_t)e * 1024 * 2048; c.ldw = 2048; c.n0src = j0 < 128 ? pn * 128 + j0 : 1024 + pn * 128 + (j0 - 128); c.WT = ws + WS_W1 + (size_t)e * 2048 * 1024; c.drow0 = d0; c.k0 = 128 * kb; }
    else { it -= I_W1; const int e = it >> 8, r = it & 255, kb = r >> 5, d0 = 32 * (r & 31);
        c.W = a.in[18] + (size_t)e * 1024 * 1024; c.ldw = 1024; c.n0src = d0; c.WT = ws + WS_W2 + (size_t)e * 1024 * 1024; c.drow0 = d0; c.k0 = 128 * kb; }
    return c;
}
__device__ __forceinline__ void cvt8_load(const CvtItem& c, int lane, f32x4v (&v)[16]) {
    const float* p = c.W + (size_t)(c.k0 + 16 * (lane >> 3)) * c.ldw + c.n0src + (lane & 7) * 4;
#pragma unroll
    for (int i = 0; i < 16; ++i) v[i] = __builtin_nontemporal_load((const f32x4v*)(p + (size_t)i * c.ldw));
}
__device__ __forceinline__ void cvt8_finish(const CvtItem& c, int lane, const f32x4v (&v)[16]) {
    unsigned char* q = c.WT + (size_t)(c.drow0 + 4 * (lane & 7)) * DM + c.k0 + 16 * (lane >> 3);
#pragma unroll
    for (int cc = 0; cc < 4; ++cc) { v4u o;
        o.x = pk4_fp8(v[0][cc] * W8_SCALE, v[1][cc] * W8_SCALE, v[2][cc] * W8_SCALE, v[3][cc] * W8_SCALE); o.y = pk4_fp8(v[4][cc] * W8_SCALE, v[5][cc] * W8_SCALE, v[6][cc] * W8_SCALE, v[7][cc] * W8_SCALE);
        o.z = pk4_fp8(v[8][cc] * W8_SCALE, v[9][cc] * W8_SCALE, v[10][cc] * W8_SCALE, v[11][cc] * W8_SCALE); o.w = pk4_fp8(v[12][cc] * W8_SCALE, v[13][cc] * W8_SCALE, v[14][cc] * W8_SCALE, v[15][cc] * W8_SCALE);
        *(GAS v4u*)(q + (size_t)cc * DM) = o; }
}
constexpr int I_MOE = I_W1 + I_W2, QB8 = 2, QPART = I_MOE / 8;
static_assert(QPART % QB8 == 0, "queue partition");
constexpr int CW_GDONE = 3072;
__device__ __forceinline__ void moe_weight_queue(const Args& a, LAS unsigned char* lds, int bid, unsigned stop_at, int nparts = 8) {
    const int tid = threadIdx.x, lane = tid & 63; (void)lds;
    unsigned* heads = (unsigned*)(a.ws + WS_CTL) + CW_QHEAD; unsigned* gdone = (unsigned*)(a.ws + WS_CTL) + CW_GDONE;
    for (int k = 0; k < nparts; ++k) { const int part = (bid + (((k & 1) << 2) | (k & 2) | ((k >> 2) & 1))) & 7;
        for (;;) { unsigned b0 = 0u, dn = 0u; if (lane == 0) { b0 = atomicAdd(&heads[64 * part], (unsigned)QB8); if (stop_at) dn = __hip_atomic_load(gdone, __ATOMIC_RELAXED, __HIP_MEMORY_SCOPE_AGENT); }
            b0 = (unsigned)__builtin_amdgcn_readfirstlane((int)b0); dn = (unsigned)__builtin_amdgcn_readfirstlane((int)dn);
            const bool leave = stop_at && dn >= stop_at;
            if (b0 >= (unsigned)QPART) { if (leave) return; break; }
            const int base = (int)b0 < I_W1 / 8 ? part * (I_W1 / 8) + (int)b0 : I_W1 + part * (I_W2 / 8) + ((int)b0 - I_W1 / 8);
            f32x4v A[16], B[16];
#define QL(j, R) cvt8_load(moe_item(a, base + (j)), lane, R)
#define QF(j, R) cvt8_finish(moe_item(a, base + (j)), lane, R)
            QL(0, A); QL(1, B);
            QF(0, A); QF(1, B);
            if (leave) return; } }
#undef QL
#undef QF
}
__device__ __forceinline__ void ph_conv(const Args& a, int bid, int nb) {
    const bf16* proj = (const bf16*)(a.ws + WS_PROJ); const float* cw = a.in[3]; const float* cb = a.in[4]; const float* dtb = a.in[5]; const float* dtraw = (const float*)(a.ws + WS_DTRAW);
    float* xc = (float*)(a.ws + WS_XC); float* dt = (float*)(a.ws + WS_DT);
    const size_t n = (size_t)T * 1024;
    for (size_t i = (size_t)bid * NT + threadIdx.x; i < n; i += (size_t)nb * NT) {
        const int t = (int)(i >> 10), c = (int)(i & 1023), s = t % SEQ;
        float v = cb[c];
#pragma unroll
        for (int k = 0; k < 4; ++k) { const int ss = s - 3 + k; if (ss >= 0) v += cw[k * 1024 + c] * bf2f(proj[(size_t)(t - 3 + k) * NP + PXBC + c]); }
        xc[i] = silu_f(v);
    }
    for (int i = bid * NT + threadIdx.x; i < T * 8; i += nb * NT) {
        const float v = dtraw[i] + dtb[i & 7];
        dt[i] = v > 20.f ? v : log1pf(__expf(v));
    }
}
__device__ __forceinline__ unsigned cvtpk(float lo, float hi) { unsigned r; asm volatile("v_cvt_pk_bf16_f32 %0, %1, %2" : "=v"(r) : "v"(lo), "v"(hi)); return r; }
__device__ __forceinline__ float silu_fast(float x) { return x * __builtin_amdgcn_rcpf(1.f + __expf(-x)); }
__device__ __forceinline__ void conv_load(const bf16* proj, int t0, int s0, int l0, int ch, unsigned (&raw)[11]) {
#pragma unroll
    for (int i = 0; i < 11; ++i) { const int l = l0 - 3 + i; unsigned wv = 0u; if (s0 + l >= 0) wv = *(const unsigned*)(proj + (size_t)(t0 + l) * NP + PXBC + ch); raw[i] = wv; }
}
__device__ __forceinline__ void conv_wload(const float* cw, const float* cb, int ch, float2 (&wv)[5]) {
#pragma unroll
    for (int k = 0; k < 4; ++k) wv[k] = *(const float2*)(cw + k * 1024 + ch);
    wv[4] = *(const float2*)(cb + ch);
}
__device__ __forceinline__ void conv_compute(const unsigned (&raw)[11], const float2 (&wv)[5], float (&o0)[8], float (&o1)[8]) {
    float w0[4], w1[4];
#pragma unroll
    for (int k = 0; k < 4; ++k) { w0[k] = wv[k].x; w1[k] = wv[k].y; }
    const float2 bb = wv[4];
#pragma unroll
    for (int j = 0; j < 8; ++j) { float v0 = bb.x, v1 = bb.y;
#pragma unroll
        for (int k = 0; k < 4; ++k) { v0 += w0[k] * bflo(raw[j + k]); v1 += w1[k] * bfhi(raw[j + k]); }
        o0[j] = silu_fast(v0); o1[j] = silu_fast(v1); }
}
constexpr int SL_ST = 272, SL_XW = 0, SL_BMT = 256 * SL_ST, SL_WL = SL_BMT + 128 * SL_ST, SL_TMP = SL_WL + 2048;
__device__ __forceinline__ void ph_ssd_local(const Args& a, LAS unsigned char* lds, int bid, int nb) {
    const bf16* proj = (const bf16*)(a.ws + WS_PROJ); const float* dtraw = (const float*)(a.ws + WS_DTRAW); const float* dtb = a.in[5]; const float* alog = a.in[6];
    float* dtg = (float*)(a.ws + WS_DT); float* acum = (float*)(a.ws + WS_ACUM); float* cdec = (float*)(a.ws + WS_CDEC); float* states = (float*)(a.ws + WS_STATES);
    const int tid = threadIdx.x, lane = tid & 63, w = tid >> 6;
    LAS unsigned char* XW = lds + SL_XW; LAS unsigned char* BMT = lds + SL_BMT; LAS float* wl = (LAS float*)(lds + SL_WL); LAS float* tmp = (LAS float*)(lds + SL_TMP);
    for (int unit = bid; unit < BATCH * NCH * 2; unit += nb) {
        const int g = unit & 1, c = (unit >> 1) % NCH, b = unit / (2 * NCH); const int t0 = b * SEQ + c * 128;
        __syncthreads();
        { const int r = tid >> 7, l = tid & 127, h = g * 4 + r;
          const float v = dtraw[(size_t)(t0 + l) * 8 + h] + dtb[h]; const float dtv = fmaxf(v, 0.f) + log1pf(__expf(-fabsf(v))); const float av = -__expf(alog[h]);
          float x = dtv * av;
          x = wave_scan_incl(x, lane);
          if (lane == 63) tmp[w] = x;
          __syncthreads();
          if (w & 1) x += tmp[w - 1];
          const float last = tmp[2 * r] + tmp[2 * r + 1];
          dtg[(size_t)(t0 + l) * 8 + h] = dtv; acum[(size_t)(t0 + l) * 8 + h] = x; wl[r * 128 + l] = dtv * __expf(last - x);
          if (l == 127) cdec[(b * NCH + c) * 8 + h] = __expf(x); }
        __syncthreads();
        { unsigned raw[6][11];
#pragma unroll
          for (int it = 0; it < 6; ++it) { const int task = tid + it * NT, pi = task % 192, l0 = (task / 192) * 8;
              const int ch = pi < 128 ? g * 256 + 2 * pi : 512 + g * 128 + 2 * (pi - 128); conv_load(proj, t0, c * 128, l0, ch, raw[it]); }
#pragma unroll
          for (int it = 0; it < 6; ++it) { const int task = tid + it * NT, pi = task % 192, l0 = (task / 192) * 8;
            const int ch = pi < 128 ? g * 256 + 2 * pi : 512 + g * 128 + 2 * (pi - 128);
            float o0[8], o1[8]; float2 cwv[5]; conv_wload(a.in[3], a.in[4], ch, cwv); conv_compute(raw[it], cwv, o0, o1);
            if (pi < 128) { const int row = 2 * pi; const LAS float* ws_ = wl + (row >> 6) * 128 + l0;
#pragma unroll
                for (int j = 0; j < 8; ++j) { o0[j] *= ws_[j]; o1[j] *= ws_[j]; }
                v4u p0, p1; p0.x = cvtpk(o0[0], o0[1]); p0.y = cvtpk(o0[2], o0[3]); p0.z = cvtpk(o0[4], o0[5]); p0.w = cvtpk(o0[6], o0[7]);
                p1.x = cvtpk(o1[0], o1[1]); p1.y = cvtpk(o1[2], o1[3]); p1.z = cvtpk(o1[4], o1[5]); p1.w = cvtpk(o1[6], o1[7]);
                *(LAS v4u*)(XW + row * SL_ST + l0 * 2) = p0; *(LAS v4u*)(XW + (row + 1) * SL_ST + l0 * 2) = p1; }
            else { const int row = 2 * (pi - 128);
                v4u p0, p1; p0.x = cvtpk(o0[0], o0[1]); p0.y = cvtpk(o0[2], o0[3]); p0.z = cvtpk(o0[4], o0[5]); p0.w = cvtpk(o0[6], o0[7]);
                p1.x = cvtpk(o1[0], o1[1]); p1.y = cvtpk(o1[2], o1[3]); p1.z = cvtpk(o1[4], o1[5]); p1.w = cvtpk(o1[6], o1[7]);
                *(LAS v4u*)(BMT + row * SL_ST + l0 * 2) = p0; *(LAS v4u*)(BMT + (row + 1) * SL_ST + l0 * 2) = p1; } } }
        __syncthreads();
        { const int r = w >> 1, ph = w & 1, qc = lane & 31, hh = lane >> 5, h = g * 4 + r;
          f32x16 acc[4];
#pragma unroll
          for (int n4 = 0; n4 < 4; ++n4)
#pragma unroll
              for (int i = 0; i < 16; ++i) acc[n4][i] = 0.f;
#pragma unroll
          for (int k2 = 0; k2 < 4; ++k2) { bf16x8 af[2], bb[2][4];
#pragma unroll
              for (int kk = 0; kk < 2; ++kk) { const int ks = 2 * k2 + kk; af[kk] = *(const LAS bf16x8*)(XW + (r * 64 + ph * 32 + qc) * SL_ST + (16 * ks + 8 * hh) * 2);
#pragma unroll
                  for (int n4 = 0; n4 < 4; ++n4) bb[kk][n4] = *(const LAS bf16x8*)(BMT + (n4 * 32 + qc) * SL_ST + (16 * ks + 8 * hh) * 2); }
#pragma unroll
              for (int kk = 0; kk < 2; ++kk)
#pragma unroll
                  for (int n4 = 0; n4 < 4; ++n4) acc[n4] = __builtin_amdgcn_mfma_f32_32x32x16_bf16(af[kk], bb[kk][n4], acc[n4], 0, 0, 0); }
          bf16* st = (bf16*)states + ((size_t)((b * NCH + c) * 8 + h)) * 8192;
          unsigned pkd[4][16];
#pragma unroll
          for (int n4 = 0; n4 < 4; ++n4)
#pragma unroll
              for (int i = 0; i < 16; ++i) pkd[n4][i] = cvtpk(acc[n4][i], dppf<0x101>(acc[n4][i]));
          if ((lane & 1) == 0) {
#pragma unroll
          for (int n4 = 0; n4 < 4; ++n4)
#pragma unroll
              for (int i = 0; i < 16; ++i) { const int pp = ph * 32 + (i & 3) + 8 * (i >> 2) + 4 * hh; *(unsigned*)(st + pp * 128 + n4 * 32 + qc) = pkd[n4][i]; } } }
    }
}
__device__ __forceinline__ void ph_scan(const Args& a, int bid, int nb) {
    const float* states = (const float*)(a.ws + WS_STATES); const float* cdec = (const float*)(a.ws + WS_CDEC); bf16* prev = (bf16*)(a.ws + WS_PREV);
    const int n4 = BATCH * 8 * 2048;
    for (int i = bid * NT + threadIdx.x; i < n4; i += nb * NT) {
        const int e4 = i & 2047, h = (i >> 11) & 7, b = i >> 14;
        f32x4v st[NCH]; float dc[NCH];
#pragma unroll
        for (int c = 0; c < NCH; ++c) { const u32x2v sw = *(const u32x2v*)((const bf16*)states + ((size_t)((b * NCH + c) * 8 + h)) * 8192 + e4 * 4);
            st[c][0] = bflo(sw.x); st[c][1] = bfhi(sw.x); st[c][2] = bflo(sw.y); st[c][3] = bfhi(sw.y); dc[c] = cdec[(b * NCH + c) * 8 + h]; }
        f32x4v hc = {0.f, 0.f, 0.f, 0.f};
#pragma unroll
        for (int c = 0; c < NCH; ++c) { u32x2v pk; pk.x = cvtpk(hc[0], hc[1]); pk.y = cvtpk(hc[2], hc[3]); *(u32x2v*)(prev + ((size_t)((b * NCH + c) * 8 + h)) * 8192 + e4 * 4) = pk; hc = hc * dc[c] + st[c]; }
    }
}
constexpr int SO_XST = 264, SO_NST = 272, SO_XS = 0, SO_BM = 256 * SO_XST, SO_CM = SO_BM + 128 * SO_NST, SO_AC = SO_CM + 128 * SO_NST, SO_DT = SO_AC + 2048, SO_EA = SO_DT + 2048, SO_END = SO_EA + 2048;
constexpr int SO_YST = 260;
static_assert(128 * SO_YST * 4 <= SO_AC && SO_END <= SCR_BYTES, "ssd_out LDS map");
__device__ __forceinline__ void ph_ssd_out(const Args& a, LAS unsigned char* lds, int bid, int nb) {
    const bf16* proj = (const bf16*)(a.ws + WS_PROJ); const float* dtg = (const float*)(a.ws + WS_DT); const float* acum = (const float*)(a.ws + WS_ACUM);
    const bf16* prev = (const bf16*)(a.ws + WS_PREV); const float* dsk = a.in[7];
    bf16* ygb = (bf16*)(a.ws + WS_CAT); float* ssd = (float*)(a.ws + WS_SSSD);
    const int tid = threadIdx.x, lane = tid & 63, w = tid >> 6, r = w >> 1, lsel = w & 1, qc = lane & 31, hh = lane >> 5;
    LAS unsigned char* XS = lds + SO_XS; LAS unsigned char* BM = lds + SO_BM; LAS unsigned char* CM = lds + SO_CM;
    LAS float* AC = (LAS float*)(lds + SO_AC); LAS float* DT = (LAS float*)(lds + SO_DT); LAS float* EA = (LAS float*)(lds + SO_EA); LAS float* YS = (LAS float*)lds;
    for (int unit = bid; unit < BATCH * NCH * 2; unit += nb) {
        const int g = unit & 1, c = (unit >> 1) % NCH, b = unit / (2 * NCH); const int t0 = b * SEQ + c * 128;
        __syncthreads();
        float2 cwv[5];
        { const int pi = tid & 255; const int ch = pi < 128 ? g * 256 + 2 * pi : (pi < 192 ? 512 + g * 128 + 2 * (pi - 128) : 768 + g * 128 + 2 * (pi - 192)); conv_wload(a.in[3], a.in[4], ch, cwv); }
        bf16x8 pf[2][8];
        { const bf16* pvb = prev + ((size_t)((b * NCH + c) * 8 + g * 4 + r)) * 8192 + qc * 128 + 8 * hh;
#pragma unroll
          for (int pb = 0; pb < 2; ++pb)
#pragma unroll
              for (int ks = 0; ks < 8; ++ks) pf[pb][ks] = *(const bf16x8*)(pvb + pb * 32 * 128 + 16 * ks); }
        { const int rr = tid >> 7, l = tid & 127, h = g * 4 + rr; const float ac = acum[(size_t)(t0 + l) * 8 + h];
          AC[rr * 128 + l] = ac; DT[rr * 128 + l] = dtg[(size_t)(t0 + l) * 8 + h]; EA[rr * 128 + l] = __expf(ac); }
#pragma unroll 1
        for (int bt = 0; bt < 2; ++bt) { unsigned raw[4][11];
#pragma unroll
          for (int it = 0; it < 4; ++it) { const int task = tid + (bt * 4 + it) * NT, pi = task & 255, l0 = (task >> 8) * 8;
              const int ch = pi < 128 ? g * 256 + 2 * pi : (pi < 192 ? 512 + g * 128 + 2 * (pi - 128) : 768 + g * 128 + 2 * (pi - 192)); conv_load(proj, t0, c * 128, l0, ch, raw[it]); }
#pragma unroll
          for (int it = 0; it < 4; ++it) { const int task = tid + (bt * 4 + it) * NT, pi = task & 255, l0 = (task >> 8) * 8;
            const int ch = pi < 128 ? g * 256 + 2 * pi : (pi < 192 ? 512 + g * 128 + 2 * (pi - 128) : 768 + g * 128 + 2 * (pi - 192));
            float o0[8], o1[8]; (void)ch; conv_compute(raw[it], cwv, o0, o1);
            if (pi < 128) { const int row = 2 * pi; u32x2v q0, q1;
                q0.x = cvtpk(o0[0], o0[1]); q0.y = cvtpk(o0[2], o0[3]); q1.x = cvtpk(o0[4], o0[5]); q1.y = cvtpk(o0[6], o0[7]);
                *(LAS u32x2v*)(XS + row * SO_XST + l0 * 2) = q0; *(LAS u32x2v*)(XS + row * SO_XST + l0 * 2 + 8) = q1;
                q0.x = cvtpk(o1[0], o1[1]); q0.y = cvtpk(o1[2], o1[3]); q1.x = cvtpk(o1[4], o1[5]); q1.y = cvtpk(o1[6], o1[7]);
                *(LAS u32x2v*)(XS + (row + 1) * SO_XST + l0 * 2) = q0; *(LAS u32x2v*)(XS + (row + 1) * SO_XST + l0 * 2 + 8) = q1; }
            else { LAS unsigned char* img = pi < 192 ? BM : CM; const int n = 2 * ((pi - 128) & 63);
#pragma unroll
                for (int j = 0; j < 8; ++j) *(LAS unsigned*)(img + (l0 + j) * SO_NST + n * 2) = cvtpk(o0[j], o1[j]); } } }
        __syncthreads();
        const int h = g * 4 + r; const float dskip = dsk[h];
        f32x16 Y[2][2];
#pragma unroll
        for (int li = 0; li < 2; ++li) {
            const int lb = lsel ? (1 + li) : (li ? 3 : 0);
            bf16x8 cfr[8];
#pragma unroll
            for (int ks = 0; ks < 8; ++ks) cfr[ks] = *(const LAS bf16x8*)(CM + (lb * 32 + qc) * SO_NST + (16 * ks + 8 * hh) * 2);
#pragma unroll
            for (int pb = 0; pb < 2; ++pb)
#pragma unroll
                for (int i = 0; i < 16; ++i) Y[li][pb][i] = 0.f;
#pragma unroll
            for (int ks = 0; ks < 8; ++ks)
#pragma unroll
                for (int pb = 0; pb < 2; ++pb) Y[li][pb] = __builtin_amdgcn_mfma_f32_32x32x16_bf16(pf[pb][ks], cfr[ks], Y[li][pb], 0, 0, 0);
            const float ea = EA[r * 128 + lb * 32 + qc];
#pragma unroll
            for (int pb = 0; pb < 2; ++pb)
#pragma unroll
                for (int i = 0; i < 16; ++i) Y[li][pb][i] *= ea;
        }
#pragma unroll
        for (int li = 0; li < 2; ++li) {
            const int lb = lsel ? (1 + li) : (li ? 3 : 0);
            bf16x8 cfr[8];
#pragma unroll
            for (int ks = 0; ks < 8; ++ks) cfr[ks] = *(const LAS bf16x8*)(CM + (lb * 32 + qc) * SO_NST + (16 * ks + 8 * hh) * 2);
            const float acl = AC[r * 128 + lb * 32 + qc];
            for (int sb = 0; sb <= lb; ++sb) {
                bf16x8 afr[8];
#pragma unroll
                for (int ks = 0; ks < 8; ++ks) afr[ks] = *(const LAS bf16x8*)(BM + (sb * 32 + qc) * SO_NST + (16 * ks + 8 * hh) * 2);
                f32x16 X, X1;
#pragma unroll
                for (int i = 0; i < 16; ++i) { X[i] = 0.f; X1[i] = 0.f; }
#pragma unroll
                for (int ks = 0; ks < 8; ks += 2) { X = __builtin_amdgcn_mfma_f32_32x32x16_bf16(afr[ks], cfr[ks], X, 0, 0, 0);
                    X1 = __builtin_amdgcn_mfma_f32_32x32x16_bf16(afr[ks + 1], cfr[ks + 1], X1, 0, 0, 0); }
                union { bf16x8 v; u32x2v h2[2]; } xfr[2][2];
#pragma unroll
                for (int k2 = 0; k2 < 2; ++k2)
#pragma unroll
                    for (int pb = 0; pb < 2; ++pb) { const LAS unsigned char* xp = XS + (r * 64 + pb * 32 + qc) * SO_XST + (sb * 32 + 16 * k2 + 4 * hh) * 2;
                        xfr[k2][pb].h2[0] = *(const LAS u32x2v*)xp; xfr[k2][pb].h2[1] = *(const LAS u32x2v*)(xp + 16); }
#pragma unroll
                for (int i = 0; i < 16; ++i) X[i] += X1[i];
                const bool dg = (sb == lb);
#pragma unroll
                for (int q = 0; q < 4; ++q) { const f32x4v as4 = *(const LAS f32x4v*)(AC + r * 128 + sb * 32 + 8 * q + 4 * hh), ds4 = *(const LAS f32x4v*)(DT + r * 128 + sb * 32 + 8 * q + 4 * hh);
#pragma unroll
                    for (int i = 0; i < 4; ++i) { const int sl = 8 * q + 4 * hh + i;
                        const float e = __expf(acl - as4[i]) * ds4[i]; const bool ok = !dg || sl <= qc; float f = ok ? e : 0.f;
                        float xv = X[4 * q + i] * f; if (dg && sl == qc) xv += dskip; X[4 * q + i] = xv; } }
#pragma unroll
                for (int k2 = 0; k2 < 2; ++k2) { union { bf16x8 v; unsigned u[4]; } gb;
#pragma unroll
                    for (int e = 0; e < 4; ++e) gb.u[e] = cvtpk(X[8 * k2 + 2 * e], X[8 * k2 + 2 * e + 1]);
#pragma unroll
                    for (int pb = 0; pb < 2; ++pb) Y[li][pb] = __builtin_amdgcn_mfma_f32_32x32x16_bf16(xfr[k2][pb].v, gb.v, Y[li][pb], 0, 0, 0); }
            }
        }
        v4u zz8[8];
#pragma unroll
        for (int it = 0; it < 8; ++it) { const int task = tid + it * NT, row = task >> 5, ck = task & 31; zz8[it] = *(const v4u*)(proj + (size_t)(t0 + row) * NP + PZ + g * 256 + ck * 8); }
        __syncthreads();
#pragma unroll
        for (int li = 0; li < 2; ++li) { const int lb = lsel ? (1 + li) : (li ? 3 : 0);
#pragma unroll
            for (int pb = 0; pb < 2; ++pb)
#pragma unroll
                for (int q = 0; q < 4; ++q) { f32x4v v4; v4[0] = Y[li][pb][4 * q]; v4[1] = Y[li][pb][4 * q + 1]; v4[2] = Y[li][pb][4 * q + 2]; v4[3] = Y[li][pb][4 * q + 3];
                    *(LAS f32x4v*)(YS + (lb * 32 + qc) * SO_YST + r * 64 + pb * 32 + 8 * q + 4 * hh) = v4; } }
        __syncthreads();
        {
#pragma unroll
          for (int it = 0; it < 8; ++it) { const int task = tid + it * NT, row = task >> 5, ck = task & 31; const v4u zz = zz8[it];
            const f32x4v y0 = *(const LAS f32x4v*)(YS + row * SO_YST + ck * 8), y1 = *(const LAS f32x4v*)(YS + row * SO_YST + ck * 8 + 4);
            float o[8]; o[0] = y0[0] * silu_fast(bflo(zz.x)); o[1] = y0[1] * silu_fast(bfhi(zz.x)); o[2] = y0[2] * silu_fast(bflo(zz.y)); o[3] = y0[3] * silu_fast(bfhi(zz.y));
            o[4] = y1[0] * silu_fast(bflo(zz.z)); o[5] = y1[1] * silu_fast(bfhi(zz.z)); o[6] = y1[2] * silu_fast(bflo(zz.w)); o[7] = y1[3] * silu_fast(bfhi(zz.w));
            float ss = 0.f;
#pragma unroll
            for (int e = 0; e < 8; ++e) ss += o[e] * o[e];
            ss = half32_sum(ss);
            if (ck == 0) ssd[(size_t)(t0 + row) * 2 + g] = ss;
            v4u ov; ov.x = cvtpk(o[0], o[1]); ov.y = cvtpk(o[2], o[3]); ov.z = cvtpk(o[4], o[5]); ov.w = cvtpk(o[6], o[7]);
            *(v4u*)(ygb + (size_t)(t0 + row) * 1024 + g * 256 + ck * 8) = ov; } }
    }
}
constexpr int AT_KST = 144, AT_VST = 520, AT_K = 0, AT_V = 256 * AT_KST, AT_B = AT_V + 64 * AT_VST;
__device__ __forceinline__ void attn_preload(const Args& a, int unit, bf16x8 (&qfa)[2][4], v4u (&kv4)[4], v4u (&vv4)[4]) {
    const bf16* proj = (const bf16*)(a.ws + WS_PROJ);
    const int tid = threadIdx.x, lane = tid & 63, w = tid >> 6, g = w >> 1, half = w & 1, qc = lane & 31, hh = lane >> 5;
    const int kvh = unit & 1, blk = (unit >> 1) % NCH, b = unit / (2 * NCH); const int t0 = b * SEQ + blk * 128;
#pragma unroll
    for (int qb = 0; qb < 2; ++qb) { const bf16* qp = proj + (size_t)(t0 + half * 64 + qb * 32 + qc) * NP + PQ + (kvh * 4 + g) * 64 + 8 * hh;
#pragma unroll
        for (int ks = 0; ks < 4; ++ks) qfa[qb][ks] = *(const bf16x8*)(qp + 16 * ks); }
#pragma unroll
    for (int it = 0; it < 4; ++it) { const int c = tid + it * NT, row = c >> 3, part = c & 7; kv4[it] = (v4u){0u, 0u, 0u, 0u}; vv4[it] = (v4u){0u, 0u, 0u, 0u};
        if (blk > 0 || row >= 128) { const bf16* src = proj + (size_t)(t0 - 128 + row) * NP + kvh * 64 + part * 8; kv4[it] = *(const v4u*)(src + PK); vv4[it] = *(const v4u*)(src + PV); } }
}
__device__ __forceinline__ void ph_attn(const Args& a, LAS unsigned char* lds, int bid, int nb, bool pre, bf16x8 (&qfa)[2][4], v4u (&kv4)[4], v4u (&vv4)[4]) {
    const bf16* proj = (const bf16*)(a.ws + WS_PROJ); const float* sinks = a.in[9]; const float* relb = a.in[10];
    bf16* ao = (bf16*)(a.ws + WS_CAT) + 512; float* ssat = (float*)(a.ws + WS_SSAT);
    const int tid = threadIdx.x, lane = tid & 63, w = tid >> 6, g = w >> 1, half = w & 1, qc = lane & 31, hh = lane >> 5;
    LAS unsigned char* Kimg = lds + AT_K; LAS unsigned char* VT = lds + AT_V; LAS float* biasT = (LAS float*)(lds + AT_B);
    for (int unit = bid; unit < BATCH * NCH * 2; unit += nb) {
        const int kvh = unit & 1, blk = (unit >> 1) % NCH, b = unit / (2 * NCH); const int t0 = b * SEQ + blk * 128;
        __syncthreads();
        if (!(pre && unit == bid)) attn_preload(a, unit, qfa, kv4, vv4);
        {
#pragma unroll
          for (int it = 0; it < 4; ++it) { const int c = tid + it * NT, row = c >> 3, part = c & 7; const v4u kv = kv4[it], vv = vv4[it];
            *(LAS v4u*)(Kimg + row * AT_KST + part * 16) = kv;
            LAS unsigned short* vt = (LAS unsigned short*)(VT + (part * 8) * AT_VST + row * 2);
            vt[0 * (AT_VST / 2)] = (unsigned short)(vv.x & 0xffffu); vt[1 * (AT_VST / 2)] = (unsigned short)(vv.x >> 16);
            vt[2 * (AT_VST / 2)] = (unsigned short)(vv.y & 0xffffu); vt[3 * (AT_VST / 2)] = (unsigned short)(vv.y >> 16);
            vt[4 * (AT_VST / 2)] = (unsigned short)(vv.z & 0xffffu); vt[5 * (AT_VST / 2)] = (unsigned short)(vv.z >> 16);
            vt[6 * (AT_VST / 2)] = (unsigned short)(vv.w & 0xffffu); vt[7 * (AT_VST / 2)] = (unsigned short)(vv.w >> 16); } }
        { const int gg = tid >> 7, dist = tid & 127; biasT[gg * 128 + dist] = relb[c_bucket[dist] * 8 + kvh * 4 + gg]; }
        __syncthreads();
        const int hq = kvh * 4 + g; const float sink = sinks[hq];
#pragma unroll 1
        for (int qb = 0; qb < 2; ++qb) {
            const int q0 = half * 64 + qb * 32; const size_t tq = (size_t)(t0 + q0 + qc);
            bf16x8 qf[4];
#pragma unroll
            for (int ks = 0; ks < 4; ++ks) qf[ks] = qb ? qfa[1][ks] : qfa[0][ks];
            f32x16 sc[5];
#pragma unroll
            for (int kb = 0; kb < 5; ++kb) {
#pragma unroll
                for (int r = 0; r < 16; ++r) sc[kb][r] = 0.f;
                bf16x8 kf[4];
#pragma unroll
                for (int ks = 0; ks < 4; ++ks) kf[ks] = *(const LAS bf16x8*)(Kimg + (q0 + 32 * kb + qc) * AT_KST + (16 * ks + 8 * hh) * 2);
                __builtin_amdgcn_sched_barrier(0);
#pragma unroll
                for (int ks = 0; ks < 4; ++ks) sc[kb] = __builtin_amdgcn_mfma_f32_32x32x16_bf16(kf[ks], qf[ks], sc[kb], 0, 0, 0); }
            float m = -INFINITY;
#pragma unroll
            for (int kb = 0; kb < 5; ++kb)
#pragma unroll
                for (int r = 0; r < 16; ++r) { const int ki = (r & 3) + 8 * (r >> 2) + 4 * hh, dist = qc + 128 - 32 * kb - ki, j = q0 + 32 * kb + ki;
                    const bool ok = dist >= 0 && dist < 128 && (blk > 0 || j >= 128);
                    const float v = ok ? sc[kb][r] * 0.125f + biasT[g * 128 + (dist & 127)] : -INFINITY; sc[kb][r] = v; m = fmaxf(m, v); }
            m = pair32_max(m); m = fmaxf(m, sink);
            float l = 0.f;
#pragma unroll
            for (int kb = 0; kb < 5; ++kb)
#pragma unroll
                for (int r = 0; r < 16; ++r) { const float pv = __expf(sc[kb][r] - m); sc[kb][r] = pv; l += pv; }
            l = pair32_sum(l); l += __expf(sink - m);
            f32x16 o[2];
#pragma unroll
            for (int db = 0; db < 2; ++db)
#pragma unroll
                for (int r = 0; r < 16; ++r) o[db][r] = 0.f;
#pragma unroll
            for (int kb = 0; kb < 5; ++kb)
#pragma unroll
                for (int k2 = 0; k2 < 2; ++k2) {
                    union { bf16x8 v; u32x2v h2[2]; } va[2];
#pragma unroll
                    for (int db = 0; db < 2; ++db) { const LAS unsigned char* vp = VT + (db * 32 + qc) * AT_VST + (q0 + 32 * kb + 16 * k2 + 4 * hh) * 2;
                        va[db].h2[0] = *(const LAS u32x2v*)vp; va[db].h2[1] = *(const LAS u32x2v*)(vp + 16); }
                    union { bf16x8 v; unsigned u[4]; } pb;
#pragma unroll
                    for (int e = 0; e < 4; ++e) pb.u[e] = cvtpk(sc[kb][8 * k2 + 2 * e], sc[kb][8 * k2 + 2 * e + 1]);
#pragma unroll
                    for (int db = 0; db < 2; ++db) o[db] = __builtin_amdgcn_mfma_f32_32x32x16_bf16(va[db].v, pb.v, o[db], 0, 0, 0); }
            const float inv = 1.f / l; float ss = 0.f;
#pragma unroll
            for (int db = 0; db < 2; ++db)
#pragma unroll
                for (int r = 0; r < 16; ++r) { o[db][r] *= inv; ss += o[db][r] * o[db][r]; }
            ss = pair32_sum(ss);
            if (hh == 0) ssat[tq * 8 + hq] = ss;
#pragma unroll
            for (int db = 0; db < 2; ++db)
#pragma unroll
                for (int q4 = 0; q4 < 4; ++q4) { uint2 pk; pk.x = cvtpk(o[db][4 * q4], o[db][4 * q4 + 1]); pk.y = cvtpk(o[db][4 * q4 + 2], o[db][4 * q4 + 3]);
                    *(uint2*)(ao + tq * 1024 + hq * 64 + db * 32 + 8 * q4 + 4 * hh) = pk; }
        }
    }
}
constexpr int RT_UST = 1025;
constexpr int RT_P = 0, RT_L = 32768;
constexpr int RT_HIST = TAB_OFF, RT_BASE = TAB_OFF + 128, RT_SE = TAB_OFF + 256, RT_SG = RT_SE + 512, RT_SS = RT_SG + 512;
static_assert(32 * RT_UST * 4 <= SCR_BYTES, "router LDS map");
__device__ __forceinline__ void ph_router(const Args& a, LAS unsigned char* lds, int bid, int nb) {
    const float* hh_ = a.in[0]; const bf16* dl_ = (const bf16*)(a.ws + WS_H); const float* g = a.in[13]; const float* wr = a.in[14]; const float* br = a.in[15];
    unsigned char* u2 = a.ws + WS_U2; int* toke = (int*)(a.ws + WS_TOKE); int* toks = (int*)(a.ws + WS_TOKS); bf16* hb = (bf16*)(a.ws + WS_U);
    int* ltok = (int*)(a.ws + WS_LTOK); float* lgate = (float*)(a.ws + WS_LGATE); unsigned* cnt = (unsigned*)(a.ws + WS_CTL);
    const int tid = threadIdx.x, lane = tid & 63, w = tid >> 6, qc = lane & 31, hh = lane >> 5;
    LAS float* U = (LAS float*)lds; LAS float* P = (LAS float*)(lds + RT_P); LAS float* L = (LAS float*)(lds + RT_L);
    LAS unsigned* hist = (LAS unsigned*)(lds + RT_HIST); LAS unsigned* basev = (LAS unsigned*)(lds + RT_BASE);
    LAS int* se = (LAS int*)(lds + RT_SE); LAS float* sg = (LAS float*)(lds + RT_SG); LAS unsigned* ssl = (LAS unsigned*)(lds + RT_SS);
    float breg[64];
#pragma unroll
    for (int kk = 0; kk < 64; ++kk) breg[kk] = wr[(size_t)(128 * w + 2 * kk + hh) * NE + qc];
    float4 gq[4];
#pragma unroll
    for (int j = 0; j < 4; ++j) gq[j] = ((const float4*)g)[lane + 64 * j];
    const float brv = br[tid & 31];
    float4 vv[4][4]; uint2 dd[4][4];
#define RT_LOAD(tile_) do { const int tk_ = (tile_) * 32; _Pragma("unroll") for (int rr = 0; rr < 4; ++rr) { const int row = w * 4 + rr; \
        const float4* xr = (const float4*)(hh_ + (size_t)(tk_ + row) * DM); const uint2* dr = (const uint2*)(dl_ + (size_t)(tk_ + row) * DM); \
        _Pragma("unroll") for (int j = 0; j < 4; ++j) { vv[rr][j] = xr[lane + 64 * j]; dd[rr][j] = dr[lane + 64 * j]; } } } while (0)
    if (bid < T / 32) RT_LOAD(bid);
    for (int tile = bid; tile < T / 32; tile += nb) {
        const int tk0 = tile * 32;
        __syncthreads();
        if (tid < NE) hist[tid] = 0u;
#pragma unroll
        for (int rr = 0; rr < 4; ++rr) { const int row = w * 4 + rr; float4 (&v)[4] = vv[rr]; float s = 0.f;
#pragma unroll
            for (int j = 0; j < 4; ++j) { const uint2 dw = dd[rr][j]; v[j].x += bflo(dw.x); v[j].y += bfhi(dw.x); v[j].z += bflo(dw.y); v[j].w += bfhi(dw.y);
                uint2 hb2; hb2.x = pg8::cvt_pk_bf16(v[j].x, v[j].y); hb2.y = pg8::cvt_pk_bf16(v[j].z, v[j].w); *(uint2*)(hb + (size_t)(tk0 + row) * DM + 4 * lane + 256 * j) = hb2;
                s += v[j].x * v[j].x + v[j].y * v[j].y + v[j].z * v[j].z + v[j].w * v[j].w; }
            const float rs = rsqrtf(wave_sum(s) * (1.f / DM) + EPS);
#pragma unroll
            for (int j = 0; j < 4; ++j) { const float4 gg = gq[j];
                const float un[4] = {v[j].x * rs * gg.x, v[j].y * rs * gg.y, v[j].z * rs * gg.z, v[j].w * rs * gg.w};
                *(unsigned*)(u2 + (size_t)(tk0 + row) * DM + 4 * lane + 256 * j) = pk4_fp8(un[0], un[1], un[2], un[3]);
                LAS float* ur = U + row * RT_UST + 4 * lane + 256 * j; ur[0] = un[0]; ur[1] = un[1]; ur[2] = un[2]; ur[3] = un[3]; } }
        if (tile + nb < T / 32) RT_LOAD(tile + nb);
        __syncthreads();
        f32x16 acc, acc2;
#pragma unroll
        for (int i = 0; i < 16; ++i) { acc[i] = 0.f; acc2[i] = 0.f; }
#pragma unroll
        for (int kb = 0; kb < 2; ++kb) { float av[32];
#pragma unroll
            for (int kk = 0; kk < 32; ++kk) av[kk] = U[qc * RT_UST + 128 * w + 2 * (kb * 32 + kk) + hh];
#pragma unroll
            for (int kk = 0; kk < 32; kk += 2) { acc = __builtin_amdgcn_mfma_f32_32x32x2f32(av[kk], breg[kb * 32 + kk], acc, 0, 0, 0);
                acc2 = __builtin_amdgcn_mfma_f32_32x32x2f32(av[kk + 1], breg[kb * 32 + kk + 1], acc2, 0, 0, 0); } }
#pragma unroll
        for (int i = 0; i < 16; ++i) acc[i] += acc2[i];
        __syncthreads();
#pragma unroll
        for (int i = 0; i < 16; ++i) P[(w * 32 + (i & 3) + 8 * (i >> 2) + 4 * hh) * 32 + qc] = acc[i];
        __syncthreads();
#pragma unroll
        for (int o2 = 0; o2 < 2; ++o2) { const int o = tid + 512 * o2; float sacc = brv;
#pragma unroll
            for (int ww = 0; ww < 8; ++ww) sacc += P[ww * 1024 + o];
            L[o] = sacc; }
        __syncthreads();
#pragma unroll 1
        for (int it = 0; it < 2; ++it) { const int tok = w * 4 + it * 2 + hh;
            float cur = L[tok * 32 + qc]; int idx[4]; float val[4];
#pragma unroll
            for (int k = 0; k < 4; ++k) { const float m = half32_max(cur);
                const unsigned long long bal = __ballot(cur == m); const unsigned hb = hh ? (unsigned)(bal >> 32) : (unsigned)bal; const int wi = __ffs((int)hb) - 1;
                idx[k] = wi; val[k] = m; if (qc == wi) cur = -INFINITY; }
            if (qc < 4) { const float e1 = __expf(val[1] - val[0]), e2 = __expf(val[2] - val[0]), e3 = __expf(val[3] - val[0]); const float inv = 1.f / (1.f + e1 + e2 + e3);
                const float gsel = qc == 0 ? inv : (qc == 1 ? e1 * inv : (qc == 2 ? e2 * inv : e3 * inv)); const int esel = qc == 0 ? idx[0] : (qc == 1 ? idx[1] : (qc == 2 ? idx[2] : idx[3]));
                se[tok * 4 + qc] = esel; sg[tok * 4 + qc] = gsel; ssl[tok * 4 + qc] = atomicAdd((unsigned*)&hist[esel], 1u); } }
        __syncthreads();
        if (tid < NE) basev[tid] = atomicAdd(&cnt[tid], hist[tid]);
        __syncthreads();
        if (tid < 128) { const int tok = tid >> 2, e = se[tid]; const unsigned sl = basev[e] + ssl[tid]; const int tg = tk0 + tok;
            toke[tg * 4 + (tid & 3)] = e; toks[tg * 4 + (tid & 3)] = (int)sl; ltok[(size_t)e * T + sl] = tg; lgate[(size_t)e * T + sl] = sg[tid]; }
    }
}
#undef RT_LOAD
__device__ __forceinline__ void moe_setup(const Args& a, LAS unsigned char* lds, int nct, int G, int c, bool gather, unsigned pitch, bool plain, bool reuse = false) {
    LAS int* s_cnt = (LAS int*)(lds + TB_CNT); LAS int* s_ptile = (LAS int*)(lds + TB_PTILE); LAS int* s_re = (LAS int*)(lds + TB_RE); LAS int* s_tstart = (LAS int*)(lds + TB_TSTART);
    LAS int* s_misc = (LAS int*)(lds + TB_MISC); LAS int* s_units = (LAS int*)(lds + TB_UNITS); LAS unsigned* rowtab = (LAS unsigned*)(lds + TB_ROWTAB);
    const unsigned* cnt = (const unsigned*)(a.ws + WS_CTL); const int* ltok = (const int*)(a.ws + WS_LTOK);
    const int tid = threadIdx.x;
    __syncthreads();
    if (reuse) {
        if (tid <= NE) s_tstart[tid] = s_ptile[tid] * nct;
        if (tid == 0) { const int ts = s_ptile[NE] * nct; s_misc[0] = ts; s_misc[1] = (ts + G - 1) / G; }
    } else {
    if (tid < NE) s_cnt[tid] = (int)cnt[tid];
    __syncthreads();
    if (tid == 0) { int pt = 0, ts = 0;
        for (int e = 0; e < NE; ++e) { const int cn = s_cnt[e], re = (cn + 255) >> 8; s_ptile[e] = pt; s_re[e] = re; s_tstart[e] = ts; pt += re; ts += re * nct; }
        s_ptile[NE] = pt; s_tstart[NE] = ts; s_misc[0] = ts; s_misc[1] = (ts + G - 1) / G; }
    }
    __syncthreads();
    if (tid < 16) { const int nwg = s_misc[0]; const long L = (long)tid * G + c; int pm = -1, pn = 0;
        if (L < nwg) { int wgid = (int)L; { const int q = nwg / 8, r = nwg % 8, xcd = wgid % 8, off = wgid / 8; wgid = (xcd < r ? xcd * (q + 1) : r * (q + 1) + (xcd - r) * q) + off; }
            int e = 0; while (wgid >= s_tstart[e + 1]) ++e;
            const int local = wgid - s_tstart[e], re = s_re[e]; (void)re; pm = s_ptile[e] + local / nct; pn = e * nct + local % nct;     }
        s_units[2 * tid] = pm; s_units[2 * tid + 1] = pn; }
    __syncthreads();
    if (gather) { const int nr = s_misc[1] < 9 ? s_misc[1] : 9;
        LAS float* btab = (LAS float*)(lds + 131072); LAS float* gtab = btab + 5 * 256;
        float bv_[5], gv_[5]; unsigned rv_[5];
#pragma unroll
        for (int q = 0; q < 5; ++q) { const int idx = tid + q * NT, i = idx >> 8, r = idx & 255; bv_[q] = 0.f; gv_[q] = 0.f; rv_[q] = 0u;
            if (i < nr) { const int pm = s_units[2 * i]; if (pm >= 0) { const int e = s_units[2 * i + 1] / nct, ct = s_units[2 * i + 1] % nct, sl = (pm - s_ptile[e]) * 256 + r; const bool ok = sl < s_cnt[e];
                if (plain) { bv_[q] = a.in[19][(size_t)e * 1024 + ct * 256 + r]; gv_[q] = ok ? ((const float*)(a.ws + WS_LGATE))[(size_t)e * T + sl] : 0.f; rv_[q] = (unsigned)(pm * 256 + r) * pitch; }
                else { bv_[q] = a.in[17][(size_t)e * 2048 + (r < 128 ? 0 : 1024 - 128) + ct * 128 + r]; rv_[q] = ok ? (unsigned)ltok[(size_t)e * T + sl] * pitch : 0u; } } } }
#pragma unroll
        for (int q = 0; q < 5; ++q) { const int idx = tid + q * NT, i = idx >> 8; if (i < nr) { btab[idx] = bv_[q]; rowtab[idx] = rv_[q]; if (plain) gtab[idx] = gv_[q]; } } }
    __syncthreads();
}
typedef float float2v __attribute__((ext_vector_type(2)));
__device__ __forceinline__ void ph_final(const Args& a, LAS unsigned char* lds, int bid, int nb, bool reuse) {
    const bf16* hb = (const bf16*)(a.ws + WS_U); const unsigned char* ys = a.ws + WS_YS; const int* toke = (const int*)(a.ws + WS_TOKE); const int* toks = (const int*)(a.ws + WS_TOKS);
    const unsigned* cnt = (const unsigned*)(a.ws + WS_CTL); const float* g = a.in[20]; float* out = a.out;
    LAS int* s_ps = (LAS int*)(lds + TB_PTILE);
    __syncthreads();
    if (!reuse) {
    LAS int* s_c = (LAS int*)(lds + TB_CNT); if (threadIdx.x < NE) s_c[threadIdx.x] = (int)cnt[threadIdx.x];
    __syncthreads();
    if (threadIdx.x == 0) { int pt = 0; for (int e = 0; e < NE; ++e) { s_ps[e] = pt; pt += (s_c[e] + 255) >> 8; } }
    __syncthreads();
    }
    const int lane = threadIdx.x & 63, gw = bid * 8 + (threadIdx.x >> 6), ngw = nb * 8;
    size_t myoff = 0; { const int j = lane >> 2, k = lane & 3, r = gw + j * ngw; if (lane < 32 && r < T) myoff = ((size_t)s_ps[toke[r * 4 + k]] * 256 + toks[r * 4 + k]) * 1024; }
    for (int j = 0; gw + j * ngw < T; ++j) { const int r = gw + j * ngw;
        float4 v[4]; int wq[4][4];
        if (j < 8) {
#pragma unroll
            for (int k = 0; k < 4; ++k) { const int li = (j & 7) * 4 + k; const size_t off = ((size_t)(unsigned)__builtin_amdgcn_readlane((int)(unsigned)(myoff >> 32), li) << 32) | (size_t)(unsigned)__builtin_amdgcn_readlane((int)(unsigned)myoff, li);
#pragma unroll
                for (int jj = 0; jj < 4; ++jj) wq[k][jj] = *(const int*)(ys + off + 4 * lane + 256 * jj); } }
        else {
#pragma unroll
            for (int k = 0; k < 4; ++k) { const size_t off = ((size_t)s_ps[toke[r * 4 + k]] * 256 + toks[r * 4 + k]) * 1024;
#pragma unroll
                for (int jj = 0; jj < 4; ++jj) wq[k][jj] = *(const int*)(ys + off + 4 * lane + 256 * jj); } }
#pragma unroll
        for (int jj = 0; jj < 4; ++jj) { const uint2 dw = *(const uint2*)(hb + (size_t)r * DM + 4 * lane + 256 * jj);
            v[jj].x = bflo(dw.x); v[jj].y = bfhi(dw.x); v[jj].z = bflo(dw.y); v[jj].w = bfhi(dw.y); }
#pragma unroll
        for (int k = 0; k < 4; ++k)
#pragma unroll
            for (int jj = 0; jj < 4; ++jj) { const int w = wq[k][jj];
                const float2v lo = __builtin_amdgcn_cvt_pk_f32_fp8(w, false), hi = __builtin_amdgcn_cvt_pk_f32_fp8(w, true);
                v[jj].x += lo[0] * (1.f / YS8_SCALE); v[jj].y += lo[1] * (1.f / YS8_SCALE); v[jj].z += hi[0] * (1.f / YS8_SCALE); v[jj].w += hi[1] * (1.f / YS8_SCALE); }
        float s = 0.f;
#pragma unroll
        for (int jj = 0; jj < 4; ++jj) s += v[jj].x * v[jj].x + v[jj].y * v[jj].y + v[jj].z * v[jj].z + v[jj].w * v[jj].w;
        const float rs = rsqrtf(wave_sum(s) * (1.f / DM) + EPS);
#pragma unroll
        for (int jj = 0; jj < 4; ++jj) { const float4 gg = *(const float4*)(g + 4 * lane + 256 * jj);
            *(float4*)(out + (size_t)r * DM + 4 * lane + 256 * jj) = make_float4(v[jj].x * rs * gg.x, v[jj].y * rs * gg.y, v[jj].z * rs * gg.z, v[jj].w * rs * gg.w); }
    }
}

__global__ void __launch_bounds__(NT, 2) mk_fwd(Args args) {
    extern __shared__ __attribute__((aligned(16))) unsigned char smem[];
    LAS unsigned char* lds = (LAS unsigned char*)smem;
    const int tid = threadIdx.x, bid = blockIdx.x, G = gridDim.x;
    unsigned char* ws = args.ws;
    const int lo = args.ph_lo, hi = args.ph_hi;
#define IN(k) (lo <= (k) && (k) < hi)
#define BOTH(k) (IN(k) && IN((k) + 1))
    XcdBarrier bar; bar.bar = (unsigned*)(ws + WS_CTL) + CW_BAR + args.bar_sel * XCD_BAR_WORDS; bar.x = 0; bar.st = nullptr;
    if (MK_ONE_LAUNCH) {
        if (tid < 4) ((volatile LAS unsigned*)(lds + XBW_OFF))[tid] = 0u;
        __syncthreads();
        bar = xcd_barrier_post((unsigned*)(ws + WS_CTL) + CW_BAR + args.bar_sel * XCD_BAR_WORDS, (volatile LAS unsigned*)(lds + XBW_OFF));
    }
#define GRID_BAR() do { if (MK_ONE_LAUNCH) xcd_barrier(bar); } while (0)

    if (IN(0)) { ph_prologue(args, lds, bid, G); if (BOTH(0)) GRID_BAR(); }
    if (IN(1)) {
        const int gp = G > 192 ? 192 : G;
        if (bid < gp) {
            pg8::Gemm g{(const bf16*)(ws + WS_U), (const bf16*)(ws + WS_WIN), T, NP, DM}; pg8::StaticOrder S; S.init(T, NP, gp, bid);
            pg8::EpiStoreBf16 E{(bf16*)(ws + WS_PROJ), NP};
            pg8::gemm_phase<pg8::EpiStoreBf16, pg8::StaticOrder, true, true, false>(lds, g, S, E);
            __syncthreads();
            if (tid == 0) __hip_atomic_fetch_add((unsigned*)(ws + WS_CTL) + CW_GDONE, 1u, __ATOMIC_RELAXED, __HIP_MEMORY_SCOPE_AGENT);
            if (!BOTH(7)) moe_weight_queue(args, lds, bid, 0u); }
        else moe_weight_queue(args, lds, bid, BOTH(7) ? (unsigned)gp : 0u);
        if (BOTH(1)) GRID_BAR();
    }
    if (IN(3)) { ph_ssd_local(args, lds, bid, G); if (BOTH(3)) GRID_BAR(); }
    if (IN(4)) { bf16x8 at_q[2][4]; v4u at_k[4], at_v[4]; const bool at_pre = bid < BATCH * NCH * 2;
        if (at_pre) attn_preload(args, bid, at_q, at_k, at_v);
        ph_scan(args, bid, G); ph_attn(args, lds, bid, G, at_pre, at_q, at_k, at_v); if (BOTH(4)) GRID_BAR(); }
    if (IN(5)) { ph_ssd_out(args, lds, bid, G); if (BOTH(5)) GRID_BAR(); }
    if (IN(7)) {
        __syncthreads();
        pg8::Gemm g{(const bf16*)(ws + WS_CAT), (const bf16*)(ws + WS_WOUT), T, DM, DM}; pg8::StaticOrder S; S.init(T, DM, G, bid);
        LAS float* r1 = (LAS float*)(lds + TAB_OFF); LAS float* r2 = r1 + 256;
        pg8::EpiResScale E{(bf16*)(ws + WS_H), DM, r1, r2, (const float*)(ws + WS_SSSD), (const float*)(ws + WS_SSAT)};
        pg8::gemm_phase<pg8::EpiResScale, pg8::StaticOrder, false, true, false>(lds, g, S, E);
        if (BOTH(7)) GRID_BAR();
    }
    if (IN(8)) {
        const int gr = (IN(1) && G >= 16) ? G / 2 : G;
        if (bid < gr) ph_router(args, lds, bid, gr);
        if (IN(1)) { __syncthreads(); moe_weight_queue(args, lds, bid, 0u, (G & 7) == 0 ? 1 : 8); }
        if (BOTH(8)) GRID_BAR(); }
    if (IN(9)) {
        moe_setup(args, lds, 8, G, bid, true, 1024u, false);
        pg8::Gemm g{(const bf16*)(ws + WS_U2), (const bf16*)(ws + WS_W1), MAXROWS, NE * 2048, DM / 2};
        pg8::MoeOrder S{(const LAS int*)(lds + TB_UNITS), (const LAS unsigned*)(lds + TB_ROWTAB), __builtin_amdgcn_readfirstlane(*(const LAS int*)(lds + TB_MISC + 4))};
        pg8::EpiSwiglu E{ws + WS_ACT, (const LAS float*)(lds + 131072), 1.f / W8_SCALE, ACT8_SCALE};
        pg8::gemm_phase<pg8::EpiSwiglu, pg8::MoeOrder, true, true, true, true>(lds, g, S, E);
        if (BOTH(9)) GRID_BAR();
    }
    if (IN(10)) {
        moe_setup(args, lds, 4, G, bid, true, 1024u, true, MK_ONE_LAUNCH && BOTH(9));
        pg8::Gemm g{(const bf16*)(ws + WS_ACT), (const bf16*)(ws + WS_W2), MAXROWS, NE * 1024, DM / 2};
        pg8::MoeOrder S{(const LAS int*)(lds + TB_UNITS), (const LAS unsigned*)(lds + TB_ROWTAB), __builtin_amdgcn_readfirstlane(*(const LAS int*)(lds + TB_MISC + 4))};
        pg8::EpiMoe2 E{ws + WS_YS, (const LAS float*)(lds + 131072), (const LAS float*)(lds + 131072) + 5 * 256, 1.f / (W8_SCALE * ACT8_SCALE), YS8_SCALE};
        pg8::gemm_phase<pg8::EpiMoe2, pg8::MoeOrder, true, true, true, true>(lds, g, S, E);
        if (BOTH(10)) GRID_BAR();
    }
    if (IN(11)) { ph_final(args, lds, bid, G, MK_ONE_LAUNCH && BOTH(10)); }
#undef IN
#undef BOTH
}

extern "C" void kernel_launch(void* const* d_in, const int* in_sizes, int n_in, void* d_out, int out_size, void* d_ws, size_t ws_size, hipStream_t stream) {
    static int grid = 0;
    if (grid == 0) {
        if (n_in != 21 || out_size != T * DM || ws_size < WS_END) { fprintf(stderr, "kernel_launch: unexpected shapes (n_in %d out %d ws %zu)\n", n_in, out_size, ws_size); grid = -1; return; }
        int dev = 0, cus = 0, per_cu = 0;
        if (hipGetDevice(&dev) != hipSuccess || hipDeviceGetAttribute(&cus, hipDeviceAttributeMultiprocessorCount, dev) != hipSuccess) { grid = -1; return; }
        if (hipFuncSetAttribute((const void*)mk_fwd, hipFuncAttributeMaxDynamicSharedMemorySize, LDS_BYTES) != hipSuccess) { fprintf(stderr, "kernel_launch: hipFuncSetAttribute failed\n"); grid = -1; return; }
        if (hipOccupancyMaxActiveBlocksPerMultiprocessor(&per_cu, (const void*)mk_fwd, NT, LDS_BYTES) != hipSuccess || per_cu < 1) { fprintf(stderr, "kernel_launch: occupancy query says %d blocks per CU\n", per_cu); }
        (void)hipGetLastError();
        grid = cus;
    }
    if (grid < 0) return;
    if (hipMemsetAsync((char*)d_ws + WS_CTL, 0, 65536, stream) != hipSuccess) return;
    Args a{};
    for (int i = 0; i < 21; ++i) a.in[i] = (const float*)d_in[i];
    a.out = (float*)d_out; a.ws = (unsigned char*)d_ws;
#if MK_ONE_LAUNCH
    a.ph_lo = 0; a.ph_hi = NPH;
    hipLaunchKernelGGL(mk_fwd, dim3(grid), dim3(NT), LDS_BYTES, stream, a);
#if defined(PROBE_LO)
    a.ph_lo = PROBE_LO; a.ph_hi = PROBE_HI; a.bar_sel = 1;
    hipLaunchKernelGGL(mk_fwd, dim3(grid), dim3(NT), LDS_BYTES, stream, a);
#endif
#if defined(PROBE_LO2)
    a.ph_lo = PROBE_LO2; a.ph_hi = PROBE_HI2; a.bar_sel = 2;
    hipLaunchKernelGGL(mk_fwd, dim3(grid), dim3(NT), LDS_BYTES, stream, a);
#endif
#else
    for (int ph = 0; ph < NPH; ++ph) { a.ph_lo = ph; a.ph_hi = ph + 1; hipLaunchKernelGGL(mk_fwd, dim3(grid), dim3(NT), LDS_BYTES, stream, a); }
#endif
}
```
